# Optimizing an MI355X kernel written in HIP

```python
import math
import jax, jax.numpy as jnp
from jax import lax
import numpy as np

D_MODEL = 1024
BATCH = 2
SEQ = 16384
DEPTH = 2
DEC_BATCH = 16
DEC_SEQ = 2048
PAST_LEN = 128

N_MIXERS = 2
N_ATTN_LAYERS = (DEPTH + 1) // 2
N_SGU_LAYERS = DEPTH // 2
DIFF_HEAD_DIM = 64
DIFF_HEADS = D_MODEL // (2 * DIFF_HEAD_DIM)
Q_BLOCK = 128
ROPE_THETA = 10000.0
CHUNK = 128
SGU_WIDTH = D_MODEL
SGU_GROUP_DIM = 128
SGU_GROUPS = SGU_WIDTH // SGU_GROUP_DIM
D_FF = 2816
CONV_WIDTH = 3
PLE_DIM = 256
EPS = 1e-6

kernel_name = "hybrid_diffattn_sgu_convffn_encoder"


def rms_norm(x, g):
    xf = x.astype(jnp.float32)
    y = xf * lax.rsqrt(jnp.mean(xf * xf, axis=-1, keepdims=True) + EPS)
    return (y * g.astype(jnp.float32)).astype(x.dtype)


def layer_norm(x, g, b):
    xf = x.astype(jnp.float32)
    mu = jnp.mean(xf, axis=-1, keepdims=True)
    xc = xf - mu
    y = xc * lax.rsqrt(jnp.mean(xc * xc, axis=-1, keepdims=True) + EPS)
    return (y * g.astype(jnp.float32) + b.astype(jnp.float32)).astype(x.dtype)


def rope_tables(seq, dtype):
    inv = 1.0 / (ROPE_THETA ** (jnp.arange(0, DIFF_HEAD_DIM, 2, dtype=jnp.float32) / DIFF_HEAD_DIM))
    ang = jnp.arange(seq, dtype=jnp.float32)[:, None] * inv[None, :]
    ang = jnp.concatenate([ang, ang], axis=-1)
    return jnp.cos(ang).astype(dtype), jnp.sin(ang).astype(dtype)


def apply_rope(x, cos, sin):
    x1, x2 = jnp.split(x, 2, axis=-1)
    rot = jnp.concatenate([-x2, x1], axis=-1)
    return x * cos[None, :, None, :] + rot * sin[None, :, None, :]


def diff_attention(h, w_qkv, lq1, lk1, lq2, lk2, subln_g, w_o, lambda_init):
    B, S, _ = h.shape
    q, k, v = jnp.split(h @ w_qkv, 3, axis=-1)
    q = q.reshape(B, S, 2 * DIFF_HEADS, DIFF_HEAD_DIM)
    k = k.reshape(B, S, 2 * DIFF_HEADS, DIFF_HEAD_DIM)
    v = v.reshape(B, S, DIFF_HEADS, 2 * DIFF_HEAD_DIM)
    cos, sin = rope_tables(S, h.dtype)
    q = apply_rope(q, cos, sin) * (DIFF_HEAD_DIM ** -0.5)
    k = apply_rope(k, cos, sin)
    f32 = jnp.float32
    lam = (jnp.exp(jnp.sum(lq1.astype(f32) * lk1.astype(f32)))
           - jnp.exp(jnp.sum(lq2.astype(f32) * lk2.astype(f32))) + lambda_init)
    nb = S // Q_BLOCK
    q_blocks = q.reshape(B, nb, Q_BLOCK, 2 * DIFF_HEADS, DIFF_HEAD_DIM).transpose(1, 0, 2, 3, 4)

    def block(qb):
        s = jnp.einsum('bqhd,bkhd->bhqk', qb, k, preferred_element_type=jnp.float32)
        p = jax.nn.softmax(s, axis=-1).reshape(B, DIFF_HEADS, 2, Q_BLOCK, S)
        a = p[:, :, 0] - lam * p[:, :, 1]
        return jnp.einsum('bhqk,bkhd->bqhd', a.astype(v.dtype), v)

    o = lax.map(block, q_blocks)
    o = o.transpose(1, 0, 2, 3, 4).reshape(B, S, DIFF_HEADS, 2 * DIFF_HEAD_DIM)
    o = rms_norm(o, subln_g) * (1.0 - lambda_init)
    return o.reshape(B, S, D_MODEL) @ w_o


def chunked_sgu(h, w_uv, ln_g, ln_b, w_s, b_s, w_out):
    B, S, _ = h.shape
    z = jax.nn.gelu(h @ w_uv, approximate=False)
    u, v = jnp.split(z, 2, axis=-1)
    v = layer_norm(v, ln_g, ln_b)
    nc = S // CHUNK
    v = v.reshape(B, nc, CHUNK, SGU_GROUPS, SGU_GROUP_DIM)
    mixed = jnp.einsum('gpq,bnqgc->bnpgc', w_s, v) + b_s.T[None, None, :, :, None]
    return (u * mixed.reshape(B, S, SGU_WIDTH)) @ w_out


def conv_ffn(h, w_up, conv_w, conv_b, w_down):
    a = h @ w_up
    S = a.shape[1]
    half = CONV_WIDTH // 2
    pad = jnp.pad(a, ((0, 0), (half, half), (0, 0)))
    c = conv_b
    for t in range(CONV_WIDTH):
        c = c + pad[:, t:t + S] * conv_w[t]
    val, gate = jnp.split(c, 2, axis=-1)
    return (jax.nn.silu(gate) * val) @ w_down


def trunk(x, p, norm_mix_g, attn_w_qkv, attn_lq1, attn_lk1, attn_lq2, attn_lk2, attn_subln_g, attn_w_o,
          sgu_w_uv, sgu_ln_g, sgu_ln_b, sgu_w_s, sgu_b_s, sgu_w_out,
          norm_ffn_g, ffn_w_up, ffn_conv_w, ffn_conv_b, ffn_w_down,
          norm_ple_g, ple_w_gate, ple_w_proj, final_norm_g):
    for i in range(DEPTH):
        h = rms_norm(x, norm_mix_g[i])
        j = i // N_MIXERS
        if i % N_MIXERS == 0:
            lambda_init = 0.8 - 0.6 * math.exp(-0.3 * i)
            x = x + diff_attention(h, attn_w_qkv[j], attn_lq1[j], attn_lk1[j], attn_lq2[j], attn_lk2[j],
                                   attn_subln_g[j], attn_w_o[j], lambda_init)
        else:
            x = x + chunked_sgu(h, sgu_w_uv[j], sgu_ln_g[j], sgu_ln_b[j], sgu_w_s[j], sgu_b_s[j], sgu_w_out[j])
        x = x + conv_ffn(rms_norm(x, norm_ffn_g[i]), ffn_w_up[i], ffn_conv_w[i], ffn_conv_b[i], ffn_w_down[i])
        gate = jax.nn.sigmoid(rms_norm(x, norm_ple_g[i]) @ ple_w_gate[i])
        x = x + gate * (p[i] @ ple_w_proj[i])
    return rms_norm(x, final_norm_g)


def setup_inputs(seed: int = 0) -> dict:
    key = jax.random.key(seed)
    ks = jax.random.split(key, 32)
    f32 = jnp.float32

    def nrm(k, shape, scale):
        return jax.random.normal(k, shape, f32) * scale

    D, W, F = D_MODEL, SGU_WIDTH, D_FF
    NA, NB = N_ATTN_LAYERS, N_SGU_LAYERS
    return {
        "x_prompt": nrm(ks[0], (BATCH, SEQ, D), 1.0),
        "x_sample": nrm(ks[1], (DEC_BATCH, DEC_SEQ, D), 1.0),
        "p_prompt": nrm(ks[2], (DEPTH, BATCH, SEQ, PLE_DIM), 1.0),
        "p_sample": nrm(ks[3], (DEPTH, DEC_BATCH, DEC_SEQ, PLE_DIM), 1.0),
        "norm_mix_g": 1.0 + nrm(ks[4], (DEPTH, D), 0.02),
        "attn_w_qkv": nrm(ks[5], (NA, D, 3 * D), D ** -0.5),
        "attn_lq1": nrm(ks[6], (NA, DIFF_HEAD_DIM), 0.1),
        "attn_lk1": nrm(ks[7], (NA, DIFF_HEAD_DIM), 0.1),
        "attn_lq2": nrm(ks[8], (NA, DIFF_HEAD_DIM), 0.1),
        "attn_lk2": nrm(ks[9], (NA, DIFF_HEAD_DIM), 0.1),
        "attn_subln_g": 1.0 + nrm(ks[10], (NA, 2 * DIFF_HEAD_DIM), 0.02),
        "attn_w_o": nrm(ks[11], (NA, D, D), 0.5 * D ** -0.5),
        "sgu_w_uv": nrm(ks[12], (NB, D, 2 * W), D ** -0.5),
        "sgu_ln_g": 1.0 + nrm(ks[13], (NB, W), 0.02),
        "sgu_ln_b": nrm(ks[14], (NB, W), 0.02),
        "sgu_w_s": nrm(ks[15], (NB, SGU_GROUPS, CHUNK, CHUNK), CHUNK ** -0.5),
        "sgu_b_s": 1.0 + nrm(ks[16], (NB, SGU_GROUPS, CHUNK), 0.02),
        "sgu_w_out": nrm(ks[17], (NB, W, D), 0.5 * W ** -0.5),
        "norm_ffn_g": 1.0 + nrm(ks[18], (DEPTH, D), 0.02),
        "ffn_w_up": nrm(ks[19], (DEPTH, D, 2 * F), D ** -0.5),
        "ffn_conv_w": nrm(ks[20], (DEPTH, CONV_WIDTH, 2 * F), CONV_WIDTH ** -0.5),
        "ffn_conv_b": nrm(ks[21], (DEPTH, 2 * F), 0.02),
        "ffn_w_down": nrm(ks[22], (DEPTH, F, D), 0.5 * F ** -0.5),
        "norm_ple_g": 1.0 + nrm(ks[23], (DEPTH, D), 0.02),
        "ple_w_gate": nrm(ks[24], (DEPTH, D, D), D ** -0.5),
        "ple_w_proj": nrm(ks[25], (DEPTH, PLE_DIM, D), 0.5 * PLE_DIM ** -0.5),
        "final_norm_g": 1.0 + nrm(ks[26], (D,), 0.02),
    }


def reference(x_prompt, x_sample, p_prompt, p_sample, norm_mix_g, attn_w_qkv, attn_lq1, attn_lk1, attn_lq2,
              attn_lk2, attn_subln_g, attn_w_o, sgu_w_uv, sgu_ln_g, sgu_ln_b, sgu_w_s, sgu_b_s, sgu_w_out,
              norm_ffn_g, ffn_w_up, ffn_conv_w, ffn_conv_b, ffn_w_down, norm_ple_g, ple_w_gate, ple_w_proj,
              final_norm_g):
    y_prompt = trunk(x_prompt, p_prompt, norm_mix_g, attn_w_qkv, attn_lq1, attn_lk1, attn_lq2, attn_lk2,
                     attn_subln_g, attn_w_o, sgu_w_uv, sgu_ln_g, sgu_ln_b, sgu_w_s, sgu_b_s, sgu_w_out,
                     norm_ffn_g, ffn_w_up, ffn_conv_w, ffn_conv_b, ffn_w_down, norm_ple_g, ple_w_gate,
                     ple_w_proj, final_norm_g)
    y_sample = trunk(x_sample, p_sample, norm_mix_g, attn_w_qkv, attn_lq1, attn_lk1, attn_lq2, attn_lk2,
                     attn_subln_g, attn_w_o, sgu_w_uv, sgu_ln_g, sgu_ln_b, sgu_w_s, sgu_b_s, sgu_w_out,
                     norm_ffn_g, ffn_w_up, ffn_conv_w, ffn_conv_b, ffn_w_down, norm_ple_g, ple_w_gate,
                     ple_w_proj, final_norm_g)
    return (y_prompt, y_sample)
```

```cpp
#include <hip/hip_runtime.h>
#include <hip/hip_cooperative_groups.h>
#include <cstdio>
#include <cstdint>
namespace cg = cooperative_groups;
#define MODE 0
#define FASTMASK 0x7f
namespace pg8 {
#define PG8_LAS __attribute__((address_space(3)))
typedef unsigned short bf16_t;
typedef short bf16x8 __attribute__((ext_vector_type(8)));
typedef float f32x4 __attribute__((ext_vector_type(4)));
typedef unsigned u32x4 __attribute__((ext_vector_type(4)));
constexpr int BM = 256, BK = 64, HALF = 128, HTB = HALF * BK * 2  , STAGE_BYTES = 8 * HTB, NXCD = 8, WGM = 8;

__host__ __device__ __forceinline__ int lds_byte(int r, int c) { const int st = (r >> 4) * 2 + (c >> 5), rr = r & 15, cc = c & 31, ob = rr * 64 + cc * 2; return st * 1024 + (ob ^ (((ob >> 9) & 1) << 5)); }
__host__ __device__ __forceinline__ void stage_rc(int b, int& R, int& C) { const int st = b / 1024, sb = b % 1024, swz = sb ^ (((sb >> 9) & 1) << 5); R = (st >> 1) * 16 + swz / 64; C = (st & 1) * 32 + (swz % 64) / 2; }
__host__ __device__ __forceinline__ int perm32(int rho) { const int n = rho >> 4, i = rho & 15; return 8 * (i >> 2) + 4 * n + (i & 3); }

struct Unit { int pm, pn; };
struct Gemm { const bf16_t* A; const bf16_t* Bt; int M, N, K; };

struct StaticOrder {
    int nM, nN, nwg, G, c;
    __host__ __device__ __forceinline__ void init(int M, int N, int G_, int c_) { nM = M / BM; nN = N / BM; nwg = nM * nN; G = G_; c = c_; }
    __host__ __device__ __forceinline__ bool next(int i, Unit& u) const {
        const long L = (long)i * G + c; if (L >= nwg) return false;
        int wgid = (int)L; { const int q = nwg / NXCD, r = nwg % NXCD, xcd = wgid % NXCD, off = wgid / NXCD; wgid = (xcd < r ? xcd * (q + 1) : r * (q + 1) + (xcd - r) * q) + off; }
        const int nig = WGM * nN, gid = wgid / nig, fm = gid * WGM, gsz = (nM - fm) < WGM ? (nM - fm) : WGM;
        u.pm = fm + ((wgid % nig) % gsz); u.pn = (wgid % nig) / gsz; return true;
    }
    __device__ __forceinline__ void a_ready(const Unit&) const {}
    __device__ __forceinline__ void done(const Unit&) const {}
};

__device__ __forceinline__ unsigned cvt_pk_bf16(float lo, float hi) { unsigned r; asm volatile("v_cvt_pk_bf16_f32 %0, %1, %2" : "=v"(r) : "v"(lo), "v"(hi)); return r; }
typedef float f32x2 __attribute__((ext_vector_type(2)));
__device__ __forceinline__ f32x2 gelu_pk(f32x2 v) {
    const f32x2 av = __builtin_elementwise_abs(v), d = av * 0.2316418882f + 1.0f;
    f32x2 t; t.x = __builtin_amdgcn_rcpf(d.x); t.y = __builtin_amdgcn_rcpf(d.y);
    f32x2 q = t * 0.5307027145f + (-0.7265760135f); q = q * t + 0.7107068705f; q = q * t + (-0.142248368f); q = q * t + 0.127414796f; q = q * t;
    const f32x2 s = (v * v) * (-0.72134752044f);
    f32x2 e; e.x = __builtin_amdgcn_exp2f(s.x); e.y = __builtin_amdgcn_exp2f(s.y);
    const f32x2 m = v * (q * e), r = v - m;
    f32x2 o; o.x = v.x < 0.f ? m.x : r.x; o.y = v.y < 0.f ? m.y : r.y; return o;
}

template <class Epi, class Sched, bool ALIGN_EPI = false, bool SP2 = false>
__device__ __forceinline__ void gemm_phase(PG8_LAS unsigned char* lds, const Gemm g, const Sched& S, const Epi& E) {
    int tid_ = threadIdx.x; asm volatile("" : "+v"(tid_));
    const int tid = tid_, wid = __builtin_amdgcn_readfirstlane(tid >> 6), lane = tid & 63, wr = wid >> 2, wc = wid & 3, fr = lane & 15, fq = lane >> 4;
    const int K = g.K, nt = K / BK;
    unsigned voffA[2], voffB[2];
#pragma unroll
    for (int i = 0; i < 2; ++i) { int R, C; stage_rc(tid * 16 + i * 8192, R, C); const int Rb = Epi::PERM ? ((R & ~31) + perm32(R & 31)) : R;
        voffA[i] = (unsigned)(R * K + C) * 2u; voffB[i] = (unsigned)(Rb * K + C) * 2u; }
    const size_t kstep = (size_t)(BK * 2);
    const size_t hstep = (size_t)HALF * K * 2;
    const size_t tstep = 2 * hstep;
    const unsigned ldsw = (unsigned)wid * 1024u;
    const int aoff = lds_byte(wr * 64 + fr, fq * 8), boff = lds_byte(wc * 32 + fr, fq * 8);
#define PG8_SA(b, h) (((b) * 2 + (h)) * HTB)
#define PG8_SB(b, h) ((4 + (b) * 2 + (h)) * HTB)
#define PG8_STAGE(bufoff, gbase, voff) do { _Pragma("unroll") for (int _i = 0; _i < 2; ++_i) \
        __builtin_amdgcn_global_load_lds((const unsigned*)((const char*)(gbase) + (voff)[_i]), (PG8_LAS unsigned*)(lds + (bufoff) + ldsw + _i * 8192), 16, 0, 0); } while (0)
#define PG8_LDA(dst, b, h) do { _Pragma("unroll") for (int m = 0; m < 4; ++m) _Pragma("unroll") for (int k = 0; k < 2; ++k) dst[m][k] = *(const PG8_LAS bf16x8*)(lds + PG8_SA(b, h) + aoff + m * 2048 + k * 1024); } while (0)
#define PG8_LDB(dst, b, h) do { _Pragma("unroll") for (int n = 0; n < 2; ++n) _Pragma("unroll") for (int k = 0; k < 2; ++k) dst[n][k] = *(const PG8_LAS bf16x8*)(lds + PG8_SB(b, h) + boff + n * 2048 + k * 1024); } while (0)
#define PG8_MMA(ai, bj, At, Bt) do { __builtin_amdgcn_s_setprio(1); _Pragma("unroll") for (int m = 0; m < 4; ++m) _Pragma("unroll") for (int n = 0; n < 2; ++n) _Pragma("unroll") for (int k = 0; k < 2; ++k) \
        acc[ai][bj][m][n] = __builtin_amdgcn_mfma_f32_16x16x32_bf16(Bt[n][k], At[m][k], acc[ai][bj][m][n], 0, 0, 0); __builtin_amdgcn_s_setprio(0); } while (0)
#define PG8_WAIT_V(n) asm volatile("s_waitcnt vmcnt(" #n ")" ::: "memory")
#define PG8_WAIT_L(n) asm volatile("s_waitcnt lgkmcnt(" #n ")" ::: "memory")
#define PG8_BAR __builtin_amdgcn_s_barrier()
#define PG8_SCHED __builtin_amdgcn_sched_barrier(0)
    Unit cur, nxt; int ui = 0;
    if (!S.next(0, cur)) return;
    f32x4 acc[2][2][4][2];
#pragma unroll
    for (int a = 0; a < 2; ++a)
#pragma unroll
        for (int b = 0; b < 2; ++b)
#pragma unroll
            for (int m = 0; m < 4; ++m)
#pragma unroll
                for (int n = 0; n < 2; ++n) acc[a][b][m][n] = (f32x4){0.f, 0.f, 0.f, 0.f};
    bf16x8 At[4][2], B0[2][2], B1[2][2];
    const char* cA = (const char*)g.A + (size_t)cur.pm * tstep; const char* cB = (const char*)g.Bt + (size_t)cur.pn * tstep;
    S.a_ready(cur);
    if constexpr (SP2) {
        PG8_STAGE(PG8_SB(0, 0), cB, voffB); PG8_STAGE(PG8_SB(0, 1), cB + hstep, voffB); PG8_STAGE(PG8_SA(0, 0), cA, voffA); PG8_STAGE(PG8_SA(0, 1), cA + hstep, voffA);
        if (wr == 1) PG8_BAR;
        PG8_WAIT_V(2); PG8_BAR;
        PG8_STAGE(PG8_SB(1, 0), cB + kstep, voffB); PG8_STAGE(PG8_SA(1, 0), cA + kstep, voffA); PG8_STAGE(PG8_SB(1, 1), cB + hstep + kstep, voffB);
        PG8_WAIT_V(6); PG8_BAR;
    } else {
        PG8_STAGE(PG8_SB(0, 0), cB, voffB); PG8_STAGE(PG8_SA(0, 0), cA, voffA); PG8_STAGE(PG8_SB(0, 1), cB + hstep, voffB); PG8_STAGE(PG8_SA(0, 1), cA + hstep, voffA);
        if (wr == 1) PG8_BAR;
        PG8_WAIT_V(4); PG8_BAR;
        PG8_STAGE(PG8_SB(1, 0), cB + kstep, voffB); PG8_STAGE(PG8_SA(1, 0), cA + kstep, voffA); PG8_STAGE(PG8_SB(1, 1), cB + hstep + kstep, voffB);
        PG8_WAIT_V(6); PG8_BAR;
    }
    for (;;) {
        const bool has_next = S.next(ui + 1, nxt);
        const char* nA = has_next ? (const char*)g.A + (size_t)nxt.pm * tstep : cA; const char* nB = has_next ? (const char*)g.Bt + (size_t)nxt.pn * tstep : cB;
#pragma unroll 1
        for (int t = 0; t < nt; t += 2) {
            const bool last = (t == nt - 2);
            const char* a1 = cA + (size_t)(t + 1) * kstep;
            const char* a2 = last ? nA : cA + (size_t)(t + 2) * kstep; const char* b2 = last ? nB : cB + (size_t)(t + 2) * kstep;
            const char* a3 = a2 + kstep; const char* b3 = b2 + kstep;
            if (last && has_next) S.a_ready(nxt);
            if constexpr (SP2) {
            PG8_LDB(B0, 0, 0); PG8_LDB(B1, 0, 1); PG8_SCHED; PG8_LDA(At, 0, 0); PG8_STAGE(PG8_SA(1, 1), a1 + hstep, voffA);
            PG8_WAIT_V(8); PG8_WAIT_L(0); PG8_BAR; PG8_MMA(0, 0, At, B0); PG8_MMA(0, 1, At, B1); PG8_BAR; PG8_SCHED;
            PG8_LDA(At, 0, 1); PG8_STAGE(PG8_SB(0, 0), b2, voffB); PG8_STAGE(PG8_SB(0, 1), b2 + hstep, voffB); PG8_STAGE(PG8_SA(0, 0), a2, voffA);
            PG8_WAIT_V(8); PG8_WAIT_L(0); PG8_BAR; PG8_MMA(1, 0, At, B0); PG8_MMA(1, 1, At, B1); PG8_BAR; PG8_SCHED;
            PG8_LDB(B0, 1, 0); PG8_LDB(B1, 1, 1); PG8_SCHED; PG8_LDA(At, 1, 0); PG8_STAGE(PG8_SA(0, 1), a2 + hstep, voffA);
            PG8_WAIT_V(8); PG8_WAIT_L(0); PG8_BAR; PG8_MMA(0, 0, At, B0); PG8_MMA(0, 1, At, B1); PG8_BAR; PG8_SCHED;
            PG8_LDA(At, 1, 1); PG8_STAGE(PG8_SB(1, 0), b3, voffB); PG8_STAGE(PG8_SB(1, 1), b3 + hstep, voffB); PG8_STAGE(PG8_SA(1, 0), a3, voffA);
            PG8_WAIT_V(8); PG8_WAIT_L(0); PG8_BAR; PG8_MMA(1, 0, At, B0); PG8_MMA(1, 1, At, B1); PG8_BAR; PG8_SCHED;
            } else {
            PG8_LDB(B0, 0, 0); PG8_SCHED; PG8_LDA(At, 0, 0); PG8_STAGE(PG8_SA(1, 1), a1 + hstep, voffA);
            PG8_WAIT_L(8); PG8_BAR; PG8_WAIT_L(0); PG8_MMA(0, 0, At, B0); PG8_BAR; PG8_SCHED;
            PG8_LDB(B1, 0, 1); PG8_STAGE(PG8_SB(0, 0), b2, voffB);
            PG8_BAR; PG8_WAIT_L(0); PG8_MMA(0, 1, At, B1); PG8_BAR;
            PG8_LDA(At, 0, 1); PG8_STAGE(PG8_SA(0, 0), a2, voffA);
            PG8_BAR; PG8_WAIT_L(0); PG8_MMA(1, 0, At, B0); PG8_BAR; PG8_SCHED;
            PG8_STAGE(PG8_SB(0, 1), b2 + hstep, voffB);
            PG8_WAIT_V(6); PG8_BAR; PG8_MMA(1, 1, At, B1); PG8_BAR;
            PG8_LDB(B0, 1, 0); PG8_SCHED; PG8_LDA(At, 1, 0); PG8_STAGE(PG8_SA(0, 1), a2 + hstep, voffA);
            PG8_WAIT_L(8); PG8_BAR; PG8_WAIT_L(0); PG8_MMA(0, 0, At, B0); PG8_BAR; PG8_SCHED;
            PG8_LDB(B1, 1, 1); PG8_STAGE(PG8_SB(1, 0), b3, voffB);
            PG8_BAR; PG8_WAIT_L(0); PG8_MMA(0, 1, At, B1); PG8_BAR;
            PG8_LDA(At, 1, 1); PG8_STAGE(PG8_SA(1, 0), a3, voffA);
            PG8_BAR; PG8_WAIT_L(0); PG8_MMA(1, 0, At, B0); PG8_BAR; PG8_SCHED;
            PG8_STAGE(PG8_SB(1, 1), b3 + hstep, voffB);
            PG8_WAIT_V(6); PG8_BAR; PG8_MMA(1, 1, At, B1); PG8_BAR;
            }
        }
        if constexpr (ALIGN_EPI) { if (wr == 0) PG8_BAR; }
        if constexpr (!Epi::AFTER_DRAIN) { E(acc, cur, wr, wc, fr, fq); S.done(cur); }
        if (!has_next) break;
#pragma unroll
        for (int a = 0; a < 2; ++a)
#pragma unroll
            for (int b = 0; b < 2; ++b)
#pragma unroll
                for (int m = 0; m < 4; ++m)
#pragma unroll
                    for (int n = 0; n < 2; ++n) acc[a][b][m][n] = (f32x4){0.f, 0.f, 0.f, 0.f};
        cur = nxt; cA = nA; cB = nB; ++ui;
        if constexpr (ALIGN_EPI) { if (wr == 1) PG8_BAR; }
    }
    PG8_WAIT_V(0);
    if constexpr (!ALIGN_EPI) { if (wr == 0) PG8_BAR; }
    PG8_BAR;
    if constexpr (Epi::AFTER_DRAIN) { E.fused(acc, cur, wr, wc, fr, fq, lds, wid, lane); S.done(cur); }
#undef PG8_SA
#undef PG8_SB
#undef PG8_STAGE
#undef PG8_LDA
#undef PG8_LDB
#undef PG8_MMA
#undef PG8_WAIT_V
#undef PG8_WAIT_L
#undef PG8_BAR
#undef PG8_SCHED
}
}
namespace xb {
#define LAS __attribute__((address_space(3)))
#define XB_TMO      128
#define XB_XCNT(j)  (256  + 64 * (j))
#define XB_XSUB(j)  (1280 + 64 * (j))
#define XB_XGEN(j)  (2304 + 64 * (j))
#define XB_TOP      3328
#define XB_TOPGEN   3392
#define XCD_BAR_WORDS 3456
#define XB_SPIN_CAP (1u << 18)

__device__ __forceinline__ unsigned xb_ld(unsigned* p)              { return __hip_atomic_load(p, __ATOMIC_RELAXED, __HIP_MEMORY_SCOPE_AGENT); }
__device__ __forceinline__ unsigned xb_add(unsigned* p, unsigned v) { return __hip_atomic_fetch_add(p, v, __ATOMIC_RELAXED, __HIP_MEMORY_SCOPE_AGENT); }
__device__ __forceinline__ unsigned xb_xcc_id() { return (unsigned)__builtin_amdgcn_s_getreg((3 << 11) | 20) & 0xFu; }
#define XB_SPIN(cond, bar) do { unsigned _sp = 0; while (cond) { __builtin_amdgcn_s_sleep(1); \
    if ((++_sp & 255u) == 0u) { if (xb_ld(&(bar)[XB_TMO])) break; if (_sp > XB_SPIN_CAP) { atomicAdd(&(bar)[XB_TMO], 1u); break; } } } } while (0)

struct XcdBarrier {
    unsigned* bar; unsigned x;
    volatile LAS unsigned* st;
};

__device__ __forceinline__ XcdBarrier xcd_barrier_post(unsigned* bar, volatile LAS unsigned* st) {
    XcdBarrier b; b.bar = bar; b.x = xb_xcc_id(); b.st = st;
    if (threadIdx.x == 0) (void)xb_add(&bar[XB_XCNT(b.x)], 1u);
    return b;
}
__device__ __forceinline__ void xcd_barrier_complete(unsigned* bar, unsigned x, unsigned& nloc, unsigned& nx) {
    const unsigned G = gridDim.x * gridDim.y * gridDim.z;
    unsigned sum, cnt, mine, sp = 0u;
    for (;;) {
        sum = 0u; cnt = 0u; mine = 0u;
#pragma unroll
        for (unsigned j = 0; j < 16; ++j) { const unsigned c = xb_ld(&bar[XB_XCNT(j)]); sum += c; cnt += (c > 0u) ? 1u : 0u; mine = (j == x) ? c : mine; }
        if (sum == G) break;
        __builtin_amdgcn_s_sleep(1);
        if ((++sp & 255u) == 0u) { if (xb_ld(&bar[XB_TMO])) break; if (sp > XB_SPIN_CAP) { atomicAdd(&bar[XB_TMO], 1u); break; } }
    }
    nloc = mine > 0u ? mine : 1u; nx = cnt > 0u ? cnt : 1u;
}

__device__ __forceinline__ void xcd_barrier(const XcdBarrier& b) {
    asm volatile("s_waitcnt vmcnt(0)" ::: "memory");
    __syncthreads();
    if (threadIdx.x == 0) {
        unsigned* bar = b.bar;
        __builtin_amdgcn_s_waitcnt(0);
        unsigned nloc = b.st[0], nx = b.st[1];
        if (nloc == 0u) { xcd_barrier_complete(bar, b.x, nloc, nx); b.st[0] = nloc; b.st[1] = nx; }
        const unsigned old = xb_add(&bar[XB_XSUB(b.x)], 1u);
        const unsigned gen = old / nloc;
        if (old + 1u == (gen + 1u) * nloc) {
            __builtin_amdgcn_fence(__ATOMIC_RELEASE, "agent");
            asm volatile("s_waitcnt vmcnt(0)" ::: "memory");
            const unsigned og = xb_add(&bar[XB_TOP], 1u);
            const unsigned tg = og / nx;
            if (og + 1u == (tg + 1u) * nx) xb_add(&bar[XB_TOPGEN], 1u);
            else XB_SPIN(xb_ld(&bar[XB_TOPGEN]) == tg, bar);
            __builtin_amdgcn_fence(__ATOMIC_ACQUIRE, "agent");
            xb_add(&bar[XB_XGEN(b.x)], 1u);
            asm volatile("s_waitcnt vmcnt(0)" ::: "memory");
        } else {
            XB_SPIN(xb_ld(&bar[XB_XGEN(b.x)]) == gen, bar);
            __builtin_amdgcn_fence(__ATOMIC_ACQUIRE, "agent");
            asm volatile("s_waitcnt vmcnt(0)" ::: "memory");
        }
    }
    __syncthreads();
}
#undef LAS
}
namespace fk {
using pg8::bf16_t; using pg8::bf16x8; using pg8::f32x4; using pg8::u32x4; using pg8::Unit; using pg8::cvt_pk_bf16; using pg8::f32x2;
typedef unsigned u32x2 __attribute__((ext_vector_type(2)));
constexpr int NTOK = 65536, DM = 1024, FF = 2816, NUP = 5632, HALF_TOK = 32768;
constexpr size_t MiB = (size_t)1 << 20;
constexpr size_t WS_LAM = 0, WS_BAR = 4096, WS_SS = 1 * MiB, WS_LNS = 3 * MiB, WS_COS = 4 * MiB, WS_SIN = 6 * MiB, WS_WSP = 8 * MiB;
constexpr size_t WS_WQKV = 10 * MiB, WS_WO = 16 * MiB, WS_WUV = 18 * MiB, WS_WOUT = 22 * MiB, WS_WUP = 24 * MiB, WS_WDN = 46 * MiB, WS_WG = 57 * MiB, WS_WP = 61 * MiB;
constexpr size_t WS_PB = 64 * MiB, WS_XB = 128 * MiB, WS_R1 = 256 * MiB, WS_R2 = 384 * MiB, WS_G = 256 * MiB, WS_HALO = 432 * MiB;
constexpr float EPS = 1e-6f;

struct Params {
  const float* in[27];
  const float* xin_a; const float* xin_b;
  float* out; unsigned char* ws;
  int ph_lo, ph_hi;
};

__device__ __forceinline__ float rstd_of(float ss) { return 1.0f / sqrtf(ss * (1.0f / 1024.0f) + EPS); }
__device__ __forceinline__ float bf2f(unsigned short b) { return __uint_as_float((unsigned)b << 16); }
__device__ __forceinline__ float sigmoidf_(float x) { return __builtin_amdgcn_rcpf(1.0f + __builtin_amdgcn_exp2f(-1.4426950408889634f * x)); }
__device__ __forceinline__ u32x4 pack8(const f32x4 a, const f32x4 b) { u32x4 w; w.x = cvt_pk_bf16(a[0], a[1]); w.y = cvt_pk_bf16(a[2], a[3]); w.z = cvt_pk_bf16(b[0], b[1]); w.w = cvt_pk_bf16(b[2], b[3]); return w; }
__device__ __forceinline__ void unpack8(const u32x4 w, f32x4& a, f32x4& b) {
  a[0] = __uint_as_float(w.x << 16); a[1] = __uint_as_float(w.x & 0xffff0000u); a[2] = __uint_as_float(w.y << 16); a[3] = __uint_as_float(w.y & 0xffff0000u);
  b[0] = __uint_as_float(w.z << 16); b[1] = __uint_as_float(w.z & 0xffff0000u); b[2] = __uint_as_float(w.w << 16); b[3] = __uint_as_float(w.w & 0xffff0000u); }

__device__ __forceinline__ float sum_fq(float v) {
  auto a = __builtin_amdgcn_permlane16_swap(__float_as_uint(v), __float_as_uint(v), false, false); v = __uint_as_float(a[0]) + __uint_as_float(a[1]);
  auto b = __builtin_amdgcn_permlane32_swap(__float_as_uint(v), __float_as_uint(v), false, false); return __uint_as_float(b[0]) + __uint_as_float(b[1]); }
#define ACC_T const f32x4 (&acc)[2][2][4][2]
__device__ __forceinline__ int opaque_lane() { int l; asm volatile("v_mbcnt_lo_u32_b32 %0, -1, 0\n\tv_mbcnt_hi_u32_b32 %0, -1, %0" : "=v"(l)); return l; }
#define OPAQUE_LANE() const int ol_ = opaque_lane(); const int fr = ol_ & 15, fq = ol_ >> 4;

struct EpiQKV {
  static constexpr bool PERM = true, AFTER_DRAIN = false;
  bf16_t *Q, *KV; const float* ss; const float* cs; const float* sn;
  __device__ __forceinline__ void operator()(ACC_T, const Unit& u, int wr, int wc, int fr_, int fq_) const { OPAQUE_LANE()
    const int sect = u.pn >> 2; bf16_t* base = KV + (size_t)(sect > 0 ? sect - 1 : 0) * NTOK * DM; if (sect == 0) base = Q;
#pragma unroll
    for (int ai = 0; ai < 2; ++ai)
#pragma unroll
      for (int m = 0; m < 4; ++m) {
        const int row = u.pm * 256 + ai * 128 + wr * 64 + m * 16 + fr; const float rs = rstd_of(ss[row]) * (sect == 0 ? 0.18033688011112042f : 1.0f);
        bf16_t* rowp = base + (size_t)row * DM;
        if (sect < 2) {
          const int pos = row < HALF_TOK ? (row & 16383) : (row & 2047);
          const int col = ((u.pn & 3) * 4 + wc) * 64 + 8 * fq;
          u32x4 w1, w2;
          { const f32x4 c0 = *(const f32x4*)(cs + pos * 32 + 8 * fq), s0 = *(const f32x4*)(sn + pos * 32 + 8 * fq);
            const f32x4 x1 = acc[ai][0][m][0] * rs, x2 = acc[ai][1][m][0] * rs; const f32x4 o1 = x1 * c0 - x2 * s0, o2 = x2 * c0 + x1 * s0;
            w1.x = cvt_pk_bf16(o1[0], o1[1]); w1.y = cvt_pk_bf16(o1[2], o1[3]); w2.x = cvt_pk_bf16(o2[0], o2[1]); w2.y = cvt_pk_bf16(o2[2], o2[3]); }
          asm volatile("" ::: "memory");
          { const f32x4 c1 = *(const f32x4*)(cs + pos * 32 + 8 * fq + 4), s1 = *(const f32x4*)(sn + pos * 32 + 8 * fq + 4);
            const f32x4 x1 = acc[ai][0][m][1] * rs, x2 = acc[ai][1][m][1] * rs; const f32x4 o1 = x1 * c1 - x2 * s1, o2 = x2 * c1 + x1 * s1;
            w1.z = cvt_pk_bf16(o1[0], o1[1]); w1.w = cvt_pk_bf16(o1[2], o1[3]); w2.z = cvt_pk_bf16(o2[0], o2[1]); w2.w = cvt_pk_bf16(o2[2], o2[3]); }
          *(u32x4*)(rowp + col) = w1; *(u32x4*)(rowp + col + 32) = w2;
          asm volatile("" ::: "memory");
        } else {
#pragma unroll
          for (int bj = 0; bj < 2; ++bj) { const int col = (u.pn & 3) * 256 + bj * 128 + wc * 32 + 8 * fq;
            *(u32x4*)(rowp + col) = pack8(acc[ai][bj][m][0] * rs, acc[ai][bj][m][1] * rs); }
          asm volatile("" ::: "memory");
        }
      }
  }
};

template <bool GATE> struct EpiRes {
  static constexpr bool PERM = true, AFTER_DRAIN = false;
  const float* xa; const float* xb_src;
  float* xout; bf16_t* xbo; float* ssn; const float* ss; const bf16_t* pp; int rowoff;
  __device__ __forceinline__ void operator()(ACC_T, const Unit& u, int wr, int wc, int fr_, int fq_) const { OPAQUE_LANE()
    const int colb = u.pn * 256 + wc * 32 + 8 * fq; const int rowb = rowoff + u.pm * 256 + wr * 64 + fr;
    f32x4 cx[4], nx[4]; u32x4 cp[2], np[2]; float crs = 1.f, nrs = 1.f;
#define RES_LOAD(X, PPV, RS, idx) do { const int row_ = rowb + ((idx) >> 2) * 128 + ((idx) & 3) * 16; \
      const float* xr_ = GATE ? (const float*)xout + (size_t)row_ * DM : (row_ < HALF_TOK ? xa + (size_t)row_ * DM : xb_src + (size_t)(row_ - HALF_TOK) * DM); \
      X[0] = *(const f32x4*)(xr_ + colb); X[1] = *(const f32x4*)(xr_ + colb + 4); X[2] = *(const f32x4*)(xr_ + colb + 128); X[3] = *(const f32x4*)(xr_ + colb + 132); \
      if (GATE) { PPV[0] = *(const u32x4*)(pp + (size_t)row_ * DM + colb); PPV[1] = *(const u32x4*)(pp + (size_t)row_ * DM + colb + 128); RS = rstd_of(ss[row_]); } } while (0)
    RES_LOAD(cx, cp, crs, 0);
#pragma unroll
    for (int idx = 0; idx < 8; ++idx) {
      const int ai = idx >> 2, m = idx & 3; const int row = rowb + ai * 128 + m * 16;
      if (idx < 7) RES_LOAD(nx, np, nrs, idx + 1);
      float sq = 0.f;
#pragma unroll
      for (int bj = 0; bj < 2; ++bj) { const int col = colb + bj * 128;
        f32x4 d0 = acc[ai][bj][m][0], d1 = acc[ai][bj][m][1];
        if (GATE) { f32x4 p0, p1; unpack8(cp[bj], p0, p1);
#pragma unroll
          for (int j = 0; j < 4; ++j) { d0[j] = sigmoidf_(d0[j] * crs) * p0[j]; d1[j] = sigmoidf_(d1[j] * crs) * p1[j]; } }
        const f32x4 v0 = cx[2 * bj] + d0, v1 = cx[2 * bj + 1] + d1;
        *(f32x4*)(xout + (size_t)row * DM + col) = v0; *(f32x4*)(xout + (size_t)row * DM + col + 4) = v1;
        *(u32x4*)(xbo + (size_t)row * DM + col) = pack8(v0, v1);
        sq += (v0[0] * v0[0] + v0[1] * v0[1]) + (v0[2] * v0[2] + v0[3] * v0[3]) + (v1[0] * v1[0] + v1[1] * v1[1]) + (v1[2] * v1[2] + v1[3] * v1[3]); }
      sq = sum_fq(sq);
      if (fq == 0) atomicAdd(ssn + row, sq);
      asm volatile("" ::: "memory");
#pragma unroll
      for (int t = 0; t < 4; ++t) cx[t] = nx[t];
      cp[0] = np[0]; cp[1] = np[1]; crs = nrs;
    }
#undef RES_LOAD
  }
};

struct EpiStore {
  static constexpr bool PERM = true, AFTER_DRAIN = false;
  bf16_t* O;
  __device__ __forceinline__ void operator()(ACC_T, const Unit& u, int wr, int wc, int fr_, int fq_) const { OPAQUE_LANE()
#pragma unroll
    for (int ai = 0; ai < 2; ++ai)
#pragma unroll
      for (int m = 0; m < 4; ++m) { const int row = u.pm * 256 + ai * 128 + wr * 64 + m * 16 + fr;
#pragma unroll
        for (int bj = 0; bj < 2; ++bj) { const int col = u.pn * 256 + bj * 128 + wc * 32 + 8 * fq;
          *(u32x4*)(O + (size_t)row * DM + col) = pack8(acc[ai][bj][m][0], acc[ai][bj][m][1]); } asm volatile("" ::: "memory"); }
  }
};

struct EpiUV {
  static constexpr bool PERM = true, AFTER_DRAIN = false;
  bf16_t *U, *Vs; const float* ss; float* lns;
  __device__ __forceinline__ void operator()(ACC_T, const Unit& u, int wr, int wc, int fr_, int fq_) const { OPAQUE_LANE()
    const bool isv = u.pn >= 4; bf16_t* base = isv ? Vs : U;
#pragma unroll
    for (int ai = 0; ai < 2; ++ai)
#pragma unroll
      for (int m = 0; m < 4; ++m) { const int row = u.pm * 256 + ai * 128 + wr * 64 + m * 16 + fr; const float rs = rstd_of(ss[row]);
        float s1 = 0.f, s2 = 0.f;
#pragma unroll
        for (int bj = 0; bj < 2; ++bj) { const int col = (u.pn & 3) * 256 + bj * 128 + wc * 32 + 8 * fq;
          const f32x4 v0 = acc[ai][bj][m][0] * rs, v1 = acc[ai][bj][m][1] * rs;
          const f32x2 a = pg8::gelu_pk((f32x2){v0[0], v0[1]}), b = pg8::gelu_pk((f32x2){v0[2], v0[3]}), c = pg8::gelu_pk((f32x2){v1[0], v1[1]}), d = pg8::gelu_pk((f32x2){v1[2], v1[3]});
          s1 += (a.x + a.y) + (b.x + b.y) + (c.x + c.y) + (d.x + d.y);
          s2 += (a.x * a.x + a.y * a.y) + (b.x * b.x + b.y * b.y) + (c.x * c.x + c.y * c.y) + (d.x * d.x + d.y * d.y);
          u32x4 w; w.x = cvt_pk_bf16(a.x, a.y); w.y = cvt_pk_bf16(b.x, b.y); w.z = cvt_pk_bf16(c.x, c.y); w.w = cvt_pk_bf16(d.x, d.y);
          *(u32x4*)(base + (size_t)row * DM + col) = w; asm volatile("" ::: "memory"); }
        if (isv) { s1 = sum_fq(s1); s2 = sum_fq(s2);
          if (fq == 0) { atomicAdd(lns + row, s1); atomicAdd(lns + NTOK + row, s2); } }
        asm volatile("" ::: "memory");
      }
  }
};

struct EpiUp {
  static constexpr bool PERM = true, AFTER_DRAIN = false;
  bf16_t* G; float* HAL; const float* ss; const float* cw; const float* cb; int rowoff;
  __device__ __forceinline__ void operator()(ACC_T, const Unit& u, int wr, int wc, int fr_, int fq_) const { OPAQUE_LANE()
    const int lane = fq * 16 + fr; const int prevl = (lane & 48) | ((fr - 1) & 15), nextl = (lane & 48) | ((fr + 1) & 15);
#pragma unroll
    for (int ai = 0; ai < 2; ++ai) {
      const int R0 = u.pm * 256 + ai * 128 + wr * 64; const int blk = R0 >> 6;
      float rs[4];
#pragma unroll
      for (int m = 0; m < 4; ++m) rs[m] = rstd_of(ss[rowoff + R0 + 16 * m + fr]);
#pragma unroll
      for (int n = 0; n < 2; ++n) {
        const int cv = u.pn * 128 + wc * 32 + 8 * fq + 4 * n;
        const f32x4 wv0 = *(const f32x4*)(cw + cv), wv1 = *(const f32x4*)(cw + NUP + cv), wv2 = *(const f32x4*)(cw + 2 * NUP + cv), bv = *(const f32x4*)(cb + cv);
        const f32x4 wg0 = *(const f32x4*)(cw + FF + cv), wg1 = *(const f32x4*)(cw + NUP + FF + cv), wg2 = *(const f32x4*)(cw + 2 * NUP + FF + cv), bg = *(const f32x4*)(cb + FF + cv);
        f32x4 av[4], ag[4];
#pragma unroll
        for (int m = 0; m < 4; ++m) { av[m] = acc[ai][0][m][n] * rs[m]; ag[m] = acc[ai][1][m][n] * rs[m]; }
#pragma unroll
        for (int m = 0; m < 4; ++m) {
          f32x4 pv, pg, nv, ng;
#pragma unroll
          for (int j = 0; j < 4; ++j) {
            const float sv = (fr == 15) ? (m > 0 ? av[m > 0 ? m - 1 : 0][j] : 0.f) : av[m][j];
            const float sg = (fr == 15) ? (m > 0 ? ag[m > 0 ? m - 1 : 0][j] : 0.f) : ag[m][j];
            pv[j] = __shfl(sv, prevl); pg[j] = __shfl(sg, prevl);
            const float tv = (fr == 0) ? (m < 3 ? av[m < 3 ? m + 1 : 3][j] : 0.f) : av[m][j];
            const float tg = (fr == 0) ? (m < 3 ? ag[m < 3 ? m + 1 : 3][j] : 0.f) : ag[m][j];
            nv[j] = __shfl(tv, nextl); ng[j] = __shfl(tg, nextl);
          }
          const f32x4 c_v = bv + wv0 * pv + wv1 * av[m] + wv2 * nv, c_g = bg + wg0 * pg + wg1 * ag[m] + wg2 * ng;
          const bool first = (m == 0 && fr == 0), last = (m == 3 && fr == 15);
          if (first) { float* h = HAL + (size_t)(blk * 4) * NUP; *(f32x4*)(h + cv) = av[m]; *(f32x4*)(h + FF + cv) = ag[m]; *(f32x4*)(h + 2 * NUP + cv) = c_v; *(f32x4*)(h + 2 * NUP + FF + cv) = c_g; }
          else if (last) { float* h = HAL + (size_t)(blk * 4) * NUP; *(f32x4*)(h + NUP + cv) = av[m]; *(f32x4*)(h + NUP + FF + cv) = ag[m]; *(f32x4*)(h + 3 * NUP + cv) = c_v; *(f32x4*)(h + 3 * NUP + FF + cv) = c_g; }
          else { u32x2 w; w.x = cvt_pk_bf16(c_g[0] * sigmoidf_(c_g[0]) * c_v[0], c_g[1] * sigmoidf_(c_g[1]) * c_v[1]); w.y = cvt_pk_bf16(c_g[2] * sigmoidf_(c_g[2]) * c_v[2], c_g[3] * sigmoidf_(c_g[3]) * c_v[3]);
            *(u32x2*)(G + (size_t)(R0 + 16 * m + fr) * FF + cv) = w; }
          asm volatile("" ::: "memory");
        }
      }
    }
  }
};
#undef ACC_T
}
namespace at {
using bf16x8 = __attribute__((ext_vector_type(8))) short;
using s16x4 = __attribute__((ext_vector_type(4))) short;
using f32x16 = __attribute__((ext_vector_type(16))) float;
using u32x4 = __attribute__((ext_vector_type(4))) unsigned;
typedef unsigned short bf16_t;
constexpr int D = 128, NW = 8, QBLK = 32, KVBLK = 64, LD = 1024;
constexpr float THR = 11.5f;
constexpr size_t SHM_V = KVBLK * D * 2, SHM_K = KVBLK * D * 2;
constexpr size_t NSLOT = 3, OFF_K = NSLOT * SHM_V, OFF_WS = NSLOT * (SHM_V + SHM_K), OFF_X = 0, ATT_LDS = OFF_WS + NW * 64 * 4;
#define KSWZ(row, colB) ((row) * 256 + ((colB) ^ (((row) & 7) << 4)))
#define SBAR() __builtin_amdgcn_sched_barrier(0)
__device__ __forceinline__ int crow(int r, int hi) { return (r & 3) + 8 * (r >> 2) + 4 * hi; }
__device__ __forceinline__ unsigned cvtpk(float lo, float hi) { unsigned r; asm volatile("v_cvt_pk_bf16_f32 %0, %1, %2" : "=v"(r) : "v"(lo), "v"(hi)); return r; }
template <bool FAST> __device__ __forceinline__ void partialSM(f32x16& p0, f32x16& p1, float& m_reg, float& mn, float& alpha) {
  if constexpr (FAST) {
#pragma unroll
    for (int r = 0; r < 16; ++r) p0[r] = __builtin_amdgcn_exp2f(p0[r]);
    alpha = 1.f; mn = 0.f;
  } else {
  float pmax = p0[0];
#pragma unroll
  for (int r = 1; r < 16; ++r) pmax = fmaxf(pmax, p0[r]);
#pragma unroll
  for (int r = 0; r < 16; ++r) pmax = fmaxf(pmax, p1[r]);
  { auto rr = __builtin_amdgcn_permlane32_swap(__float_as_uint(pmax), __float_as_uint(pmax), false, false);
    pmax = fmaxf(__uint_as_float(rr[0]), __uint_as_float(rr[1])); }
  if (__builtin_expect(__all(pmax - m_reg <= THR), 1)) { mn = m_reg; alpha = 1.f; }
  else { mn = fmaxf(m_reg, pmax); alpha = __builtin_amdgcn_exp2f(m_reg - mn); m_reg = mn; }
#pragma unroll
  for (int r = 0; r < 16; ++r) p0[r] = p0[r] - mn;
#pragma unroll
  for (int r = 0; r < 16; ++r) p1[r] = p1[r] - mn;
#pragma unroll
  for (int r = 0; r < 16; ++r) p0[r] = __builtin_amdgcn_exp2f(p0[r]);
  }
}
__device__ __forceinline__ void finishSM(f32x16& p0, f32x16& p1, float alpha, float& l_reg, bf16x8& pa0, bf16x8& pa1, bf16x8& pa2, bf16x8& pa3) {
#pragma unroll
  for (int r = 0; r < 16; ++r) p1[r] = __builtin_amdgcn_exp2f(p1[r]);
  typedef float f32x2_ __attribute__((ext_vector_type(2)));
  f32x2_ s2 = (f32x2_){p0[0], p0[1]} + (f32x2_){p1[0], p1[1]};
#pragma unroll
  for (int r = 2; r < 16; r += 2) { s2 += (f32x2_){p0[r], p0[r + 1]}; s2 += (f32x2_){p1[r], p1[r + 1]}; }
  float ps = s2[0] + s2[1];
  { auto rr = __builtin_amdgcn_permlane32_swap(__float_as_uint(ps), __float_as_uint(ps), false, false);
    ps = __uint_as_float(rr[0]) + __uint_as_float(rr[1]); }
  l_reg = l_reg * alpha + ps;
#define PK4(P, BASE, OUT) do { unsigned a0 = cvtpk(P[BASE + 0], P[BASE + 1]), a1 = cvtpk(P[BASE + 2], P[BASE + 3]);   \
    unsigned b0 = cvtpk(P[BASE + 4], P[BASE + 5]), b1 = cvtpk(P[BASE + 6], P[BASE + 7]);                              \
    auto r0 = __builtin_amdgcn_permlane32_swap(a0, b0, false, false); auto r1 = __builtin_amdgcn_permlane32_swap(a1, b1, false, false); \
    u32x4 w = {r0[0], r1[0], r0[1], r1[1]}; OUT = *reinterpret_cast<bf16x8*>(&w); } while (0)
  PK4(p0, 0, pa0); PK4(p0, 8, pa1); PK4(p1, 0, pa2); PK4(p1, 8, pa3);
#undef PK4
}
__device__ __forceinline__ void qkt(f32x16& p0, f32x16& p1, const char* Ks, const bf16x8* qr, int r32, int hi, int ms) {
  p0 = f32x16{}; p1 = f32x16{};
#pragma unroll
  for (int d0 = 0; d0 < 4; ++d0) { int cb = (ms * 64 + d0 * 16 + hi * 8) * 2;
    bf16x8 b0 = *reinterpret_cast<const bf16x8*>(Ks + KSWZ(r32, cb));
    bf16x8 b1 = *reinterpret_cast<const bf16x8*>(Ks + KSWZ(32 + r32, cb));
    p0 = __builtin_amdgcn_mfma_f32_32x32x16_bf16(b0, qr[d0], p0, 0, 0, 0);
    p1 = __builtin_amdgcn_mfma_f32_32x32x16_bf16(b1, qr[d0], p1, 0, 0, 0); }
}
__device__ __forceinline__ int v_st(int k, int c) { const int kk = (k & ~0xC) | ((k & 4) << 1) | ((k & 8) >> 1); return ((kk >> 3) * 4 + (c >> 5)) * 512 + ((kk & 7) * 32 + (c & 31)) * 2; }
__device__ __forceinline__ int v_rd_base(int lane) { return ((lane & 3) << 3) | (((lane >> 2) & 3) << 6) | (((lane >> 4) & 1) << 5) | (((lane >> 5) & 1) << 8); }
constexpr int v_rd_off(int d0, int ks, int half) { return d0 * 512 + ks * 4096 + half * 2048; }
typedef short v4i16_t __attribute__((ext_vector_type(4)));
typedef const __attribute__((address_space(3))) char* lds_cptr;
template <int OFF> __device__ __forceinline__ s16x4 tr_read(lds_cptr vb) {
  return __builtin_bit_cast(s16x4, __builtin_amdgcn_ds_read_tr16_b64_v4i16((__attribute__((address_space(3))) v4i16_t*)(vb + OFF)));
}
template <int D0> __device__ __forceinline__ void pv_one(f32x16& od, lds_cptr vb, bf16x8 pa0, bf16x8 pa1, bf16x8 pa2, bf16x8 pa3) {
  const s16x4 l0 = tr_read<v_rd_off(D0, 0, 0)>(vb), h0 = tr_read<v_rd_off(D0, 0, 1)>(vb), l1 = tr_read<v_rd_off(D0, 1, 0)>(vb), h1 = tr_read<v_rd_off(D0, 1, 1)>(vb);
  const s16x4 l2 = tr_read<v_rd_off(D0, 2, 0)>(vb), h2 = tr_read<v_rd_off(D0, 2, 1)>(vb), l3 = tr_read<v_rd_off(D0, 3, 0)>(vb), h3 = tr_read<v_rd_off(D0, 3, 1)>(vb);
#define PK(L, H) (bf16x8){L[0], L[1], L[2], L[3], H[0], H[1], H[2], H[3]}
  od = __builtin_amdgcn_mfma_f32_32x32x16_bf16(pa0, PK(l0, h0), od, 0, 0, 0);
  od = __builtin_amdgcn_mfma_f32_32x32x16_bf16(pa1, PK(l1, h1), od, 0, 0, 0);
  od = __builtin_amdgcn_mfma_f32_32x32x16_bf16(pa2, PK(l2, h2), od, 0, 0, 0);
  od = __builtin_amdgcn_mfma_f32_32x32x16_bf16(pa3, PK(l3, h3), od, 0, 0, 0);
#undef PK
}
__device__ __forceinline__ void pv_d0(f32x16* o, lds_cptr vb, bf16x8 pa0, bf16x8 pa1, bf16x8 pa2, bf16x8 pa3) {
  pv_one<0>(o[0], vb, pa0, pa1, pa2, pa3); pv_one<1>(o[1], vb, pa0, pa1, pa2, pa3); pv_one<2>(o[2], vb, pa0, pa1, pa2, pa3); pv_one<3>(o[3], vb, pa0, pa1, pa2, pa3);
}
template <bool FAST> __device__ __forceinline__ bool diff_unit(const bf16_t* __restrict__ Q, const bf16_t* __restrict__ K, const bf16_t* __restrict__ V, bf16_t* __restrict__ AO,
                                          long tq0, long tk0, int seq, int h, float lam, const float* __restrict__ subg, char* lds) {
  int tid_ = threadIdx.x; asm volatile("" : "+v"(tid_)); const int tid = tid_, wid = tid >> 6, lane = tid & 63, r32 = lane & 31, hi = lane >> 5, pr = wid & 3, ms = wid >> 2;
  char* V_lds = lds; char* K_lds = lds + OFF_K;
  float* wsf = (float*)(lds + OFF_WS) + wid * 64; float* li_l = wsf; float* al_l = wsf + 32;
  float* X = (float*)(lds + OFF_X) + pr * (32 * 128);
  float m_reg = -1e30f, l_reg = 0; f32x16 o[4] = {}; bf16x8 qr[4];
  const bf16_t* Qw = Q + (tq0 + pr * QBLK + r32) * LD + (2 * h + ms) * 64 + hi * 8;
#pragma unroll
  for (int d0 = 0; d0 < 4; ++d0) qr[d0] = *reinterpret_cast<const bf16x8*>(Qw + d0 * 16);
  const bf16_t* Kh = K + tk0 * LD + h * 128; const bf16_t* Vh = V + tk0 * LD + h * 128;
  const int sr = tid >> 4, sc = (tid & 15) * 8, vst0 = v_st(sr, sc), vst1 = v_st(32 + sr, sc);
  const lds_cptr vb0 = (lds_cptr)V_lds + v_rd_base(lane);
  struct { bf16x8 vs0, vs1, ks0, ks1; } sr_[2];
#define SLOAD(i, k0) do { sr_[i].vs0 = *(const bf16x8*)(&Vh[(long)((k0) + sr) * LD + sc]); sr_[i].vs1 = *(const bf16x8*)(&Vh[(long)((k0) + 32 + sr) * LD + sc]); \
    sr_[i].ks0 = *(const bf16x8*)(&Kh[(long)((k0) + sr) * LD + sc]); sr_[i].ks1 = *(const bf16x8*)(&Kh[(long)((k0) + 32 + sr) * LD + sc]); } while (0)
#define SWRITE(off, i) do { *(bf16x8*)(V_lds + (off) + vst0) = sr_[i].vs0;          \
    *(bf16x8*)(V_lds + (off) + vst1) = sr_[i].vs1; int kc = sc * 2;               \
    *(bf16x8*)(K_lds + (off) + KSWZ(sr, kc)) = sr_[i].ks0;                       \
    *(bf16x8*)(K_lds + (off) + KSWZ(32 + sr, kc)) = sr_[i].ks1; } while (0)
#define SWAIT() asm volatile("s_waitcnt vmcnt(4)" ::: "memory")
#define RESC(a) do { if (!FAST) if (__any((a) < 1.f)) { if (hi == 0) al_l[r32] = (a); asm volatile("s_waitcnt lgkmcnt(0)" ::: "memory"); \
    _Pragma("unroll") for (int d = 0; d < 4; ++d) _Pragma("unroll") for (int r = 0; r < 16; ++r) o[d][r] *= al_l[crow(r, hi)]; } } while (0)
  f32x16 pA0, pA1, pB0, pB1; float mnA, mnB, alA, alB; bf16x8 pa0, pa1, pa2, pa3; const int NT = seq / KVBLK;
  constexpr int SE = 0, SO = 1;
  int s0 = 0, s1 = (int)SHM_V, s2 = 2 * (int)SHM_V;
  SLOAD(SE, 0); asm volatile("s_waitcnt vmcnt(0)" ::: "memory"); SWRITE(0, SE); __syncthreads();
  qkt(pA0, pA1, K_lds, qr, r32, hi, ms); partialSM<FAST>(pA0, pA1, m_reg, mnA, alA); RESC(alA);
  SLOAD(SO, KVBLK); if (2 < NT) SLOAD(SE, 2 * KVBLK);
  SWAIT(); SWRITE(s1, SO); __syncthreads();
  for (int j = 1; j + 1 < NT; j += 2) {
    SBAR(); qkt(pB0, pB1, K_lds + s1, qr, r32, hi, ms);
    finishSM(pA0, pA1, alA, l_reg, pa0, pa1, pa2, pa3); SBAR();
    SLOAD(SO, (j + 2) * KVBLK); SBAR();
    SWAIT(); SWRITE(s2, SE);
    pv_d0(o, vb0 + s0, pa0, pa1, pa2, pa3); partialSM<FAST>(pB0, pB1, m_reg, mnB, alB); RESC(alB);
    __syncthreads();
    SBAR(); qkt(pA0, pA1, K_lds + s2, qr, r32, hi, ms);
    finishSM(pB0, pB1, alB, l_reg, pa0, pa1, pa2, pa3); SBAR();
    if (j + 3 < NT) SLOAD(SE, (j + 3) * KVBLK); SBAR();
    SWAIT(); SWRITE(s0, SO);
    pv_d0(o, vb0 + s1, pa0, pa1, pa2, pa3); partialSM<FAST>(pA0, pA1, m_reg, mnA, alA); RESC(alA);
    __syncthreads();
    { const int t = s0; s0 = s2; s2 = s1; s1 = t; }
  }
  SBAR(); qkt(pB0, pB1, K_lds + s1, qr, r32, hi, ms);
  finishSM(pA0, pA1, alA, l_reg, pa0, pa1, pa2, pa3); SBAR();
  pv_d0(o, vb0 + s0, pa0, pa1, pa2, pa3); partialSM<FAST>(pB0, pB1, m_reg, mnB, alB); RESC(alB);
  finishSM(pB0, pB1, alB, l_reg, pa0, pa1, pa2, pa3); SBAR();
  pv_d0(o, vb0 + s1, pa0, pa1, pa2, pa3);
  __syncthreads();
  if constexpr (FAST) { const int bad = !(l_reg > 1e-30f && l_reg < 1e30f); if (__syncthreads_or(bad)) return true; }
  if (hi == 0) li_l[r32] = l_reg; asm volatile("s_waitcnt lgkmcnt(0)" ::: "memory");
  float rli[16];
#pragma unroll
  for (int r = 0; r < 16; ++r) rli[r] = __builtin_amdgcn_rcpf(li_l[crow(r, hi)]);
  if (ms == 1) {
#pragma unroll
    for (int r = 0; r < 16; ++r)
#pragma unroll
      for (int d0 = 0; d0 < 4; ++d0) X[crow(r, hi) * 128 + d0 * 32 + r32] = o[d0][r] * rli[r];
  }
  __syncthreads();
  if (ms == 0) {
    float sg[4];
#pragma unroll
    for (int d0 = 0; d0 < 4; ++d0) sg[d0] = subg[d0 * 32 + r32] * 0.8f;
#pragma unroll
    for (int r = 0; r < 16; ++r) {
      float v[4]; float sq = 0.f;
#pragma unroll
      for (int d0 = 0; d0 < 4; ++d0) { v[d0] = o[d0][r] * rli[r] - lam * X[crow(r, hi) * 128 + d0 * 32 + r32]; sq += v[d0] * v[d0]; }
      sq += __shfl_xor(sq, 1); sq += __shfl_xor(sq, 2); sq += __shfl_xor(sq, 4); sq += __shfl_xor(sq, 8); sq += __shfl_xor(sq, 16);
      const float rs = 1.0f / sqrtf(sq * (1.0f / 128.0f) + 1e-6f);
      bf16_t* orow = AO + (tq0 + pr * QBLK + crow(r, hi)) * LD + h * 128 + r32;
#pragma unroll
      for (int d0 = 0; d0 < 4; ++d0) orow[d0 * 32] = (bf16_t)(cvtpk(v[d0] * rs * sg[d0], 0.f) & 0xffffu);
    }
  }
  __syncthreads();
  return false;
#undef SLOAD
#undef SWRITE
#undef SWAIT
#undef RESC
}
#undef KSWZ
#undef SBAR
}
namespace fk {
#define LAS3 __attribute__((address_space(3)))
constexpr int NWAVES = 8, NTHR = 512;
constexpr int LDS_BYTES = 147456;
constexpr int NPH = 22;

__device__ __forceinline__ int otid() { int t = threadIdx.x; asm volatile("" : "+v"(t)); return t; }
__device__ __forceinline__ float wave_sum(float v) {
#pragma unroll
  for (int o = 1; o < 64; o <<= 1) v += __shfl_xor(v, o);
  return v;
}
__device__ __forceinline__ unsigned f2bf(float f) { unsigned u = __builtin_bit_cast(unsigned, f); return (u + 0x7fffu + ((u >> 16) & 1u)) >> 16; }
__device__ __forceinline__ unsigned pk2(float lo, float hi) { return f2bf(lo) | (f2bf(hi) << 16); }

__device__ __forceinline__ int srcblk(int mode, int n0) {
  if (mode == 1) { const int pn = n0 >> 8; if (pn >= 8) return n0; const int bj = (n0 >> 7) & 1, wc = (n0 >> 5) & 3; return pn * 256 + wc * 64 + bj * 32; }
  if (mode == 2) { const int pn = n0 >> 8, bj = (n0 >> 7) & 1, i = n0 & 127; return bj * FF + pn * 128 + i; }
  return n0;
}
__device__ __forceinline__ void transpose_item(const float* __restrict__ W, int K, int N, const float* __restrict__ gk, int mode, bf16_t* __restrict__ WT, float* scr, int item, int lane) {
  const int nblk = N / 32, kb = item / nblk, nb = item % nblk, k0 = 64 * kb, n0 = 32 * nb, s0 = srcblk(mode, n0);
#pragma unroll 8
  for (int i = 0; i < 32; ++i) { const int kk = 2 * i + (lane >> 5); float w = W[(size_t)(k0 + kk) * N + s0 + (lane & 31)]; if (gk) w *= gk[k0 + kk]; scr[kk * 33 + (lane & 31)] = w; }
  asm volatile("s_waitcnt lgkmcnt(0)" ::: "memory");
  const int c = lane & 7;
#pragma unroll
  for (int j = 0; j < 4; ++j) { const int n = (lane >> 3) + 8 * j; const float* s = scr + (8 * c) * 33 + n;
    u32x4 o; o.x = pk2(s[0 * 33], s[1 * 33]); o.y = pk2(s[2 * 33], s[3 * 33]); o.z = pk2(s[4 * 33], s[5 * 33]); o.w = pk2(s[6 * 33], s[7 * 33]);
    *(u32x4*)(WT + (size_t)(n0 + n) * K + k0 + 8 * c) = o; }
  asm volatile("s_waitcnt lgkmcnt(0)" ::: "memory");
}
__device__ __forceinline__ void row_to_bf16_ss(const float* xrow, bf16_t* orow, float* ssp, int lane) {
  const f32x4* xr = (const f32x4*)xrow + lane; f32x4 v[4]; float s = 0.f;
#pragma unroll
  for (int j = 0; j < 4; ++j) { v[j] = xr[64 * j]; s += (v[j][0] * v[j][0] + v[j][1] * v[j][1]) + (v[j][2] * v[j][2] + v[j][3] * v[j][3]); }
  s = wave_sum(s);
  unsigned long long* o8 = (unsigned long long*)orow + lane;
#pragma unroll
  for (int j = 0; j < 4; ++j) o8[64 * j] = (unsigned long long)pk2(v[j][0], v[j][1]) | ((unsigned long long)pk2(v[j][2], v[j][3]) << 32);
  if (lane == 0) *ssp = s;
}
struct WJob { const float* W; int K, N; const float* gk; int mode; size_t dst; };

__device__ __forceinline__ void prep_phase(const Params& P, char* lds, int vcu, int G) {
  const int tid = otid(), lane = tid & 63, wave = tid >> 6;
  float* scr = (float*)(lds + wave * 16384);
  const int gw = vcu * NWAVES + wave, NGW = G * NWAVES; unsigned char* ws = P.ws;
#define TJOB(Wp, K_, N_, gk_, mode_, dst_) { const int nit = ((K_) / 64) * ((N_) / 32); for (int it = gw; it < nit; it += NGW) transpose_item(Wp, K_, N_, gk_, mode_, (bf16_t*)(ws + (dst_)), scr, it, lane); }
  TJOB(P.in[5], 1024, 3072, P.in[4], 1, WS_WQKV)
  TJOB(P.in[11], 1024, 1024, nullptr, 0, WS_WO)
  TJOB(P.in[12], 1024, 2048, P.in[4] + 1024, 0, WS_WUV)
  TJOB(P.in[17], 1024, 1024, nullptr, 0, WS_WOUT)
#pragma unroll 1
  for (int L = 0; L < 2; ++L) {
    TJOB(P.in[19] + (size_t)L * 1024 * NUP, 1024, NUP, P.in[18] + L * 1024, 2, WS_WUP + (size_t)L * 11 * MiB)
    TJOB(P.in[22] + (size_t)L * FF * 1024, FF, 1024, nullptr, 0, WS_WDN + (size_t)L * (11 * MiB / 2))
    TJOB(P.in[24] + (size_t)L * 1024 * 1024, 1024, 1024, P.in[23] + L * 1024, 0, WS_WG + (size_t)L * 2 * MiB)
    TJOB(P.in[25] + (size_t)L * 256 * 1024, 256, 1024, nullptr, 0, WS_WP + (size_t)L * (MiB / 2))
  }
#undef TJOB
  for (int m = gw; m < NTOK; m += NGW) { const float* xr = m < HALF_TOK ? P.xin_a + (size_t)m * DM : P.xin_b + (size_t)(m - HALF_TOK) * DM;
    row_to_bf16_ss(xr, (bf16_t*)(ws + WS_XB) + (size_t)m * DM, (float*)(ws + WS_SS) + m, lane); }
  const size_t gt = (size_t)vcu * NTHR + tid, GT = (size_t)G * NTHR;
  for (size_t i = gt; i < (size_t)2 * NTOK * 256 / 8; i += GT) { const size_t e = i * 8; const int L = (int)(e / ((size_t)NTOK * 256)); const size_t r = e % ((size_t)NTOK * 256);
    const float* src = r < (size_t)HALF_TOK * 256 ? P.in[2] + (size_t)L * HALF_TOK * 256 + r : P.in[3] + (size_t)L * HALF_TOK * 256 + (r - (size_t)HALF_TOK * 256);
    const f32x4 a = *(const f32x4*)src, b = *(const f32x4*)(src + 4); *(u32x4*)((bf16_t*)(ws + WS_PB) + e) = pack8(a, b); }
  for (size_t i = gt; i < (size_t)16384 * 32; i += GT) { const int d = (int)(i & 31), pos = (int)(i >> 5);
    const float inv = 1.0f / powf(10000.0f, (float)(2 * d) / 64.0f); const float ang = (float)pos * inv;
    const double tw = 6.283185307179586476925; double r = (double)ang; r -= tw * rint(r / tw); const float rf = (float)r;
    ((float*)(ws + WS_COS))[i] = cosf(rf); ((float*)(ws + WS_SIN))[i] = sinf(rf); }
  for (size_t i = gt; i < (size_t)8 * 128 * 128 / 8; i += GT) { const float* src = P.in[15] + i * 8; *(u32x4*)((bf16_t*)(ws + WS_WSP) + i * 8) = pack8(*(const f32x4*)src, *(const f32x4*)(src + 4)); }
  for (size_t i = gt; i < (size_t)6 * NTOK; i += GT) ((float*)(ws + WS_SS))[NTOK + i] = 0.f;
  for (size_t i = gt; i < (size_t)2 * NTOK; i += GT) ((float*)(ws + WS_LNS))[i] = 0.f;
  if (vcu == 0 && tid == 0) { float d1 = 0.f, d2 = 0.f; for (int i = 0; i < 64; ++i) { d1 += P.in[6][i] * P.in[7][i]; d2 += P.in[8][i] * P.in[9][i]; }
    *(float*)(ws + WS_LAM) = expf(d1) - expf(d2) + 0.2f; }
}

__device__ __forceinline__ void sgu_unit(const Params& P, char* lds, int chunk, int g) {
  const int tid = otid(), lane = tid & 63, w = tid >> 6; unsigned char* ws = P.ws;
  bf16_t* vT = (bf16_t*)lds; bf16_t* Wsm = (bf16_t*)(lds + 34816); float* st_mean = (float*)(lds + 69632); float* st_rstd = st_mean + 128;
  bf16_t* U = (bf16_t*)(ws + WS_R1); const bf16_t* Vs = (const bf16_t*)(ws + WS_XB); const float* lns = (const float*)(ws + WS_LNS);
  if (tid < 128) { const int row = chunk * 128 + tid; const float mean = lns[row] * (1.0f / 1024.0f); const float var = lns[NTOK + row] * (1.0f / 1024.0f) - mean * mean;
    st_mean[tid] = mean; st_rstd[tid] = 1.0f / sqrtf(fmaxf(var, 0.f) + EPS); }
  const int c8 = (tid & 15) * 8;
#pragma unroll
  for (int i = 0; i < 4; ++i) { const int p = (tid >> 4) + 32 * i; *(u32x4*)(Wsm + p * 136 + c8) = *(const u32x4*)((const bf16_t*)(ws + WS_WSP) + (size_t)(g * 128 + p) * 128 + c8); }
  __syncthreads();
  { const float* lng = P.in[13] + g * 128 + c8; const float* lnb = P.in[14] + g * 128 + c8;
    const f32x4 g0 = *(const f32x4*)lng, g1 = *(const f32x4*)(lng + 4), b0 = *(const f32x4*)lnb, b1 = *(const f32x4*)(lnb + 4);
#pragma unroll
    for (int i = 0; i < 4; ++i) { const int q = (tid >> 4) + 32 * i; f32x4 x0, x1; unpack8(*(const u32x4*)(Vs + (size_t)(chunk * 128 + q) * DM + g * 128 + c8), x0, x1);
      const float mean = st_mean[q], rs = st_rstd[q];
      x0 = (x0 - mean) * rs * g0 + b0; x1 = (x1 - mean) * rs * g1 + b1;
#pragma unroll
      for (int e = 0; e < 4; ++e) { vT[(c8 + e) * 136 + q] = (bf16_t)f2bf(x0[e]); vT[(c8 + 4 + e) * 136 + q] = (bf16_t)f2bf(x1[e]); } } }
  __syncthreads();
  const int i16 = lane & 15, kg = lane >> 4;
  f32x4 acc[8];
#pragma unroll
  for (int cb = 0; cb < 8; ++cb) acc[cb] = (f32x4){0.f, 0.f, 0.f, 0.f};
#pragma unroll
  for (int ks = 0; ks < 4; ++ks) { const bf16x8 bfrag = *(const bf16x8*)(Wsm + (16 * w + i16) * 136 + ks * 32 + kg * 8);
#pragma unroll
    for (int cb = 0; cb < 8; ++cb) { const bf16x8 afrag = *(const bf16x8*)(vT + (16 * cb + i16) * 136 + ks * 32 + kg * 8);
      acc[cb] = __builtin_amdgcn_mfma_f32_16x16x32_bf16(afrag, bfrag, acc[cb], 0, 0, 0); } }
  const int p = 16 * w + i16; const size_t token = (size_t)chunk * 128 + p; const float bias = P.in[16][g * 128 + p];
#pragma unroll
  for (int cb = 0; cb < 8; ++cb) { bf16_t* up = U + token * DM + g * 128 + 16 * cb + 4 * kg; const u32x2 uu = *(const u32x2*)up;
    const float u0 = __uint_as_float(uu.x << 16), u1 = __uint_as_float(uu.x & 0xffff0000u), u2 = __uint_as_float(uu.y << 16), u3 = __uint_as_float(uu.y & 0xffff0000u);
    u32x2 o; o.x = cvt_pk_bf16(u0 * (acc[cb][0] + bias), u1 * (acc[cb][1] + bias)); o.y = cvt_pk_bf16(u2 * (acc[cb][2] + bias), u3 * (acc[cb][3] + bias)); *(u32x2*)up = o; }
  __syncthreads();
}

__device__ __forceinline__ void fixup_phase(const Params& P, int L, int half, int vcu, int G) {
  unsigned char* ws = P.ws; const float* HAL = (const float*)(ws + WS_HALO); bf16_t* Gb = (bf16_t*)(ws + WS_G);
  const float* cw = P.in[20] + (size_t)L * 3 * NUP; const int S = half == 0 ? 16384 : 2048;
  const size_t gt = (size_t)vcu * NTHR + otid(), GT = (size_t)G * NTHR;
  for (size_t i = gt; i < (size_t)512 * 2 * FF; i += GT) { const int f = (int)(i % FF); const int rb = (int)(i / FF); const int blk = rb >> 1, which = rb & 1;
    const int row = blk * 64 + (which ? 63 : 0); const int pos = row % S;
    const float* h = HAL + (size_t)(blk * 4) * NUP;
    float cv = h[(2 + which) * NUP + f], cg = h[(2 + which) * NUP + FF + f];
    if (which == 0) { if (pos != 0) { const float* hp = HAL + (size_t)((blk - 1) * 4 + 1) * NUP; cv += cw[f] * hp[f]; cg += cw[FF + f] * hp[FF + f]; } }
    else { if (pos != S - 1) { const float* hn = HAL + (size_t)((blk + 1) * 4 + 0) * NUP; cv += cw[2 * NUP + f] * hn[f]; cg += cw[2 * NUP + FF + f] * hn[FF + f]; } }
    Gb[(size_t)row * FF + f] = (bf16_t)f2bf(cg * sigmoidf_(cg) * cv); }
}

__device__ __forceinline__ void final_phase(const Params& P, int vcu, int G) {
  const int t_ = otid(); const int lane = t_ & 63, wave = t_ >> 6; const int gw = vcu * NWAVES + wave, NGW = G * NWAVES;
  const float* ss = (const float*)(P.ws + WS_SS) + (size_t)6 * NTOK; const float* g = P.in[26];
  for (int m = gw; m < NTOK; m += NGW) { const float rs = rstd_of(ss[m]); f32x4* xr = (f32x4*)(P.out + (size_t)m * DM) + lane;
#pragma unroll
    for (int j = 0; j < 4; ++j) { const f32x4 gg = *((const f32x4*)g + lane + 64 * j); xr[64 * j] = xr[64 * j] * rs * gg; } }
}

__global__ void __launch_bounds__(NTHR, 2) mega(Params P) {
  extern __shared__ __attribute__((aligned(16))) unsigned char lds_raw[];
  cg::grid_group grid = cg::this_grid();
  LAS3 unsigned char* lds3 = (LAS3 unsigned char*)lds_raw; char* lds = (char*)lds_raw;
  const int G = gridDim.x, bx = blockIdx.x; const int vcu = (G % 8 == 0) ? (bx % 8) * (G / 8) + bx / 8 : bx;
  unsigned char* ws = P.ws; const int lo = P.ph_lo, hi = P.ph_hi;
  volatile LAS3 unsigned* MISC = (volatile LAS3 unsigned*)(lds3 + 139264);
  if (threadIdx.x < 4) MISC[threadIdx.x] = 0u;
  __syncthreads();
  xb::XcdBarrier bar = xb::xcd_barrier_post((unsigned*)(ws + WS_BAR), MISC);
  float* SS = (float*)(ws + WS_SS);
  bf16_t* XB = (bf16_t*)(ws + WS_XB); bf16_t* R1 = (bf16_t*)(ws + WS_R1); bf16_t* R2 = (bf16_t*)(ws + WS_R2);
#ifndef ENMASK
#define ENMASK 0xffffffffu
#endif
#define IN(k) (lo <= (k) && (k) < hi)
#define EN(b) (((ENMASK) >> (b)) & 1u)
#define SEAM(k) do { if (IN(k) && IN((k) + 1)) { if ((k) == 0) grid.sync(); else xb::xcd_barrier(bar); } else __syncthreads(); } while (0)
#define GEMM(EpiT, E, Aptr, Bptr, M_, N_, K_) do { pg8::Gemm g_{(const bf16_t*)(Aptr), (const bf16_t*)(Bptr), M_, N_, K_}; pg8::StaticOrder S_; S_.init(M_, N_, G, bx); \
    pg8::gemm_phase<EpiT, pg8::StaticOrder, true, true>(lds3, g_, S_, E); } while (0)

  if (EN(0) && IN(0)) { prep_phase(P, lds, vcu, G); }
  SEAM(0);
  if (EN(1) && IN(1)) { EpiQKV E{R1, (bf16_t*)P.out, SS, (const float*)(ws + WS_COS), (const float*)(ws + WS_SIN)};
    GEMM(EpiQKV, E, XB, ws + WS_WQKV, NTOK, 3072, 1024); }
  SEAM(1);
  if (EN(2) && IN(2)) { const float lam = *(const float*)(ws + WS_LAM); const float* subg = P.in[10];
    const bf16_t* Q = R1; const bf16_t* K = (const bf16_t*)P.out; const bf16_t* V = K + (size_t)NTOK * DM; bf16_t* AO = R2;
    const int nu = (G == 256) ? 16 : (4096 + G - 1) / G;
#define ATT_UNIT_ARGS(i) \
      int ui; if (G == 256) { const int x = vcu >> 5, j = vcu & 31; ui = ((i) < 8) ? ((2 * x + ((i) >> 2)) * 128 + j + 32 * ((i) & 3)) : (2048 + (16 * x) * 16 + ((i) - 8) * 32 + j); } \
      else { ui = bx + (i) * G; if (ui >= 4096) break; } \
      long tq0, tk0; int seq, h; \
      if (ui < 2048) { const int ph = ui >> 7, qb = ui & 127; tk0 = (long)(ph >> 3) * 16384; tq0 = tk0 + qb * 128; seq = 16384; h = ph & 7; } \
      else { const int v = ui - 2048, pair = v >> 4, qb = v & 15; tk0 = (long)HALF_TOK + (long)(pair >> 3) * 2048; tq0 = tk0 + qb * 128; seq = 2048; h = pair & 7; }
    unsigned long long badmask = 0ull;
#pragma unroll 1
    for (int i = 0; i < nu && i < 64; ++i) { ATT_UNIT_ARGS(i)
      if (at::diff_unit<true>(Q, K, V, AO, tq0, tk0, seq, h, lam, subg, lds)) badmask |= 1ull << i; }
#pragma unroll 1
    for (int i = 0; i < nu && i < 64; ++i) { if (!((badmask >> i) & 1ull)) continue; ATT_UNIT_ARGS(i)
      (void)at::diff_unit<false>(Q, K, V, AO, tq0, tk0, seq, h, lam, subg, lds); }
#undef ATT_UNIT_ARGS
  }
  SEAM(2);
  if (EN(3) && IN(3)) { EpiRes<false> E{P.xin_a, P.xin_b, P.out, XB, SS + 1 * NTOK, nullptr, nullptr, 0}; GEMM(EpiRes<false>, E, R2, ws + WS_WO, NTOK, 1024, 1024); }
  SEAM(3);
#pragma unroll 1
  for (int L = 0; L < 2; ++L) {
    const int pb = 4 + 10 * L;
    if (L == 1) {
      if (EN(11) && IN(11)) { EpiUV E{R1, XB, SS + 3 * NTOK, (float*)(ws + WS_LNS)}; GEMM(EpiUV, E, R2, ws + WS_WUV, NTOK, 2048, 1024); }
      SEAM(11);
      if (EN(12) && IN(12)) { for (int ui = vcu; ui < 4096; ui += G) sgu_unit(P, lds, ui >> 3, ui & 7); }
      SEAM(12);
      if (EN(13) && IN(13)) { EpiRes<false> E{P.out, P.out + (size_t)HALF_TOK * DM, P.out, XB, SS + 4 * NTOK, nullptr, nullptr, 0}; GEMM(EpiRes<false>, E, R1, ws + WS_WOUT, NTOK, 1024, 1024); }
      SEAM(13);
    }
#pragma unroll 1
    for (int half = 0; half < 2; ++half) {
      const int p0 = pb + 3 * half; const int rowoff = half * HALF_TOK;
      if (EN(4) && IN(p0)) { EpiUp E{(bf16_t*)(ws + WS_G), (float*)(ws + WS_HALO), SS + (size_t)(1 + 3 * L) * NTOK, P.in[20] + (size_t)L * 3 * NUP, P.in[21] + (size_t)L * NUP, rowoff};
        GEMM(EpiUp, E, XB + (size_t)rowoff * DM, ws + WS_WUP + (size_t)L * 11 * MiB, HALF_TOK, NUP, 1024); }
      SEAM(p0);
      if (EN(5) && IN(p0 + 1)) fixup_phase(P, L, half, vcu, G);
      SEAM(p0 + 1);
      if (EN(6) && IN(p0 + 2)) { EpiRes<false> E{P.out, P.out + (size_t)HALF_TOK * DM, P.out, XB, SS + (size_t)(2 + 3 * L) * NTOK, nullptr, nullptr, rowoff};
        GEMM(EpiRes<false>, E, ws + WS_G, ws + WS_WDN + (size_t)L * (11 * MiB / 2), HALF_TOK, 1024, FF); }
      SEAM(p0 + 2);
    }
    const int pp = pb + 6;
    if (EN(10) && IN(pp)) {
      { EpiStore E{R1}; GEMM(EpiStore, E, (bf16_t*)(ws + WS_PB) + (size_t)L * NTOK * 256, ws + WS_WP + (size_t)L * (MiB / 2), NTOK, 1024, 256); }
      __syncthreads();
      { EpiRes<true> E{nullptr, nullptr, P.out, R2, SS + (size_t)(3 + 3 * L) * NTOK, SS + (size_t)(2 + 3 * L) * NTOK, R1, 0};
        GEMM(EpiRes<true>, E, XB, ws + WS_WG + (size_t)L * 2 * MiB, NTOK, 1024, 1024); }
    }
    SEAM(pp);
  }
  if (EN(21) && IN(21)) final_phase(P, vcu, G);
#undef IN
#undef SEAM
#undef EN
#undef GEMM
}
}
#ifndef MODE
#define MODE 0
#endif
#ifndef FASTMASK
#define FASTMASK 0x7f
#endif
namespace fk {
__global__ void __launch_bounds__(256) k_resync(const float* __restrict__ x, bf16_t* __restrict__ xb, float* __restrict__ ss) {
  const int lane = threadIdx.x & 63; const int gw = blockIdx.x * 4 + (threadIdx.x >> 6), NGW = gridDim.x * 4;
  for (int m = gw; m < NTOK; m += NGW) row_to_bf16_ss(x + (size_t)m * DM, xb + (size_t)m * DM, ss + m, lane);
}
}
extern "C" void kernel_launch(void* const* d_in, const int* in_sizes, int n_in, void* d_out, int out_size, void* d_ws, size_t ws_size, hipStream_t stream) {
  static int grid = 0;
  if (grid == 0) {
    if (n_in != 27 || out_size != fk::NTOK * fk::DM || ws_size < (size_t)512 * fk::MiB) { fprintf(stderr, "kernel_launch: unexpected shapes n_in %d out %d ws %zu\n", n_in, out_size, ws_size); grid = -1; return; }
    int dev = 0, cus = 0, per_cu = 0; hipGetDevice(&dev); hipDeviceGetAttribute(&cus, hipDeviceAttributeMultiprocessorCount, dev);
    if (hipFuncSetAttribute((const void*)fk::mega, hipFuncAttributeMaxDynamicSharedMemorySize, fk::LDS_BYTES) != hipSuccess) { fprintf(stderr, "kernel_launch: hipFuncSetAttribute failed\n"); grid = -1; return; }
    if (hipOccupancyMaxActiveBlocksPerMultiprocessor(&per_cu, (const void*)fk::mega, fk::NTHR, fk::LDS_BYTES) != hipSuccess || per_cu < 1) { fprintf(stderr, "kernel_launch: occupancy query says %d\n", per_cu); per_cu = 1; }
    (void)hipGetLastError();
    grid = cus * per_cu; if (grid > 256) grid = 256;
    fprintf(stderr, "kernel_launch: grid %d (cus %d per_cu %d) ws %zu\n", grid, cus, per_cu, ws_size);
  }
  if (grid < 0) return;
  fk::Params p{};
  for (int i = 0; i < 27; ++i) p.in[i] = (const float*)d_in[i];
  p.xin_a = (const float*)d_in[0]; p.xin_b = (const float*)d_in[1]; p.out = (float*)d_out; p.ws = (unsigned char*)d_ws;
#if MODE == 0
  hipMemsetAsync((char*)d_ws + fk::WS_BAR, 0, 16384, stream);
  p.ph_lo = 0; p.ph_hi = fk::NPH; void* args[] = {&p};
  hipError_t e = hipLaunchCooperativeKernel((const void*)fk::mega, dim3(grid), dim3(fk::NTHR), args, fk::LDS_BYTES, stream);
  if (e != hipSuccess) fprintf(stderr, "cooperative launch failed: %s (grid %d)\n", hipGetErrorString(e), grid);
#else
  auto runph = [&](int a, int b) { for (int k = a; k <= b; ++k) { p.ph_lo = k; p.ph_hi = k + 1; hipLaunchKernelGGL(fk::mega, dim3(grid), dim3(fk::NTHR), fk::LDS_BYTES, stream, p); } };
  char* nws = (char*)d_ws + 128 * fk::MiB; float* out = (float*)d_out; unsigned char* ws = (unsigned char*)d_ws;
  hipMemsetAsync((char*)d_ws + fk::WS_BAR, 0, 16384, stream);
  runph(0, 0);
  const int first[7] = {1, 4, 10, 11, 14, 20, 21}, last[7] = {3, 9, 10, 13, 19, 20, 21};
  if (!(FASTMASK & 1)) { hipMemcpyAsync(out, d_in[0], (size_t)fk::HALF_TOK * 1024 * 4, hipMemcpyDeviceToDevice, stream); hipMemcpyAsync(out + (size_t)fk::HALF_TOK * 1024, d_in[1], (size_t)fk::HALF_TOK * 1024 * 4, hipMemcpyDeviceToDevice, stream); }
  for (int s = 0; s < 7; ++s) {
    if (FASTMASK & (1 << s)) {
      if (s > 0) fk::k_resync<<<1024, 256, 0, stream>>>(out, (fk::bf16_t*)(ws + (s == 3 ? fk::WS_R2 : fk::WS_XB)), (float*)(ws + fk::WS_SS) + (size_t)s * fk::NTOK);
      runph(first[s], last[s]);
    } else nv::stage(s, d_in, out, nws, stream);
  }
#endif
}
```

```cpp
#include <hip/hip_runtime.h>
#include <hip/hip_cooperative_groups.h>
#include <cstdio>
#include <cstdint>
namespace cg = cooperative_groups;
#define MODE 0
#define FASTMASK 0x7f
namespace pg8 {
#define PG8_LAS __attribute__((address_space(3)))
typedef unsigned short bf16_t;
typedef short bf16x8 __attribute__((ext_vector_type(8)));
typedef float f32x4 __attribute__((ext_vector_type(4)));
typedef unsigned u32x4 __attribute__((ext_vector_type(4)));
constexpr int BM = 256, BK = 64, HALF = 128, HTB = HALF * BK * 2  , STAGE_BYTES = 8 * HTB, NXCD = 8, WGM = 8;

__host__ __device__ __forceinline__ int lds_byte(int r, int c) { const int st = (r >> 4) * 2 + (c >> 5), rr = r & 15, cc = c & 31, ob = rr * 64 + cc * 2; return st * 1024 + (ob ^ (((ob >> 9) & 1) << 5)); }
__host__ __device__ __forceinline__ void stage_rc(int b, int& R, int& C) { const int st = b / 1024, sb = b % 1024, swz = sb ^ (((sb >> 9) & 1) << 5); R = (st >> 1) * 16 + swz / 64; C = (st & 1) * 32 + (swz % 64) / 2; }
__host__ __device__ __forceinline__ int perm32(int rho) { const int n = rho >> 4, i = rho & 15; return 8 * (i >> 2) + 4 * n + (i & 3); }

struct Unit { int pm, pn; };
struct Gemm { const bf16_t* A; const bf16_t* Bt; int M, N, K; };

struct StaticOrder {
    int nM, nN, nwg, G, c;
    __host__ __device__ __forceinline__ void init(int M, int N, int G_, int c_) { nM = M / BM; nN = N / BM; nwg = nM * nN; G = G_; c = c_; }
    __host__ __device__ __forceinline__ bool next(int i, Unit& u) const {
        const long L = (long)i * G + c; if (L >= nwg) return false;
        int wgid = (int)L; { const int q = nwg / NXCD, r = nwg % NXCD, xcd = wgid % NXCD, off = wgid / NXCD; wgid = (xcd < r ? xcd * (q + 1) : r * (q + 1) + (xcd - r) * q) + off; }
        const int nig = WGM * nN, gid = wgid / nig, fm = gid * WGM, gsz = (nM - fm) < WGM ? (nM - fm) : WGM;
        u.pm = fm + ((wgid % nig) % gsz); u.pn = (wgid % nig) / gsz; return true;
    }
    __device__ __forceinline__ void a_ready(const Unit&) const {}
    __device__ __forceinline__ void done(const Unit&) const {}
};

__device__ __forceinline__ unsigned cvt_pk_bf16(float lo, float hi) { unsigned r; asm volatile("v_cvt_pk_bf16_f32 %0, %1, %2" : "=v"(r) : "v"(lo), "v"(hi)); return r; }
typedef float f32x2 __attribute__((ext_vector_type(2)));
__device__ __forceinline__ f32x2 gelu_pk(f32x2 v) {
    const f32x2 av = __builtin_elementwise_abs(v), d = av * 0.2316418882f + 1.0f;
    f32x2 t; t.x = __builtin_amdgcn_rcpf(d.x); t.y = __builtin_amdgcn_rcpf(d.y);
    f32x2 q = t * 0.5307027145f + (-0.7265760135f); q = q * t + 0.7107068705f; q = q * t + (-0.142248368f); q = q * t + 0.127414796f; q = q * t;
    const f32x2 s = (v * v) * (-0.72134752044f);
    f32x2 e; e.x = __builtin_amdgcn_exp2f(s.x); e.y = __builtin_amdgcn_exp2f(s.y);
    const f32x2 m = v * (q * e), r = v - m;
    f32x2 o; o.x = v.x < 0.f ? m.x : r.x; o.y = v.y < 0.f ? m.y : r.y; return o;
}

template <class Epi, class Sched, bool ALIGN_EPI = false, bool SP2 = false>
__device__ __forceinline__ void gemm_phase(PG8_LAS unsigned char* lds, const Gemm g, const Sched& S, const Epi& E) {
    int tid_ = threadIdx.x; asm volatile("" : "+v"(tid_));
    const int tid = tid_, wid = __builtin_amdgcn_readfirstlane(tid >> 6), lane = tid & 63, wr = wid >> 2, wc = wid & 3, fr = lane & 15, fq = lane >> 4;
    const int K = g.K, nt = K / BK;
    unsigned voffA[2], voffB[2];
#pragma unroll
    for (int i = 0; i < 2; ++i) { int R, C; stage_rc(tid * 16 + i * 8192, R, C); const int Rb = Epi::PERM ? ((R & ~31) + perm32(R & 31)) : R;
        voffA[i] = (unsigned)(R * K + C) * 2u; voffB[i] = (unsigned)(Rb * K + C) * 2u; }
    const size_t kstep = (size_t)(BK * 2);
    const size_t hstep = (size_t)HALF * K * 2;
    const size_t tstep = 2 * hstep;
    const unsigned ldsw = (unsigned)wid * 1024u;
    const int aoff = lds_byte(wr * 64 + fr, fq * 8), boff = lds_byte(wc * 32 + fr, fq * 8);
#define PG8_SA(b, h) (((b) * 2 + (h)) * HTB)
#define PG8_SB(b, h) ((4 + (b) * 2 + (h)) * HTB)
#define PG8_STAGE(bufoff, gbase, voff) do { _Pragma("unroll") for (int _i = 0; _i < 2; ++_i) \
        __builtin_amdgcn_global_load_lds((const unsigned*)((const char*)(gbase) + (voff)[_i]), (PG8_LAS unsigned*)(lds + (bufoff) + ldsw + _i * 8192), 16, 0, 0); } while (0)
#define PG8_LDA(dst, b, h) do { _Pragma("unroll") for (int m = 0; m < 4; ++m) _Pragma("unroll") for (int k = 0; k < 2; ++k) dst[m][k] = *(const PG8_LAS bf16x8*)(lds + PG8_SA(b, h) + aoff + m * 2048 + k * 1024); } while (0)
#define PG8_LDB(dst, b, h) do { _Pragma("unroll") for (int n = 0; n < 2; ++n) _Pragma("unroll") for (int k = 0; k < 2; ++k) dst[n][k] = *(const PG8_LAS bf16x8*)(lds + PG8_SB(b, h) + boff + n * 2048 + k * 1024); } while (0)
#define PG8_MMA(ai, bj, At, Bt) do { __builtin_amdgcn_s_setprio(1); _Pragma("unroll") for (int m = 0; m < 4; ++m) _Pragma("unroll") for (int n = 0; n < 2; ++n) _Pragma("unroll") for (int k = 0; k < 2; ++k) \
        acc[ai][bj][m][n] = __builtin_amdgcn_mfma_f32_16x16x32_bf16(Bt[n][k], At[m][k], acc[ai][bj][m][n], 0, 0, 0); __builtin_amdgcn_s_setprio(0); } while (0)
#define PG8_WAIT_V(n) asm volatile("s_waitcnt vmcnt(" #n ")" ::: "memory")
#define PG8_WAIT_L(n) asm volatile("s_waitcnt lgkmcnt(" #n ")" ::: "memory")
#define PG8_BAR __builtin_amdgcn_s_barrier()
#define PG8_SCHED __builtin_amdgcn_sched_barrier(0)
    Unit cur, nxt; int ui = 0;
    if (!S.next(0, cur)) return;
    f32x4 acc[2][2][4][2];
#pragma unroll
    for (int a = 0; a < 2; ++a)
#pragma unroll
        for (int b = 0; b < 2; ++b)
#pragma unroll
            for (int m = 0; m < 4; ++m)
#pragma unroll
                for (int n = 0; n < 2; ++n) acc[a][b][m][n] = (f32x4){0.f, 0.f, 0.f, 0.f};
    bf16x8 At[4][2], B0[2][2], B1[2][2];
    const char* cA = (const char*)g.A + (size_t)cur.pm * tstep; const char* cB = (const char*)g.Bt + (size_t)cur.pn * tstep;
    S.a_ready(cur);
    if constexpr (SP2) {
        PG8_STAGE(PG8_SB(0, 0), cB, voffB); PG8_STAGE(PG8_SB(0, 1), cB + hstep, voffB); PG8_STAGE(PG8_SA(0, 0), cA, voffA); PG8_STAGE(PG8_SA(0, 1), cA + hstep, voffA);
        if (wr == 1) PG8_BAR;
        PG8_WAIT_V(2); PG8_BAR;
        PG8_STAGE(PG8_SB(1, 0), cB + kstep, voffB); PG8_STAGE(PG8_SA(1, 0), cA + kstep, voffA); PG8_STAGE(PG8_SB(1, 1), cB + hstep + kstep, voffB);
        PG8_WAIT_V(6); PG8_BAR;
    } else {
        PG8_STAGE(PG8_SB(0, 0), cB, voffB); PG8_STAGE(PG8_SA(0, 0), cA, voffA); PG8_STAGE(PG8_SB(0, 1), cB + hstep, voffB); PG8_STAGE(PG8_SA(0, 1), cA + hstep, voffA);
        if (wr == 1) PG8_BAR;
        PG8_WAIT_V(4); PG8_BAR;
        PG8_STAGE(PG8_SB(1, 0), cB + kstep, voffB); PG8_STAGE(PG8_SA(1, 0), cA + kstep, voffA); PG8_STAGE(PG8_SB(1, 1), cB + hstep + kstep, voffB);
        PG8_WAIT_V(6); PG8_BAR;
    }
    for (;;) {
        const bool has_next = S.next(ui + 1, nxt);
        const char* nA = has_next ? (const char*)g.A + (size_t)nxt.pm * tstep : cA; const char* nB = has_next ? (const char*)g.Bt + (size_t)nxt.pn * tstep : cB;
#pragma unroll 1
        for (int t = 0; t < nt; t += 2) {
            const bool last = (t == nt - 2);
            const char* a1 = cA + (size_t)(t + 1) * kstep;
            const char* a2 = last ? nA : cA + (size_t)(t + 2) * kstep; const char* b2 = last ? nB : cB + (size_t)(t + 2) * kstep;
            const char* a3 = a2 + kstep; const char* b3 = b2 + kstep;
            if (last && has_next) S.a_ready(nxt);
            if constexpr (SP2) {
            PG8_LDB(B0, 0, 0); PG8_LDB(B1, 0, 1); PG8_SCHED; PG8_LDA(At, 0, 0); PG8_STAGE(PG8_SA(1, 1), a1 + hstep, voffA);
            PG8_WAIT_V(8); PG8_WAIT_L(0); PG8_BAR; PG8_MMA(0, 0, At, B0); PG8_MMA(0, 1, At, B1); PG8_BAR; PG8_SCHED;
            PG8_LDA(At, 0, 1); PG8_STAGE(PG8_SB(0, 0), b2, voffB); PG8_STAGE(PG8_SB(0, 1), b2 + hstep, voffB); PG8_STAGE(PG8_SA(0, 0), a2, voffA);
            PG8_WAIT_V(8); PG8_WAIT_L(0); PG8_BAR; PG8_MMA(1, 0, At, B0); PG8_MMA(1, 1, At, B1); PG8_BAR; PG8_SCHED;
            PG8_LDB(B0, 1, 0); PG8_LDB(B1, 1, 1); PG8_SCHED; PG8_LDA(At, 1, 0); PG8_STAGE(PG8_SA(0, 1), a2 + hstep, voffA);
            PG8_WAIT_V(8); PG8_WAIT_L(0); PG8_BAR; PG8_MMA(0, 0, At, B0); PG8_MMA(0, 1, At, B1); PG8_BAR; PG8_SCHED;
            PG8_LDA(At, 1, 1); PG8_STAGE(PG8_SB(1, 0), b3, voffB); PG8_STAGE(PG8_SB(1, 1), b3 + hstep, voffB); PG8_STAGE(PG8_SA(1, 0), a3, voffA);
            PG8_WAIT_V(8); PG8_WAIT_L(0); PG8_BAR; PG8_MMA(1, 0, At, B0); PG8_MMA(1, 1, At, B1); PG8_BAR; PG8_SCHED;
            } else {
            PG8_LDB(B0, 0, 0); PG8_SCHED; PG8_LDA(At, 0, 0); PG8_STAGE(PG8_SA(1, 1), a1 + hstep, voffA);
            PG8_WAIT_L(8); PG8_BAR; PG8_WAIT_L(0); PG8_MMA(0, 0, At, B0); PG8_BAR; PG8_SCHED;
            PG8_LDB(B1, 0, 1); PG8_STAGE(PG8_SB(0, 0), b2, voffB);
            PG8_BAR; PG8_WAIT_L(0); PG8_MMA(0, 1, At, B1); PG8_BAR;
            PG8_LDA(At, 0, 1); PG8_STAGE(PG8_SA(0, 0), a2, voffA);
            PG8_BAR; PG8_WAIT_L(0); PG8_MMA(1, 0, At, B0); PG8_BAR; PG8_SCHED;
            PG8_STAGE(PG8_SB(0, 1), b2 + hstep, voffB);
            PG8_WAIT_V(6); PG8_BAR; PG8_MMA(1, 1, At, B1); PG8_BAR;
            PG8_LDB(B0, 1, 0); PG8_SCHED; PG8_LDA(At, 1, 0); PG8_STAGE(PG8_SA(0, 1), a2 + hstep, voffA);
            PG8_WAIT_L(8); PG8_BAR; PG8_WAIT_L(0); PG8_MMA(0, 0, At, B0); PG8_BAR; PG8_SCHED;
            PG8_LDB(B1, 1, 1); PG8_STAGE(PG8_SB(1, 0), b3, voffB);
            PG8_BAR; PG8_WAIT_L(0); PG8_MMA(0, 1, At, B1); PG8_BAR;
            PG8_LDA(At, 1, 1); PG8_STAGE(PG8_SA(1, 0), a3, voffA);
            PG8_BAR; PG8_WAIT_L(0); PG8_MMA(1, 0, At, B0); PG8_BAR; PG8_SCHED;
            PG8_STAGE(PG8_SB(1, 1), b3 + hstep, voffB);
            PG8_WAIT_V(6); PG8_BAR; PG8_MMA(1, 1, At, B1); PG8_BAR;
            }
        }
        if constexpr (ALIGN_EPI) { if (wr == 0) PG8_BAR; }
        if constexpr (!Epi::AFTER_DRAIN) { E(acc, cur, wr, wc, fr, fq); S.done(cur); }
        if (!has_next) break;
#pragma unroll
        for (int a = 0; a < 2; ++a)
#pragma unroll
            for (int b = 0; b < 2; ++b)
#pragma unroll
                for (int m = 0; m < 4; ++m)
#pragma unroll
                    for (int n = 0; n < 2; ++n) acc[a][b][m][n] = (f32x4){0.f, 0.f, 0.f, 0.f};
        cur = nxt; cA = nA; cB = nB; ++ui;
        if constexpr (ALIGN_EPI) { if (wr == 1) PG8_BAR; }
    }
    PG8_WAIT_V(0);
    if constexpr (!ALIGN_EPI) { if (wr == 0) PG8_BAR; }
    PG8_BAR;
    if constexpr (Epi::AFTER_DRAIN) { E.fused(acc, cur, wr, wc, fr, fq, lds, wid, lane); S.done(cur); }
#undef PG8_SA
#undef PG8_SB
#undef PG8_STAGE
#undef PG8_LDA
#undef PG8_LDB
#undef PG8_MMA
#undef PG8_WAIT_V
#undef PG8_WAIT_L
#undef PG8_BAR
#undef PG8_SCHED
}
}
namespace xb {
#define LAS __attribute__((address_space(3)))
#define XB_TMO      128
#define XB_XCNT(j)  (256  + 64 * (j))
#define XB_XSUB(j)  (1280 + 64 * (j))
#define XB_XGEN(j)  (2304 + 64 * (j))
#define XB_TOP      3328
#define XB_TOPGEN   3392
#define XCD_BAR_WORDS 3456
#define XB_SPIN_CAP (1u << 18)

__device__ __forceinline__ unsigned xb_ld(unsigned* p)              { return __hip_atomic_load(p, __ATOMIC_RELAXED, __HIP_MEMORY_SCOPE_AGENT); }
__device__ __forceinline__ unsigned xb_add(unsigned* p, unsigned v) { return __hip_atomic_fetch_add(p, v, __ATOMIC_RELAXED, __HIP_MEMORY_SCOPE_AGENT); }
__device__ __forceinline__ unsigned xb_xcc_id() { return (unsigned)__builtin_amdgcn_s_getreg((3 << 11) | 20) & 0xFu; }
#define XB_SPIN(cond, bar) do { unsigned _sp = 0; while (cond) { __builtin_amdgcn_s_sleep(1); \
    if ((++_sp & 255u) == 0u) { if (xb_ld(&(bar)[XB_TMO])) break; if (_sp > XB_SPIN_CAP) { atomicAdd(&(bar)[XB_TMO], 1u); break; } } } } while (0)

struct XcdBarrier {
    unsigned* bar; unsigned x;
    volatile LAS unsigned* st;
};

__device__ __forceinline__ XcdBarrier xcd_barrier_post(unsigned* bar, volatile LAS unsigned* st) {
    XcdBarrier b; b.bar = bar; b.x = xb_xcc_id(); b.st = st;
    if (threadIdx.x == 0) (void)xb_add(&bar[XB_XCNT(b.x)], 1u);
    return b;
}
__device__ __forceinline__ void xcd_barrier_complete(unsigned* bar, unsigned x, unsigned& nloc, unsigned& nx) {
    const unsigned G = gridDim.x * gridDim.y * gridDim.z;
    unsigned sum, cnt, mine, sp = 0u;
    for (;;) {
        sum = 0u; cnt = 0u; mine = 0u;
#pragma unroll
        for (unsigned j = 0; j < 16; ++j) { const unsigned c = xb_ld(&bar[XB_XCNT(j)]); sum += c; cnt += (c > 0u) ? 1u : 0u; mine = (j == x) ? c : mine; }
        if (sum == G) break;
        __builtin_amdgcn_s_sleep(1);
        if ((++sp & 255u) == 0u) { if (xb_ld(&bar[XB_TMO])) break; if (sp > XB_SPIN_CAP) { atomicAdd(&bar[XB_TMO], 1u); break; } }
    }
    nloc = mine > 0u ? mine : 1u; nx = cnt > 0u ? cnt : 1u;
}

__device__ __forceinline__ void xcd_barrier(const XcdBarrier& b) {
    asm volatile("s_waitcnt vmcnt(0)" ::: "memory");
    __syncthreads();
    if (threadIdx.x == 0) {
        unsigned* bar = b.bar;
        __builtin_amdgcn_s_waitcnt(0);
        unsigned nloc = b.st[0], nx = b.st[1];
        if (nloc == 0u) { xcd_barrier_complete(bar, b.x, nloc, nx); b.st[0] = nloc; b.st[1] = nx; }
        const unsigned old = xb_add(&bar[XB_XSUB(b.x)], 1u);
        const unsigned gen = old / nloc;
        if (old + 1u == (gen + 1u) * nloc) {
            __builtin_amdgcn_fence(__ATOMIC_RELEASE, "agent");
            asm volatile("s_waitcnt vmcnt(0)" ::: "memory");
            const unsigned og = xb_add(&bar[XB_TOP], 1u);
            const unsigned tg = og / nx;
            if (og + 1u == (tg + 1u) * nx) xb_add(&bar[XB_TOPGEN], 1u);
            else XB_SPIN(xb_ld(&bar[XB_TOPGEN]) == tg, bar);
            __builtin_amdgcn_fence(__ATOMIC_ACQUIRE, "agent");
            xb_add(&bar[XB_XGEN(b.x)], 1u);
            asm volatile("s_waitcnt vmcnt(0)" ::: "memory");
        } else {
            XB_SPIN(xb_ld(&bar[XB_XGEN(b.x)]) == gen, bar);
            __builtin_amdgcn_fence(__ATOMIC_ACQUIRE, "agent");
            asm volatile("s_waitcnt vmcnt(0)" ::: "memory");
        }
    }
    __syncthreads();
}
#undef LAS
}
namespace fk {
using pg8::bf16_t; using pg8::bf16x8; using pg8::f32x4; using pg8::u32x4; using pg8::Unit; using pg8::cvt_pk_bf16; using pg8::f32x2;
typedef unsigned u32x2 __attribute__((ext_vector_type(2)));
constexpr int NTOK = 65536, DM = 1024, FF = 2816, NUP = 5632, HALF_TOK = 32768;
constexpr size_t MiB = (size_t)1 << 20;
constexpr size_t WS_LAM = 0, WS_BAR = 4096, WS_SS = 1 * MiB, WS_LNS = 3 * MiB, WS_COS = 4 * MiB, WS_SIN = 6 * MiB, WS_WSP = 8 * MiB;
constexpr size_t WS_WQKV = 10 * MiB, WS_WO = 16 * MiB, WS_WUV = 18 * MiB, WS_WOUT = 22 * MiB, WS_WUP = 24 * MiB, WS_WDN = 46 * MiB, WS_WG = 57 * MiB, WS_WP = 61 * MiB;
constexpr size_t WS_PB = 64 * MiB, WS_XB = 128 * MiB, WS_R1 = 256 * MiB, WS_R2 = 384 * MiB, WS_G = 256 * MiB, WS_HALO = 432 * MiB;
constexpr float EPS = 1e-6f;

struct Params {
  const float* in[27];
  const float* xin_a; const float* xin_b;
  float* out; unsigned char* ws;
  int ph_lo, ph_hi;
};

__device__ __forceinline__ float rstd_of(float ss) { return 1.0f / sqrtf(ss * (1.0f / 1024.0f) + EPS); }
__device__ __forceinline__ float bf2f(unsigned short b) { return __uint_as_float((unsigned)b << 16); }
__device__ __forceinline__ float sigmoidf_(float x) { return __builtin_amdgcn_rcpf(1.0f + __builtin_amdgcn_exp2f(-1.4426950408889634f * x)); }
__device__ __forceinline__ u32x4 pack8(const f32x4 a, const f32x4 b) { u32x4 w; w.x = cvt_pk_bf16(a[0], a[1]); w.y = cvt_pk_bf16(a[2], a[3]); w.z = cvt_pk_bf16(b[0], b[1]); w.w = cvt_pk_bf16(b[2], b[3]); return w; }
__device__ __forceinline__ void unpack8(const u32x4 w, f32x4& a, f32x4& b) {
  a[0] = __uint_as_float(w.x << 16); a[1] = __uint_as_float(w.x & 0xffff0000u); a[2] = __uint_as_float(w.y << 16); a[3] = __uint_as_float(w.y & 0xffff0000u);
  b[0] = __uint_as_float(w.z << 16); b[1] = __uint_as_float(w.z & 0xffff0000u); b[2] = __uint_as_float(w.w << 16); b[3] = __uint_as_float(w.w & 0xffff0000u); }

__device__ __forceinline__ float sum_fq(float v) {
  auto a = __builtin_amdgcn_permlane16_swap(__float_as_uint(v), __float_as_uint(v), false, false); v = __uint_as_float(a[0]) + __uint_as_float(a[1]);
  auto b = __builtin_amdgcn_permlane32_swap(__float_as_uint(v), __float_as_uint(v), false, false); return __uint_as_float(b[0]) + __uint_as_float(b[1]); }
#define ACC_T const f32x4 (&acc)[2][2][4][2]
__device__ __forceinline__ int opaque_lane() { int l; asm volatile("v_mbcnt_lo_u32_b32 %0, -1, 0\n\tv_mbcnt_hi_u32_b32 %0, -1, %0" : "=v"(l)); return l; }
#define OPAQUE_LANE() const int ol_ = opaque_lane(); const int fr = ol_ & 15, fq = ol_ >> 4;

struct EpiQKV {
  static constexpr bool PERM = true, AFTER_DRAIN = false;
  bf16_t *Q, *KV; const float* ss; const float* cs; const float* sn;
  __device__ __forceinline__ void operator()(ACC_T, const Unit& u, int wr, int wc, int fr_, int fq_) const { OPAQUE_LANE()
    const int sect = u.pn >> 2; bf16_t* base = KV + (size_t)(sect > 0 ? sect - 1 : 0) * NTOK * DM; if (sect == 0) base = Q;
#pragma unroll
    for (int ai = 0; ai < 2; ++ai)
#pragma unroll
      for (int m = 0; m < 4; ++m) {
        const int row = u.pm * 256 + ai * 128 + wr * 64 + m * 16 + fr; const float rs = rstd_of(ss[row]) * (sect == 0 ? 0.18033688011112042f : 1.0f);
        bf16_t* rowp = base + (size_t)row * DM;
        if (sect < 2) {
          const int pos = row < HALF_TOK ? (row & 16383) : (row & 2047);
          const int col = ((u.pn & 3) * 4 + wc) * 64 + 8 * fq;
          u32x4 w1, w2;
          { const f32x4 c0 = *(const f32x4*)(cs + pos * 32 + 8 * fq), s0 = *(const f32x4*)(sn + pos * 32 + 8 * fq);
            const f32x4 x1 = acc[ai][0][m][0] * rs, x2 = acc[ai][1][m][0] * rs; const f32x4 o1 = x1 * c0 - x2 * s0, o2 = x2 * c0 + x1 * s0;
            w1.x = cvt_pk_bf16(o1[0], o1[1]); w1.y = cvt_pk_bf16(o1[2], o1[3]); w2.x = cvt_pk_bf16(o2[0], o2[1]); w2.y = cvt_pk_bf16(o2[2], o2[3]); }
          asm volatile("" ::: "memory");
          { const f32x4 c1 = *(const f32x4*)(cs + pos * 32 + 8 * fq + 4), s1 = *(const f32x4*)(sn + pos * 32 + 8 * fq + 4);
            const f32x4 x1 = acc[ai][0][m][1] * rs, x2 = acc[ai][1][m][1] * rs; const f32x4 o1 = x1 * c1 - x2 * s1, o2 = x2 * c1 + x1 * s1;
            w1.z = cvt_pk_bf16(o1[0], o1[1]); w1.w = cvt_pk_bf16(o1[2], o1[3]); w2.z = cvt_pk_bf16(o2[0], o2[1]); w2.w = cvt_pk_bf16(o2[2], o2[3]); }
          *(u32x4*)(rowp + col) = w1; *(u32x4*)(rowp + col + 32) = w2;
          asm volatile("" ::: "memory");
        } else {
#pragma unroll
          for (int bj = 0; bj < 2; ++bj) { const int col = (u.pn & 3) * 256 + bj * 128 + wc * 32 + 8 * fq;
            *(u32x4*)(rowp + col) = pack8(acc[ai][bj][m][0] * rs, acc[ai][bj][m][1] * rs); }
          asm volatile("" ::: "memory");
        }
      }
  }
};

template <int KIND> struct EpiRes {
  static constexpr bool PERM = true, AFTER_DRAIN = false;
  const float* xa; const float* xb_src; const bf16_t* xsrc; bf16_t* xbo; float* ssn; const float* ss; const bf16_t* pp; int rowoff;
  __device__ __forceinline__ void operator()(ACC_T, const Unit& u, int wr, int wc, int fr_, int fq_) const { OPAQUE_LANE()
    const int colb = u.pn * 256 + wc * 32 + 8 * fq; const int rowb = rowoff + u.pm * 256 + wr * 64 + fr;
    f32x4 cx[4], nx[4]; u32x4 cb[2], nb[2], cp[2], np[2]; float crs = 1.f, nrs = 1.f;
#define RES_LOAD(X, XB_, PPV, RS, idx) do { const int row_ = rowb + ((idx) >> 2) * 128 + ((idx) & 3) * 16; \
      if (KIND == 0) { const float* xr_ = (row_ < HALF_TOK ? xa + (size_t)row_ * DM : xb_src + (size_t)(row_ - HALF_TOK) * DM); \
        X[0] = *(const f32x4*)(xr_ + colb); X[1] = *(const f32x4*)(xr_ + colb + 4); X[2] = *(const f32x4*)(xr_ + colb + 128); X[3] = *(const f32x4*)(xr_ + colb + 132); } \
      else { XB_[0] = *(const u32x4*)(xsrc + (size_t)row_ * DM + colb); XB_[1] = *(const u32x4*)(xsrc + (size_t)row_ * DM + colb + 128); } \
      if (KIND == 2) { PPV[0] = *(const u32x4*)(pp + (size_t)row_ * DM + colb); PPV[1] = *(const u32x4*)(pp + (size_t)row_ * DM + colb + 128); RS = rstd_of(ss[row_]); } } while (0)
    RES_LOAD(cx, cb, cp, crs, 0);
#pragma unroll
    for (int idx = 0; idx < 8; ++idx) {
      const int ai = idx >> 2, m = idx & 3; const int row = rowb + ai * 128 + m * 16;
      if (idx < 7) RES_LOAD(nx, nb, np, nrs, idx + 1);
      float sq = 0.f;
#pragma unroll
      for (int bj = 0; bj < 2; ++bj) { const int col = colb + bj * 128;
        f32x4 d0 = acc[ai][bj][m][0], d1 = acc[ai][bj][m][1];
        if (KIND == 2) { f32x4 p0, p1; unpack8(cp[bj], p0, p1);
#pragma unroll
          for (int j = 0; j < 4; ++j) { d0[j] = sigmoidf_(d0[j] * crs) * p0[j]; d1[j] = sigmoidf_(d1[j] * crs) * p1[j]; } }
        f32x4 a0, a1; if (KIND == 0) { a0 = cx[2 * bj]; a1 = cx[2 * bj + 1]; } else unpack8(cb[bj], a0, a1);
        const f32x4 v0 = a0 + d0, v1 = a1 + d1;
        *(u32x4*)(xbo + (size_t)row * DM + col) = pack8(v0, v1);
        sq += (v0[0] * v0[0] + v0[1] * v0[1]) + (v0[2] * v0[2] + v0[3] * v0[3]) + (v1[0] * v1[0] + v1[1] * v1[1]) + (v1[2] * v1[2] + v1[3] * v1[3]); }
      sq = sum_fq(sq);
      if (fq == 0) atomicAdd(ssn + row, sq);
      asm volatile("" ::: "memory");
      if (KIND == 0) {
#pragma unroll
        for (int t = 0; t < 4; ++t) cx[t] = nx[t]; }
      else { cb[0] = nb[0]; cb[1] = nb[1]; }
      if (KIND == 2) { cp[0] = np[0]; cp[1] = np[1]; crs = nrs; }
    }
#undef RES_LOAD
  }
};

struct EpiStore {
  static constexpr bool PERM = true, AFTER_DRAIN = false;
  bf16_t* O;
  __device__ __forceinline__ void operator()(ACC_T, const Unit& u, int wr, int wc, int fr_, int fq_) const { OPAQUE_LANE()
#pragma unroll
    for (int ai = 0; ai < 2; ++ai)
#pragma unroll
      for (int m = 0; m < 4; ++m) { const int row = u.pm * 256 + ai * 128 + wr * 64 + m * 16 + fr;
#pragma unroll
        for (int bj = 0; bj < 2; ++bj) { const int col = u.pn * 256 + bj * 128 + wc * 32 + 8 * fq;
          *(u32x4*)(O + (size_t)row * DM + col) = pack8(acc[ai][bj][m][0], acc[ai][bj][m][1]); } asm volatile("" ::: "memory"); }
  }
};

struct EpiUV {
  static constexpr bool PERM = true, AFTER_DRAIN = false;
  bf16_t *U, *Vs; const float* ss; float* lns;
  __device__ __forceinline__ void operator()(ACC_T, const Unit& u, int wr, int wc, int fr_, int fq_) const { OPAQUE_LANE()
    const bool isv = u.pn >= 4; bf16_t* base = isv ? Vs : U;
#pragma unroll
    for (int ai = 0; ai < 2; ++ai)
#pragma unroll
      for (int m = 0; m < 4; ++m) { const int row = u.pm * 256 + ai * 128 + wr * 64 + m * 16 + fr; const float rs = rstd_of(ss[row]);
        float s1 = 0.f, s2 = 0.f;
#pragma unroll
        for (int bj = 0; bj < 2; ++bj) { const int col = (u.pn & 3) * 256 + bj * 128 + wc * 32 + 8 * fq;
          const f32x4 v0 = acc[ai][bj][m][0] * rs, v1 = acc[ai][bj][m][1] * rs;
          const f32x2 a = pg8::gelu_pk((f32x2){v0[0], v0[1]}), b = pg8::gelu_pk((f32x2){v0[2], v0[3]}), c = pg8::gelu_pk((f32x2){v1[0], v1[1]}), d = pg8::gelu_pk((f32x2){v1[2], v1[3]});
          s1 += (a.x + a.y) + (b.x + b.y) + (c.x + c.y) + (d.x + d.y);
          s2 += (a.x * a.x + a.y * a.y) + (b.x * b.x + b.y * b.y) + (c.x * c.x + c.y * c.y) + (d.x * d.x + d.y * d.y);
          u32x4 w; w.x = cvt_pk_bf16(a.x, a.y); w.y = cvt_pk_bf16(b.x, b.y); w.z = cvt_pk_bf16(c.x, c.y); w.w = cvt_pk_bf16(d.x, d.y);
          *(u32x4*)(base + (size_t)row * DM + col) = w; asm volatile("" ::: "memory"); }
        if (isv) { s1 = sum_fq(s1); s2 = sum_fq(s2);
          if (fq == 0) { atomicAdd(lns + row, s1); atomicAdd(lns + NTOK + row, s2); } }
        asm volatile("" ::: "memory");
      }
  }
};

struct EpiUp {
  static constexpr bool PERM = true, AFTER_DRAIN = false;
  bf16_t* G; float* HAL; const float* ss; const float* cw; const float* cb; int rowoff;
  __device__ __forceinline__ void operator()(ACC_T, const Unit& u, int wr, int wc, int fr_, int fq_) const { OPAQUE_LANE()
    const int lane = fq * 16 + fr; const int prevl = (lane & 48) | ((fr - 1) & 15), nextl = (lane & 48) | ((fr + 1) & 15);
#pragma unroll
    for (int ai = 0; ai < 2; ++ai) {
      const int R0 = u.pm * 256 + ai * 128 + wr * 64; const int blk = R0 >> 6;
      float rs[4];
#pragma unroll
      for (int m = 0; m < 4; ++m) rs[m] = rstd_of(ss[rowoff + R0 + 16 * m + fr]);
#pragma unroll
      for (int n = 0; n < 2; ++n) {
        const int cv = u.pn * 128 + wc * 32 + 8 * fq + 4 * n;
        const f32x4 wv0 = *(const f32x4*)(cw + cv), wv1 = *(const f32x4*)(cw + NUP + cv), wv2 = *(const f32x4*)(cw + 2 * NUP + cv), bv = *(const f32x4*)(cb + cv);
        const f32x4 wg0 = *(const f32x4*)(cw + FF + cv), wg1 = *(const f32x4*)(cw + NUP + FF + cv), wg2 = *(const f32x4*)(cw + 2 * NUP + FF + cv), bg = *(const f32x4*)(cb + FF + cv);
        f32x4 av[4], ag[4];
#pragma unroll
        for (int m = 0; m < 4; ++m) { av[m] = acc[ai][0][m][n] * rs[m]; ag[m] = acc[ai][1][m][n] * rs[m]; }
#pragma unroll
        for (int m = 0; m < 4; ++m) {
          f32x4 pv, pg, nv, ng;
#pragma unroll
          for (int j = 0; j < 4; ++j) {
            const float sv = (fr == 15) ? (m > 0 ? av[m > 0 ? m - 1 : 0][j] : 0.f) : av[m][j];
            const float sg = (fr == 15) ? (m > 0 ? ag[m > 0 ? m - 1 : 0][j] : 0.f) : ag[m][j];
            pv[j] = __shfl(sv, prevl); pg[j] = __shfl(sg, prevl);
            const float tv = (fr == 0) ? (m < 3 ? av[m < 3 ? m + 1 : 3][j] : 0.f) : av[m][j];
            const float tg = (fr == 0) ? (m < 3 ? ag[m < 3 ? m + 1 : 3][j] : 0.f) : ag[m][j];
            nv[j] = __shfl(tv, nextl); ng[j] = __shfl(tg, nextl);
          }
          const f32x4 c_v = bv + wv0 * pv + wv1 * av[m] + wv2 * nv, c_g = bg + wg0 * pg + wg1 * ag[m] + wg2 * ng;
          const bool first = (m == 0 && fr == 0), last = (m == 3 && fr == 15);
          if (first) { float* h = HAL + (size_t)(blk * 4) * NUP; *(f32x4*)(h + cv) = av[m]; *(f32x4*)(h + FF + cv) = ag[m]; *(f32x4*)(h + 2 * NUP + cv) = c_v; *(f32x4*)(h + 2 * NUP + FF + cv) = c_g; }
          else if (last) { float* h = HAL + (size_t)(blk * 4) * NUP; *(f32x4*)(h + NUP + cv) = av[m]; *(f32x4*)(h + NUP + FF + cv) = ag[m]; *(f32x4*)(h + 3 * NUP + cv) = c_v; *(f32x4*)(h + 3 * NUP + FF + cv) = c_g; }
          else { u32x2 w; w.x = cvt_pk_bf16(c_g[0] * sigmoidf_(c_g[0]) * c_v[0], c_g[1] * sigmoidf_(c_g[1]) * c_v[1]); w.y = cvt_pk_bf16(c_g[2] * sigmoidf_(c_g[2]) * c_v[2], c_g[3] * sigmoidf_(c_g[3]) * c_v[3]);
            *(u32x2*)(G + (size_t)(R0 + 16 * m + fr) * FF + cv) = w; }
          asm volatile("" ::: "memory");
        }
      }
    }
  }
};
#undef ACC_T
}
namespace at {
using bf16x8 = __attribute__((ext_vector_type(8))) short;
using s16x4 = __attribute__((ext_vector_type(4))) short;
using f32x16 = __attribute__((ext_vector_type(16))) float;
using u32x4 = __attribute__((ext_vector_type(4))) unsigned;
typedef unsigned short bf16_t;
constexpr int D = 128, NW = 8, QBLK = 32, KVBLK = 64, LD = 1024;
constexpr float THR = 11.5f;
constexpr size_t SHM_V = KVBLK * D * 2, SHM_K = KVBLK * D * 2;
constexpr size_t NSLOT = 3, OFF_K = NSLOT * SHM_V, OFF_WS = NSLOT * (SHM_V + SHM_K), OFF_X = 0, ATT_LDS = OFF_WS + NW * 64 * 4;
#define KSWZ(row, colB) ((row) * 256 + ((colB) ^ (((row) & 7) << 4)))
#define SBAR() __builtin_amdgcn_sched_barrier(0)
__device__ __forceinline__ int crow(int r, int hi) { return (r & 3) + 8 * (r >> 2) + 4 * hi; }
__device__ __forceinline__ unsigned cvtpk(float lo, float hi) { unsigned r; asm volatile("v_cvt_pk_bf16_f32 %0, %1, %2" : "=v"(r) : "v"(lo), "v"(hi)); return r; }
template <bool FAST> __device__ __forceinline__ void partialSM(f32x16& p0, f32x16& p1, float& m_reg, float& mn, float& alpha) {
  if constexpr (FAST) {
#pragma unroll
    for (int r = 0; r < 16; ++r) p0[r] = __builtin_amdgcn_exp2f(p0[r]);
    alpha = 1.f; mn = 0.f;
  } else {
  float pmax = p0[0];
#pragma unroll
  for (int r = 1; r < 16; ++r) pmax = fmaxf(pmax, p0[r]);
#pragma unroll
  for (int r = 0; r < 16; ++r) pmax = fmaxf(pmax, p1[r]);
  { auto rr = __builtin_amdgcn_permlane32_swap(__float_as_uint(pmax), __float_as_uint(pmax), false, false);
    pmax = fmaxf(__uint_as_float(rr[0]), __uint_as_float(rr[1])); }
  if (__builtin_expect(__all(pmax - m_reg <= THR), 1)) { mn = m_reg; alpha = 1.f; }
  else { mn = fmaxf(m_reg, pmax); alpha = __builtin_amdgcn_exp2f(m_reg - mn); m_reg = mn; }
#pragma unroll
  for (int r = 0; r < 16; ++r) p0[r] = p0[r] - mn;
#pragma unroll
  for (int r = 0; r < 16; ++r) p1[r] = p1[r] - mn;
#pragma unroll
  for (int r = 0; r < 16; ++r) p0[r] = __builtin_amdgcn_exp2f(p0[r]);
  }
}
__device__ __forceinline__ void finishSM(f32x16& p0, f32x16& p1, float alpha, float& l_reg, bf16x8& pa0, bf16x8& pa1, bf16x8& pa2, bf16x8& pa3) {
#pragma unroll
  for (int r = 0; r < 16; ++r) p1[r] = __builtin_amdgcn_exp2f(p1[r]);
  typedef float f32x2_ __attribute__((ext_vector_type(2)));
  f32x2_ s2 = (f32x2_){p0[0], p0[1]} + (f32x2_){p1[0], p1[1]};
#pragma unroll
  for (int r = 2; r < 16; r += 2) { s2 += (f32x2_){p0[r], p0[r + 1]}; s2 += (f32x2_){p1[r], p1[r + 1]}; }
  float ps = s2[0] + s2[1];
  { auto rr = __builtin_amdgcn_permlane32_swap(__float_as_uint(ps), __float_as_uint(ps), false, false);
    ps = __uint_as_float(rr[0]) + __uint_as_float(rr[1]); }
  l_reg = l_reg * alpha + ps;
#define PK4(P, BASE, OUT) do { unsigned a0 = cvtpk(P[BASE + 0], P[BASE + 1]), a1 = cvtpk(P[BASE + 2], P[BASE + 3]);   \
    unsigned b0 = cvtpk(P[BASE + 4], P[BASE + 5]), b1 = cvtpk(P[BASE + 6], P[BASE + 7]);                              \
    auto r0 = __builtin_amdgcn_permlane32_swap(a0, b0, false, false); auto r1 = __builtin_amdgcn_permlane32_swap(a1, b1, false, false); \
    u32x4 w = {r0[0], r1[0], r0[1], r1[1]}; OUT = *reinterpret_cast<bf16x8*>(&w); } while (0)
  PK4(p0, 0, pa0); PK4(p0, 8, pa1); PK4(p1, 0, pa2); PK4(p1, 8, pa3);
#undef PK4
}
__device__ __forceinline__ void qkt(f32x16& p0, f32x16& p1, const char* Ks, const bf16x8* qr, int r32, int hi, int ms) {
  p0 = f32x16{}; p1 = f32x16{};
#pragma unroll
  for (int d0 = 0; d0 < 4; ++d0) { int cb = (ms * 64 + d0 * 16 + hi * 8) * 2;
    bf16x8 b0 = *reinterpret_cast<const bf16x8*>(Ks + KSWZ(r32, cb));
    bf16x8 b1 = *reinterpret_cast<const bf16x8*>(Ks + KSWZ(32 + r32, cb));
    p0 = __builtin_amdgcn_mfma_f32_32x32x16_bf16(b0, qr[d0], p0, 0, 0, 0);
    p1 = __builtin_amdgcn_mfma_f32_32x32x16_bf16(b1, qr[d0], p1, 0, 0, 0); }
}
__device__ __forceinline__ int v_st(int k, int c) { const int kk = (k & ~0xC) | ((k & 4) << 1) | ((k & 8) >> 1); return ((kk >> 3) * 4 + (c >> 5)) * 512 + ((kk & 7) * 32 + (c & 31)) * 2; }
__device__ __forceinline__ int v_rd_base(int lane) { return ((lane & 3) << 3) | (((lane >> 2) & 3) << 6) | (((lane >> 4) & 1) << 5) | (((lane >> 5) & 1) << 8); }
constexpr int v_rd_off(int d0, int ks, int half) { return d0 * 512 + ks * 4096 + half * 2048; }
typedef short v4i16_t __attribute__((ext_vector_type(4)));
typedef const __attribute__((address_space(3))) char* lds_cptr;
template <int OFF> __device__ __forceinline__ s16x4 tr_read(lds_cptr vb) {
  return __builtin_bit_cast(s16x4, __builtin_amdgcn_ds_read_tr16_b64_v4i16((__attribute__((address_space(3))) v4i16_t*)(vb + OFF)));
}
template <int D0> __device__ __forceinline__ void pv_one(f32x16& od, lds_cptr vb, bf16x8 pa0, bf16x8 pa1, bf16x8 pa2, bf16x8 pa3) {
  const s16x4 l0 = tr_read<v_rd_off(D0, 0, 0)>(vb), h0 = tr_read<v_rd_off(D0, 0, 1)>(vb), l1 = tr_read<v_rd_off(D0, 1, 0)>(vb), h1 = tr_read<v_rd_off(D0, 1, 1)>(vb);
  const s16x4 l2 = tr_read<v_rd_off(D0, 2, 0)>(vb), h2 = tr_read<v_rd_off(D0, 2, 1)>(vb), l3 = tr_read<v_rd_off(D0, 3, 0)>(vb), h3 = tr_read<v_rd_off(D0, 3, 1)>(vb);
#define PK(L, H) (bf16x8){L[0], L[1], L[2], L[3], H[0], H[1], H[2], H[3]}
  od = __builtin_amdgcn_mfma_f32_32x32x16_bf16(pa0, PK(l0, h0), od, 0, 0, 0);
  od = __builtin_amdgcn_mfma_f32_32x32x16_bf16(pa1, PK(l1, h1), od, 0, 0, 0);
  od = __builtin_amdgcn_mfma_f32_32x32x16_bf16(pa2, PK(l2, h2), od, 0, 0, 0);
  od = __builtin_amdgcn_mfma_f32_32x32x16_bf16(pa3, PK(l3, h3), od, 0, 0, 0);
#undef PK
}
__device__ __forceinline__ void pv_d0(f32x16* o, lds_cptr vb, bf16x8 pa0, bf16x8 pa1, bf16x8 pa2, bf16x8 pa3) {
  pv_one<0>(o[0], vb, pa0, pa1, pa2, pa3); pv_one<1>(o[1], vb, pa0, pa1, pa2, pa3); pv_one<2>(o[2], vb, pa0, pa1, pa2, pa3); pv_one<3>(o[3], vb, pa0, pa1, pa2, pa3);
}
template <bool FAST> __device__ __forceinline__ bool diff_unit(const bf16_t* __restrict__ Q, const bf16_t* __restrict__ K, const bf16_t* __restrict__ V, bf16_t* __restrict__ AO,
                                          long tq0, long tk0, int seq, int h, float lam, const float* __restrict__ subg, char* lds) {
  int tid_ = threadIdx.x; asm volatile("" : "+v"(tid_)); const int tid = tid_, wid = tid >> 6, lane = tid & 63, r32 = lane & 31, hi = lane >> 5, pr = wid & 3, ms = wid >> 2;
  char* V_lds = lds; char* K_lds = lds + OFF_K;
  float* wsf = (float*)(lds + OFF_WS) + wid * 64; float* li_l = wsf; float* al_l = wsf + 32;
  float* X = (float*)(lds + OFF_X) + pr * (32 * 128);
  float m_reg = -1e30f, l_reg = 0; f32x16 o[4] = {}; bf16x8 qr[4];
  const bf16_t* Qw = Q + (tq0 + pr * QBLK + r32) * LD + (2 * h + ms) * 64 + hi * 8;
#pragma unroll
  for (int d0 = 0; d0 < 4; ++d0) qr[d0] = *reinterpret_cast<const bf16x8*>(Qw + d0 * 16);
  const bf16_t* Kh = K + tk0 * LD + h * 128; const bf16_t* Vh = V + tk0 * LD + h * 128;
  const int sr = tid >> 4, sc = (tid & 15) * 8, vst0 = v_st(sr, sc), vst1 = v_st(32 + sr, sc);
  const lds_cptr vb0 = (lds_cptr)V_lds + v_rd_base(lane);
  struct { bf16x8 vs0, vs1, ks0, ks1; } sr_[2];
#define SLOAD(i, k0) do { sr_[i].vs0 = *(const bf16x8*)(&Vh[(long)((k0) + sr) * LD + sc]); sr_[i].vs1 = *(const bf16x8*)(&Vh[(long)((k0) + 32 + sr) * LD + sc]); \
    sr_[i].ks0 = *(const bf16x8*)(&Kh[(long)((k0) + sr) * LD + sc]); sr_[i].ks1 = *(const bf16x8*)(&Kh[(long)((k0) + 32 + sr) * LD + sc]); } while (0)
#define SWRITE(off, i) do { *(bf16x8*)(V_lds + (off) + vst0) = sr_[i].vs0;          \
    *(bf16x8*)(V_lds + (off) + vst1) = sr_[i].vs1; int kc = sc * 2;               \
    *(bf16x8*)(K_lds + (off) + KSWZ(sr, kc)) = sr_[i].ks0;                       \
    *(bf16x8*)(K_lds + (off) + KSWZ(32 + sr, kc)) = sr_[i].ks1; } while (0)
#define SWAIT() asm volatile("s_waitcnt vmcnt(4)" ::: "memory")
#define RESC(a) do { if (!FAST) if (__any((a) < 1.f)) { if (hi == 0) al_l[r32] = (a); asm volatile("s_waitcnt lgkmcnt(0)" ::: "memory"); \
    _Pragma("unroll") for (int d = 0; d < 4; ++d) _Pragma("unroll") for (int r = 0; r < 16; ++r) o[d][r] *= al_l[crow(r, hi)]; } } while (0)
  f32x16 pA0, pA1, pB0, pB1; float mnA, mnB, alA, alB; bf16x8 pa0, pa1, pa2, pa3; const int NT = seq / KVBLK;
  constexpr int SE = 0, SO = 1;
  int s0 = 0, s1 = (int)SHM_V, s2 = 2 * (int)SHM_V;
  SLOAD(SE, 0); asm volatile("s_waitcnt vmcnt(0)" ::: "memory"); SWRITE(0, SE); __syncthreads();
  qkt(pA0, pA1, K_lds, qr, r32, hi, ms); partialSM<FAST>(pA0, pA1, m_reg, mnA, alA); RESC(alA);
  SLOAD(SO, KVBLK); if (2 < NT) SLOAD(SE, 2 * KVBLK);
  SWAIT(); SWRITE(s1, SO); __syncthreads();
  for (int j = 1; j + 1 < NT; j += 2) {
    SBAR(); qkt(pB0, pB1, K_lds + s1, qr, r32, hi, ms);
    finishSM(pA0, pA1, alA, l_reg, pa0, pa1, pa2, pa3); SBAR();
    SLOAD(SO, (j + 2) * KVBLK); SBAR();
    SWAIT(); SWRITE(s2, SE);
    pv_d0(o, vb0 + s0, pa0, pa1, pa2, pa3); partialSM<FAST>(pB0, pB1, m_reg, mnB, alB); RESC(alB);
    __syncthreads();
    SBAR(); qkt(pA0, pA1, K_lds + s2, qr, r32, hi, ms);
    finishSM(pB0, pB1, alB, l_reg, pa0, pa1, pa2, pa3); SBAR();
    if (j + 3 < NT) SLOAD(SE, (j + 3) * KVBLK); SBAR();
    SWAIT(); SWRITE(s0, SO);
    pv_d0(o, vb0 + s1, pa0, pa1, pa2, pa3); partialSM<FAST>(pA0, pA1, m_reg, mnA, alA); RESC(alA);
    __syncthreads();
    { const int t = s0; s0 = s2; s2 = s1; s1 = t; }
  }
  SBAR(); qkt(pB0, pB1, K_lds + s1, qr, r32, hi, ms);
  finishSM(pA0, pA1, alA, l_reg, pa0, pa1, pa2, pa3); SBAR();
  pv_d0(o, vb0 + s0, pa0, pa1, pa2, pa3); partialSM<FAST>(pB0, pB1, m_reg, mnB, alB); RESC(alB);
  finishSM(pB0, pB1, alB, l_reg, pa0, pa1, pa2, pa3); SBAR();
  pv_d0(o, vb0 + s1, pa0, pa1, pa2, pa3);
  __syncthreads();
  if constexpr (FAST) { const int bad = !(l_reg > 1e-30f && l_reg < 1e30f); if (__syncthreads_or(bad)) return true; }
  if (hi == 0) li_l[r32] = l_reg; asm volatile("s_waitcnt lgkmcnt(0)" ::: "memory");
  float rli[16];
#pragma unroll
  for (int r = 0; r < 16; ++r) rli[r] = __builtin_amdgcn_rcpf(li_l[crow(r, hi)]);
  if (ms == 1) {
#pragma unroll
    for (int r = 0; r < 16; ++r)
#pragma unroll
      for (int d0 = 0; d0 < 4; ++d0) X[crow(r, hi) * 128 + d0 * 32 + r32] = o[d0][r] * rli[r];
  }
  __syncthreads();
  if (ms == 0) {
    float sg[4];
#pragma unroll
    for (int d0 = 0; d0 < 4; ++d0) sg[d0] = subg[d0 * 32 + r32] * 0.8f;
#pragma unroll
    for (int r = 0; r < 16; ++r) {
      float v[4]; float sq = 0.f;
#pragma unroll
      for (int d0 = 0; d0 < 4; ++d0) { v[d0] = o[d0][r] * rli[r] - lam * X[crow(r, hi) * 128 + d0 * 32 + r32]; sq += v[d0] * v[d0]; }
      sq += __shfl_xor(sq, 1); sq += __shfl_xor(sq, 2); sq += __shfl_xor(sq, 4); sq += __shfl_xor(sq, 8); sq += __shfl_xor(sq, 16);
      const float rs = 1.0f / sqrtf(sq * (1.0f / 128.0f) + 1e-6f);
      bf16_t* orow = AO + (tq0 + pr * QBLK + crow(r, hi)) * LD + h * 128 + r32;
#pragma unroll
      for (int d0 = 0; d0 < 4; ++d0) orow[d0 * 32] = (bf16_t)(cvtpk(v[d0] * rs * sg[d0], 0.f) & 0xffffu);
    }
  }
  __syncthreads();
  return false;
#undef SLOAD
#undef SWRITE
#undef SWAIT
#undef RESC
}
#undef KSWZ
#undef SBAR
}
namespace fk {
#define LAS3 __attribute__((address_space(3)))
constexpr int NWAVES = 8, NTHR = 512;
constexpr int LDS_BYTES = 147456;
constexpr int NPH = 22;

__device__ __forceinline__ int otid() { int t = threadIdx.x; asm volatile("" : "+v"(t)); return t; }
__device__ __forceinline__ float wave_sum(float v) {
#pragma unroll
  for (int o = 1; o < 64; o <<= 1) v += __shfl_xor(v, o);
  return v;
}
__device__ __forceinline__ unsigned f2bf(float f) { unsigned u = __builtin_bit_cast(unsigned, f); return (u + 0x7fffu + ((u >> 16) & 1u)) >> 16; }
__device__ __forceinline__ unsigned pk2(float lo, float hi) { return f2bf(lo) | (f2bf(hi) << 16); }

__device__ __forceinline__ int srcblk(int mode, int n0) {
  if (mode == 1) { const int pn = n0 >> 8; if (pn >= 8) return n0; const int bj = (n0 >> 7) & 1, wc = (n0 >> 5) & 3; return pn * 256 + wc * 64 + bj * 32; }
  if (mode == 2) { const int pn = n0 >> 8, bj = (n0 >> 7) & 1, i = n0 & 127; return bj * FF + pn * 128 + i; }
  return n0;
}
__device__ __forceinline__ void transpose_item(const float* __restrict__ W, int K, int N, const float* __restrict__ gk, int mode, bf16_t* __restrict__ WT, float* scr, int item, int lane) {
  const int nblk = N / 32, kb = item / nblk, nb = item % nblk, k0 = 64 * kb, n0 = 32 * nb, s0 = srcblk(mode, n0);
#pragma unroll 8
  for (int i = 0; i < 32; ++i) { const int kk = 2 * i + (lane >> 5); float w = W[(size_t)(k0 + kk) * N + s0 + (lane & 31)]; if (gk) w *= gk[k0 + kk]; scr[kk * 33 + (lane & 31)] = w; }
  asm volatile("s_waitcnt lgkmcnt(0)" ::: "memory");
  const int c = lane & 7;
#pragma unroll
  for (int j = 0; j < 4; ++j) { const int n = (lane >> 3) + 8 * j; const float* s = scr + (8 * c) * 33 + n;
    u32x4 o; o.x = pk2(s[0 * 33], s[1 * 33]); o.y = pk2(s[2 * 33], s[3 * 33]); o.z = pk2(s[4 * 33], s[5 * 33]); o.w = pk2(s[6 * 33], s[7 * 33]);
    *(u32x4*)(WT + (size_t)(n0 + n) * K + k0 + 8 * c) = o; }
  asm volatile("s_waitcnt lgkmcnt(0)" ::: "memory");
}
__device__ __forceinline__ void row_to_bf16_ss(const float* xrow, bf16_t* orow, float* ssp, int lane) {
  const f32x4* xr = (const f32x4*)xrow + lane; f32x4 v[4]; float s = 0.f;
#pragma unroll
  for (int j = 0; j < 4; ++j) { v[j] = xr[64 * j]; s += (v[j][0] * v[j][0] + v[j][1] * v[j][1]) + (v[j][2] * v[j][2] + v[j][3] * v[j][3]); }
  s = wave_sum(s);
  unsigned long long* o8 = (unsigned long long*)orow + lane;
#pragma unroll
  for (int j = 0; j < 4; ++j) o8[64 * j] = (unsigned long long)pk2(v[j][0], v[j][1]) | ((unsigned long long)pk2(v[j][2], v[j][3]) << 32);
  if (lane == 0) *ssp = s;
}
struct WJob { const float* W; int K, N; const float* gk; int mode; size_t dst; };

__device__ __forceinline__ void prep_phase(const Params& P, char* lds, int vcu, int G) {
  const int tid = otid(), lane = tid & 63, wave = tid >> 6;
  float* scr = (float*)(lds + wave * 16384);
  const int gw = vcu * NWAVES + wave, NGW = G * NWAVES; unsigned char* ws = P.ws;
#define TJOB(Wp, K_, N_, gk_, mode_, dst_) { const int nit = ((K_) / 64) * ((N_) / 32); for (int it = gw; it < nit; it += NGW) transpose_item(Wp, K_, N_, gk_, mode_, (bf16_t*)(ws + (dst_)), scr, it, lane); }
  TJOB(P.in[5], 1024, 3072, P.in[4], 1, WS_WQKV)
  TJOB(P.in[11], 1024, 1024, nullptr, 0, WS_WO)
  TJOB(P.in[12], 1024, 2048, P.in[4] + 1024, 0, WS_WUV)
  TJOB(P.in[17], 1024, 1024, nullptr, 0, WS_WOUT)
#pragma unroll 1
  for (int L = 0; L < 2; ++L) {
    TJOB(P.in[19] + (size_t)L * 1024 * NUP, 1024, NUP, P.in[18] + L * 1024, 2, WS_WUP + (size_t)L * 11 * MiB)
    TJOB(P.in[22] + (size_t)L * FF * 1024, FF, 1024, nullptr, 0, WS_WDN + (size_t)L * (11 * MiB / 2))
    TJOB(P.in[24] + (size_t)L * 1024 * 1024, 1024, 1024, P.in[23] + L * 1024, 0, WS_WG + (size_t)L * 2 * MiB)
    TJOB(P.in[25] + (size_t)L * 256 * 1024, 256, 1024, nullptr, 0, WS_WP + (size_t)L * (MiB / 2))
  }
#undef TJOB
  for (int m = gw; m < NTOK; m += NGW) { const float* xr = m < HALF_TOK ? P.xin_a + (size_t)m * DM : P.xin_b + (size_t)(m - HALF_TOK) * DM;
    row_to_bf16_ss(xr, (bf16_t*)(ws + WS_XB) + (size_t)m * DM, (float*)(ws + WS_SS) + m, lane); }
  const size_t gt = (size_t)vcu * NTHR + tid, GT = (size_t)G * NTHR;
  for (size_t i = gt; i < (size_t)2 * NTOK * 256 / 8; i += GT) { const size_t e = i * 8; const int L = (int)(e / ((size_t)NTOK * 256)); const size_t r = e % ((size_t)NTOK * 256);
    const float* src = r < (size_t)HALF_TOK * 256 ? P.in[2] + (size_t)L * HALF_TOK * 256 + r : P.in[3] + (size_t)L * HALF_TOK * 256 + (r - (size_t)HALF_TOK * 256);
    const f32x4 a = *(const f32x4*)src, b = *(const f32x4*)(src + 4); *(u32x4*)((bf16_t*)(ws + WS_PB) + e) = pack8(a, b); }
  for (size_t i = gt; i < (size_t)16384 * 32; i += GT) { const int d = (int)(i & 31), pos = (int)(i >> 5);
    const float inv = 1.0f / powf(10000.0f, (float)(2 * d) / 64.0f); const float ang = (float)pos * inv;
    const double tw = 6.283185307179586476925; double r = (double)ang; r -= tw * rint(r / tw); const float rf = (float)r;
    ((float*)(ws + WS_COS))[i] = cosf(rf); ((float*)(ws + WS_SIN))[i] = sinf(rf); }
  for (size_t i = gt; i < (size_t)8 * 128 * 128 / 8; i += GT) { const float* src = P.in[15] + i * 8; *(u32x4*)((bf16_t*)(ws + WS_WSP) + i * 8) = pack8(*(const f32x4*)src, *(const f32x4*)(src + 4)); }
  for (size_t i = gt; i < (size_t)6 * NTOK; i += GT) ((float*)(ws + WS_SS))[NTOK + i] = 0.f;
  for (size_t i = gt; i < (size_t)2 * NTOK; i += GT) ((float*)(ws + WS_LNS))[i] = 0.f;
  if (vcu == 0 && tid == 0) { float d1 = 0.f, d2 = 0.f; for (int i = 0; i < 64; ++i) { d1 += P.in[6][i] * P.in[7][i]; d2 += P.in[8][i] * P.in[9][i]; }
    *(float*)(ws + WS_LAM) = expf(d1) - expf(d2) + 0.2f; }
}

__device__ __forceinline__ void sgu_unit(const Params& P, char* lds, int chunk, int g) {
  const int tid = otid(), lane = tid & 63, w = tid >> 6; unsigned char* ws = P.ws;
  bf16_t* vT = (bf16_t*)lds; bf16_t* Wsm = (bf16_t*)(lds + 34816); float* st_mean = (float*)(lds + 69632); float* st_rstd = st_mean + 128;
  bf16_t* U = (bf16_t*)(ws + WS_R1); const bf16_t* Vs = (const bf16_t*)(ws + WS_XB); const float* lns = (const float*)(ws + WS_LNS);
  if (tid < 128) { const int row = chunk * 128 + tid; const float mean = lns[row] * (1.0f / 1024.0f); const float var = lns[NTOK + row] * (1.0f / 1024.0f) - mean * mean;
    st_mean[tid] = mean; st_rstd[tid] = 1.0f / sqrtf(fmaxf(var, 0.f) + EPS); }
  const int c8 = (tid & 15) * 8;
#pragma unroll
  for (int i = 0; i < 4; ++i) { const int p = (tid >> 4) + 32 * i; *(u32x4*)(Wsm + p * 136 + c8) = *(const u32x4*)((const bf16_t*)(ws + WS_WSP) + (size_t)(g * 128 + p) * 128 + c8); }
  __syncthreads();
  { const float* lng = P.in[13] + g * 128 + c8; const float* lnb = P.in[14] + g * 128 + c8;
    const f32x4 g0 = *(const f32x4*)lng, g1 = *(const f32x4*)(lng + 4), b0 = *(const f32x4*)lnb, b1 = *(const f32x4*)(lnb + 4);
#pragma unroll
    for (int i = 0; i < 4; ++i) { const int q = (tid >> 4) + 32 * i; f32x4 x0, x1; unpack8(*(const u32x4*)(Vs + (size_t)(chunk * 128 + q) * DM + g * 128 + c8), x0, x1);
      const float mean = st_mean[q], rs = st_rstd[q];
      x0 = (x0 - mean) * rs * g0 + b0; x1 = (x1 - mean) * rs * g1 + b1;
#pragma unroll
      for (int e = 0; e < 4; ++e) { vT[(c8 + e) * 136 + q] = (bf16_t)f2bf(x0[e]); vT[(c8 + 4 + e) * 136 + q] = (bf16_t)f2bf(x1[e]); } } }
  __syncthreads();
  const int i16 = lane & 15, kg = lane >> 4;
  f32x4 acc[8];
#pragma unroll
  for (int cb = 0; cb < 8; ++cb) acc[cb] = (f32x4){0.f, 0.f, 0.f, 0.f};
#pragma unroll
  for (int ks = 0; ks < 4; ++ks) { const bf16x8 bfrag = *(const bf16x8*)(Wsm + (16 * w + i16) * 136 + ks * 32 + kg * 8);
#pragma unroll
    for (int cb = 0; cb < 8; ++cb) { const bf16x8 afrag = *(const bf16x8*)(vT + (16 * cb + i16) * 136 + ks * 32 + kg * 8);
      acc[cb] = __builtin_amdgcn_mfma_f32_16x16x32_bf16(afrag, bfrag, acc[cb], 0, 0, 0); } }
  const int p = 16 * w + i16; const size_t token = (size_t)chunk * 128 + p; const float bias = P.in[16][g * 128 + p];
#pragma unroll
  for (int cb = 0; cb < 8; ++cb) { bf16_t* up = U + token * DM + g * 128 + 16 * cb + 4 * kg; const u32x2 uu = *(const u32x2*)up;
    const float u0 = __uint_as_float(uu.x << 16), u1 = __uint_as_float(uu.x & 0xffff0000u), u2 = __uint_as_float(uu.y << 16), u3 = __uint_as_float(uu.y & 0xffff0000u);
    u32x2 o; o.x = cvt_pk_bf16(u0 * (acc[cb][0] + bias), u1 * (acc[cb][1] + bias)); o.y = cvt_pk_bf16(u2 * (acc[cb][2] + bias), u3 * (acc[cb][3] + bias)); *(u32x2*)up = o; }
  __syncthreads();
}

__device__ __forceinline__ void fixup_phase(const Params& P, int L, int half, int vcu, int G) {
  unsigned char* ws = P.ws; const float* HAL = (const float*)(ws + WS_HALO); bf16_t* Gb = (bf16_t*)(ws + WS_G);
  const float* cw = P.in[20] + (size_t)L * 3 * NUP; const int S = half == 0 ? 16384 : 2048;
  const size_t gt = (size_t)vcu * NTHR + otid(), GT = (size_t)G * NTHR;
  for (size_t i = gt; i < (size_t)512 * 2 * FF; i += GT) { const int f = (int)(i % FF); const int rb = (int)(i / FF); const int blk = rb >> 1, which = rb & 1;
    const int row = blk * 64 + (which ? 63 : 0); const int pos = row % S;
    const float* h = HAL + (size_t)(blk * 4) * NUP;
    float cv = h[(2 + which) * NUP + f], cg = h[(2 + which) * NUP + FF + f];
    if (which == 0) { if (pos != 0) { const float* hp = HAL + (size_t)((blk - 1) * 4 + 1) * NUP; cv += cw[f] * hp[f]; cg += cw[FF + f] * hp[FF + f]; } }
    else { if (pos != S - 1) { const float* hn = HAL + (size_t)((blk + 1) * 4 + 0) * NUP; cv += cw[2 * NUP + f] * hn[f]; cg += cw[2 * NUP + FF + f] * hn[FF + f]; } }
    Gb[(size_t)row * FF + f] = (bf16_t)f2bf(cg * sigmoidf_(cg) * cv); }
}

__device__ __forceinline__ void final_phase(const Params& P, int vcu, int G) {
  const int t_ = otid(); const int lane = t_ & 63, wave = t_ >> 6; const int gw = vcu * NWAVES + wave, NGW = G * NWAVES;
  const float* ss = (const float*)(P.ws + WS_SS) + (size_t)6 * NTOK; const float* g = P.in[26]; const bf16_t* X = (const bf16_t*)(P.ws + WS_R2);
  for (int m = gw; m < NTOK; m += NGW) { const float rs = rstd_of(ss[m]); const u32x4* xr = (const u32x4*)(X + (size_t)m * DM) + lane; f32x4* yr = (f32x4*)(P.out + (size_t)m * DM);
#pragma unroll
    for (int j = 0; j < 2; ++j) { f32x4 a, b; unpack8(xr[64 * j], a, b); const int c4 = (lane + 64 * j) * 2;
      yr[c4] = a * rs * *((const f32x4*)g + c4); yr[c4 + 1] = b * rs * *((const f32x4*)g + c4 + 1); } }
}

__global__ void __launch_bounds__(NTHR, 2) mega(Params P) {
  extern __shared__ __attribute__((aligned(16))) unsigned char lds_raw[];
  cg::grid_group grid = cg::this_grid();
  LAS3 unsigned char* lds3 = (LAS3 unsigned char*)lds_raw; char* lds = (char*)lds_raw;
  const int G = gridDim.x, bx = blockIdx.x; const int vcu = (G % 8 == 0) ? (bx % 8) * (G / 8) + bx / 8 : bx;
  unsigned char* ws = P.ws; const int lo = P.ph_lo, hi = P.ph_hi;
  volatile LAS3 unsigned* MISC = (volatile LAS3 unsigned*)(lds3 + 139264);
  if (threadIdx.x < 4) MISC[threadIdx.x] = 0u;
  __syncthreads();
  xb::XcdBarrier bar = xb::xcd_barrier_post((unsigned*)(ws + WS_BAR), MISC);
  float* SS = (float*)(ws + WS_SS);
  bf16_t* XB = (bf16_t*)(ws + WS_XB); bf16_t* R1 = (bf16_t*)(ws + WS_R1); bf16_t* R2 = (bf16_t*)(ws + WS_R2);
#ifndef ENMASK
#define ENMASK 0xffffffffu
#endif
#define IN(k) (lo <= (k) && (k) < hi)
#define EN(b) (((ENMASK) >> (b)) & 1u)
#define SEAM(k) do { if (IN(k) && IN((k) + 1)) { if ((k) == 0) grid.sync(); else xb::xcd_barrier(bar); } else __syncthreads(); } while (0)
#define GEMM(EpiT, E, Aptr, Bptr, M_, N_, K_) do { pg8::Gemm g_{(const bf16_t*)(Aptr), (const bf16_t*)(Bptr), M_, N_, K_}; pg8::StaticOrder S_; S_.init(M_, N_, G, bx); \
    pg8::gemm_phase<EpiT, pg8::StaticOrder, true, true>(lds3, g_, S_, E); } while (0)

  if (EN(0) && IN(0)) { prep_phase(P, lds, vcu, G); }
  SEAM(0);
  if (EN(1) && IN(1)) { EpiQKV E{R1, (bf16_t*)P.out, SS, (const float*)(ws + WS_COS), (const float*)(ws + WS_SIN)};
    GEMM(EpiQKV, E, XB, ws + WS_WQKV, NTOK, 3072, 1024); }
  SEAM(1);
  if (EN(2) && IN(2)) { const float lam = *(const float*)(ws + WS_LAM); const float* subg = P.in[10];
    const bf16_t* Q = R1; const bf16_t* K = (const bf16_t*)P.out; const bf16_t* V = K + (size_t)NTOK * DM; bf16_t* AO = R2;
    const int nu = (G == 256) ? 16 : (4096 + G - 1) / G;
#define ATT_UNIT_ARGS(i) \
      int ui; if (G == 256) { const int x = vcu >> 5, j = vcu & 31; ui = ((i) < 8) ? ((2 * x + ((i) >> 2)) * 128 + j + 32 * ((i) & 3)) : (2048 + (16 * x) * 16 + ((i) - 8) * 32 + j); } \
      else { ui = bx + (i) * G; if (ui >= 4096) break; } \
      long tq0, tk0; int seq, h; \
      if (ui < 2048) { const int ph = ui >> 7, qb = ui & 127; tk0 = (long)(ph >> 3) * 16384; tq0 = tk0 + qb * 128; seq = 16384; h = ph & 7; } \
      else { const int v = ui - 2048, pair = v >> 4, qb = v & 15; tk0 = (long)HALF_TOK + (long)(pair >> 3) * 2048; tq0 = tk0 + qb * 128; seq = 2048; h = pair & 7; }
    unsigned long long badmask = 0ull;
#ifdef PROBE_FORCE_SAFE
    badmask = ~0ull;
#endif
#pragma unroll 1
    for (int i = 0; i < nu && i < 64; ++i) { ATT_UNIT_ARGS(i)
      if (at::diff_unit<true>(Q, K, V, AO, tq0, tk0, seq, h, lam, subg, lds)) badmask |= 1ull << i; }
#pragma unroll 1
    for (int i = 0; i < nu && i < 64; ++i) { if (!((badmask >> i) & 1ull)) continue; ATT_UNIT_ARGS(i)
      (void)at::diff_unit<false>(Q, K, V, AO, tq0, tk0, seq, h, lam, subg, lds); }
#undef ATT_UNIT_ARGS
  }
  SEAM(2);
  if (EN(3) && IN(3)) { EpiRes<0> E{P.xin_a, P.xin_b, nullptr, XB, SS + 1 * NTOK, nullptr, nullptr, 0}; GEMM(EpiRes<0>, E, R2, ws + WS_WO, NTOK, 1024, 1024); }
  SEAM(3);
#pragma unroll 1
  for (int L = 0; L < 2; ++L) {
    const int pb = 4 + 10 * L;
    if (L == 1) {
      if (EN(11) && IN(11)) { EpiUV E{R1, XB, SS + 3 * NTOK, (float*)(ws + WS_LNS)}; GEMM(EpiUV, E, R2, ws + WS_WUV, NTOK, 2048, 1024); }
      SEAM(11);
      if (EN(12) && IN(12)) { for (int ui = vcu; ui < 4096; ui += G) sgu_unit(P, lds, ui >> 3, ui & 7); }
      SEAM(12);
      if (EN(13) && IN(13)) { EpiRes<1> E{nullptr, nullptr, R2, XB, SS + 4 * NTOK, nullptr, nullptr, 0}; GEMM(EpiRes<1>, E, R1, ws + WS_WOUT, NTOK, 1024, 1024); }
      SEAM(13);
    }
#pragma unroll 1
    for (int half = 0; half < 2; ++half) {
      const int p0 = pb + 3 * half; const int rowoff = half * HALF_TOK;
      if (EN(4) && IN(p0)) { EpiUp E{(bf16_t*)(ws + WS_G), (float*)(ws + WS_HALO), SS + (size_t)(1 + 3 * L) * NTOK, P.in[20] + (size_t)L * 3 * NUP, P.in[21] + (size_t)L * NUP, rowoff};
        GEMM(EpiUp, E, XB + (size_t)rowoff * DM, ws + WS_WUP + (size_t)L * 11 * MiB, HALF_TOK, NUP, 1024); }
      SEAM(p0);
      if (EN(5) && IN(p0 + 1)) fixup_phase(P, L, half, vcu, G);
      SEAM(p0 + 1);
      if (EN(6) && IN(p0 + 2)) { EpiRes<1> E{nullptr, nullptr, XB, XB, SS + (size_t)(2 + 3 * L) * NTOK, nullptr, nullptr, rowoff};
        GEMM(EpiRes<1>, E, ws + WS_G, ws + WS_WDN + (size_t)L * (11 * MiB / 2), HALF_TOK, 1024, FF); }
      SEAM(p0 + 2);
    }
    const int pp = pb + 6;
    if (EN(10) && IN(pp)) {
      { EpiStore E{R1}; GEMM(EpiStore, E, (bf16_t*)(ws + WS_PB) + (size_t)L * NTOK * 256, ws + WS_WP + (size_t)L * (MiB / 2), NTOK, 1024, 256); }
      __syncthreads();
      { EpiRes<2> E{nullptr, nullptr, XB, R2, SS + (size_t)(3 + 3 * L) * NTOK, SS + (size_t)(2 + 3 * L) * NTOK, R1, 0};
        GEMM(EpiRes<2>, E, XB, ws + WS_WG + (size_t)L * 2 * MiB, NTOK, 1024, 1024); }
    }
    SEAM(pp);
  }
  if (EN(21) && IN(21)) final_phase(P, vcu, G);
#undef IN
#undef SEAM
#undef EN
#undef GEMM
}
}
#ifndef MODE
#define MODE 0
#endif
#ifndef FASTMASK
#define FASTMASK 0x7f
#endif
namespace fk {
__global__ void __launch_bounds__(256) k_resync(const float* __restrict__ x, bf16_t* __restrict__ xb, float* __restrict__ ss) {
  const int lane = threadIdx.x & 63; const int gw = blockIdx.x * 4 + (threadIdx.x >> 6), NGW = gridDim.x * 4;
  for (int m = gw; m < NTOK; m += NGW) row_to_bf16_ss(x + (size_t)m * DM, xb + (size_t)m * DM, ss + m, lane);
}
}
extern "C" void kernel_launch(void* const* d_in, const int* in_sizes, int n_in, void* d_out, int out_size, void* d_ws, size_t ws_size, hipStream_t stream) {
  static int grid = 0;
  if (grid == 0) {
    if (n_in != 27 || out_size != fk::NTOK * fk::DM || ws_size < (size_t)512 * fk::MiB) { fprintf(stderr, "kernel_launch: unexpected shapes n_in %d out %d ws %zu\n", n_in, out_size, ws_size); grid = -1; return; }
    int dev = 0, cus = 0, per_cu = 0; hipGetDevice(&dev); hipDeviceGetAttribute(&cus, hipDeviceAttributeMultiprocessorCount, dev);
    if (hipFuncSetAttribute((const void*)fk::mega, hipFuncAttributeMaxDynamicSharedMemorySize, fk::LDS_BYTES) != hipSuccess) { fprintf(stderr, "kernel_launch: hipFuncSetAttribute failed\n"); grid = -1; return; }
    if (hipOccupancyMaxActiveBlocksPerMultiprocessor(&per_cu, (const void*)fk::mega, fk::NTHR, fk::LDS_BYTES) != hipSuccess || per_cu < 1) { fprintf(stderr, "kernel_launch: occupancy query says %d\n", per_cu); per_cu = 1; }
    (void)hipGetLastError();
    grid = cus * per_cu; if (grid > 256) grid = 256;
    fprintf(stderr, "kernel_launch: grid %d (cus %d per_cu %d) ws %zu\n", grid, cus, per_cu, ws_size);
  }
  if (grid < 0) return;
  fk::Params p{};
  for (int i = 0; i < 27; ++i) p.in[i] = (const float*)d_in[i];
  p.xin_a = (const float*)d_in[0]; p.xin_b = (const float*)d_in[1]; p.out = (float*)d_out; p.ws = (unsigned char*)d_ws;
#if MODE == 0
  hipMemsetAsync((char*)d_ws + fk::WS_BAR, 0, 16384, stream);
  p.ph_lo = 0; p.ph_hi = fk::NPH; void* args[] = {&p};
  hipError_t e = hipLaunchCooperativeKernel((const void*)fk::mega, dim3(grid), dim3(fk::NTHR), args, fk::LDS_BYTES, stream);
  if (e != hipSuccess) fprintf(stderr, "cooperative launch failed: %s (grid %d)\n", hipGetErrorString(e), grid);
#else
  auto runph = [&](int a, int b) { for (int k = a; k <= b; ++k) { p.ph_lo = k; p.ph_hi = k + 1; hipLaunchKernelGGL(fk::mega, dim3(grid), dim3(fk::NTHR), fk::LDS_BYTES, stream, p); } };
  char* nws = (char*)d_ws + 128 * fk::MiB; float* out = (float*)d_out; unsigned char* ws = (unsigned char*)d_ws;
  hipMemsetAsync((char*)d_ws + fk::WS_BAR, 0, 16384, stream);
  runph(0, 0);
  const int first[7] = {1, 4, 10, 11, 14, 20, 21}, last[7] = {3, 9, 10, 13, 19, 20, 21};
  if (!(FASTMASK & 1)) { hipMemcpyAsync(out, d_in[0], (size_t)fk::HALF_TOK * 1024 * 4, hipMemcpyDeviceToDevice, stream); hipMemcpyAsync(out + (size_t)fk::HALF_TOK * 1024, d_in[1], (size_t)fk::HALF_TOK * 1024 * 4, hipMemcpyDeviceToDevice, stream); }
  for (int s = 0; s < 7; ++s) {
    if (FASTMASK & (1 << s)) {
      if (s > 0) fk::k_resync<<<1024, 256, 0, stream>>>(out, (fk::bf16_t*)(ws + (s == 3 ? fk::WS_R2 : fk::WS_XB)), (float*)(ws + fk::WS_SS) + (size_t)s * fk::NTOK);
      runph(first[s], last[s]);
    } else nv::stage(s, d_in, out, nws, stream);
  }
#endif
}
```

```cpp
#include <hip/hip_runtime.h>
#include <hip/hip_cooperative_groups.h>
#include <cstdio>
#include <cstdint>
namespace cg = cooperative_groups;
#define MODE 0
#define FASTMASK 0x7f
namespace pg8 {
#define PG8_LAS __attribute__((address_space(3)))
typedef unsigned short bf16_t;
typedef short bf16x8 __attribute__((ext_vector_type(8)));
typedef float f32x4 __attribute__((ext_vector_type(4)));
typedef unsigned u32x4 __attribute__((ext_vector_type(4)));
constexpr int BM = 256, BK = 64, HALF = 128, HTB = HALF * BK * 2  , STAGE_BYTES = 8 * HTB, NXCD = 8, WGM = 8;

__host__ __device__ __forceinline__ int lds_byte(int r, int c) { const int st = (r >> 4) * 2 + (c >> 5), rr = r & 15, cc = c & 31, ob = rr * 64 + cc * 2; return st * 1024 + (ob ^ (((ob >> 9) & 1) << 5)); }
__host__ __device__ __forceinline__ void stage_rc(int b, int& R, int& C) { const int st = b / 1024, sb = b % 1024, swz = sb ^ (((sb >> 9) & 1) << 5); R = (st >> 1) * 16 + swz / 64; C = (st & 1) * 32 + (swz % 64) / 2; }
__host__ __device__ __forceinline__ int perm32(int rho) { const int n = rho >> 4, i = rho & 15; return 8 * (i >> 2) + 4 * n + (i & 3); }

struct Unit { int pm, pn; };
struct Gemm { const bf16_t* A; const bf16_t* Bt; int M, N, K; };

struct StaticOrder {
    int nM, nN, nwg, G, c;
    __host__ __device__ __forceinline__ void init(int M, int N, int G_, int c_) { nM = M / BM; nN = N / BM; nwg = nM * nN; G = G_; c = c_; }
    __host__ __device__ __forceinline__ bool next(int i, Unit& u) const {
        const long L = (long)i * G + c; if (L >= nwg) return false;
        int wgid = (int)L; { const int q = nwg / NXCD, r = nwg % NXCD, xcd = wgid % NXCD, off = wgid / NXCD; wgid = (xcd < r ? xcd * (q + 1) : r * (q + 1) + (xcd - r) * q) + off; }
        const int nig = WGM * nN, gid = wgid / nig, fm = gid * WGM, gsz = (nM - fm) < WGM ? (nM - fm) : WGM;
        u.pm = fm + ((wgid % nig) % gsz); u.pn = (wgid % nig) / gsz; return true;
    }
    __device__ __forceinline__ void a_ready(const Unit&) const {}
    __device__ __forceinline__ void done(const Unit&) const {}
};

__device__ __forceinline__ unsigned cvt_pk_bf16(float lo, float hi) { unsigned r; asm volatile("v_cvt_pk_bf16_f32 %0, %1, %2" : "=v"(r) : "v"(lo), "v"(hi)); return r; }
typedef float f32x2 __attribute__((ext_vector_type(2)));
__device__ __forceinline__ f32x2 gelu_pk(f32x2 v) {
    const f32x2 av = __builtin_elementwise_abs(v), d = av * 0.2316418882f + 1.0f;
    f32x2 t; t.x = __builtin_amdgcn_rcpf(d.x); t.y = __builtin_amdgcn_rcpf(d.y);
    f32x2 q = t * 0.5307027145f + (-0.7265760135f); q = q * t + 0.7107068705f; q = q * t + (-0.142248368f); q = q * t + 0.127414796f; q = q * t;
    const f32x2 s = (v * v) * (-0.72134752044f);
    f32x2 e; e.x = __builtin_amdgcn_exp2f(s.x); e.y = __builtin_amdgcn_exp2f(s.y);
    const f32x2 m = v * (q * e), r = v - m;
    f32x2 o; o.x = v.x < 0.f ? m.x : r.x; o.y = v.y < 0.f ? m.y : r.y; return o;
}

template <class Epi, class Sched, bool ALIGN_EPI = false, bool SP2 = false>
__device__ __forceinline__ void gemm_phase(PG8_LAS unsigned char* lds, const Gemm g, const Sched& S, const Epi& E) {
    int tid_ = threadIdx.x; asm volatile("" : "+v"(tid_));
    const int tid = tid_, wid = __builtin_amdgcn_readfirstlane(tid >> 6), lane = tid & 63, wr = wid >> 2, wc = wid & 3, fr = lane & 15, fq = lane >> 4;
    const int K = g.K, nt = K / BK;
    unsigned voffA[2], voffB[2];
#pragma unroll
    for (int i = 0; i < 2; ++i) { int R, C; stage_rc(tid * 16 + i * 8192, R, C); const int Rb = Epi::PERM ? ((R & ~31) + perm32(R & 31)) : R;
        voffA[i] = (unsigned)(R * K + C) * 2u; voffB[i] = (unsigned)(Rb * K + C) * 2u; }
    const size_t kstep = (size_t)(BK * 2);
    const size_t hstep = (size_t)HALF * K * 2;
    const size_t tstep = 2 * hstep;
    const unsigned ldsw = (unsigned)wid * 1024u;
    const int aoff = lds_byte(wr * 64 + fr, fq * 8), boff = lds_byte(wc * 32 + fr, fq * 8);
#define PG8_SA(b, h) (((b) * 2 + (h)) * HTB)
#define PG8_SB(b, h) ((4 + (b) * 2 + (h)) * HTB)
#define PG8_STAGE(bufoff, gbase, voff) do { _Pragma("unroll") for (int _i = 0; _i < 2; ++_i) \
        __builtin_amdgcn_global_load_lds((const unsigned*)((const char*)(gbase) + (voff)[_i]), (PG8_LAS unsigned*)(lds + (bufoff) + ldsw + _i * 8192), 16, 0, 0); } while (0)
#define PG8_LDA(dst, b, h) do { _Pragma("unroll") for (int m = 0; m < 4; ++m) _Pragma("unroll") for (int k = 0; k < 2; ++k) dst[m][k] = *(const PG8_LAS bf16x8*)(lds + PG8_SA(b, h) + aoff + m * 2048 + k * 1024); } while (0)
#define PG8_LDB(dst, b, h) do { _Pragma("unroll") for (int n = 0; n < 2; ++n) _Pragma("unroll") for (int k = 0; k < 2; ++k) dst[n][k] = *(const PG8_LAS bf16x8*)(lds + PG8_SB(b, h) + boff + n * 2048 + k * 1024); } while (0)
#define PG8_MMA(ai, bj, At, Bt) do { __builtin_amdgcn_s_setprio(1); _Pragma("unroll") for (int m = 0; m < 4; ++m) _Pragma("unroll") for (int n = 0; n < 2; ++n) _Pragma("unroll") for (int k = 0; k < 2; ++k) \
        acc[ai][bj][m][n] = __builtin_amdgcn_mfma_f32_16x16x32_bf16(Bt[n][k], At[m][k], acc[ai][bj][m][n], 0, 0, 0); __builtin_amdgcn_s_setprio(0); } while (0)
#define PG8_WAIT_V(n) asm volatile("s_waitcnt vmcnt(" #n ")" ::: "memory")
#define PG8_WAIT_L(n) asm volatile("s_waitcnt lgkmcnt(" #n ")" ::: "memory")
#define PG8_BAR __builtin_amdgcn_s_barrier()
#define PG8_SCHED __builtin_amdgcn_sched_barrier(0)
    Unit cur, nxt; int ui = 0;
    if (!S.next(0, cur)) return;
    f32x4 acc[2][2][4][2];
#pragma unroll
    for (int a = 0; a < 2; ++a)
#pragma unroll
        for (int b = 0; b < 2; ++b)
#pragma unroll
            for (int m = 0; m < 4; ++m)
#pragma unroll
                for (int n = 0; n < 2; ++n) acc[a][b][m][n] = (f32x4){0.f, 0.f, 0.f, 0.f};
    bf16x8 At[4][2], B0[2][2], B1[2][2];
    const char* cA = (const char*)g.A + (size_t)cur.pm * tstep; const char* cB = (const char*)g.Bt + (size_t)cur.pn * tstep;
    S.a_ready(cur);
    if constexpr (SP2) {
        PG8_STAGE(PG8_SB(0, 0), cB, voffB); PG8_STAGE(PG8_SB(0, 1), cB + hstep, voffB); PG8_STAGE(PG8_SA(0, 0), cA, voffA); PG8_STAGE(PG8_SA(0, 1), cA + hstep, voffA);
        if (wr == 1) PG8_BAR;
        PG8_WAIT_V(2); PG8_BAR;
        PG8_STAGE(PG8_SB(1, 0), cB + kstep, voffB); PG8_STAGE(PG8_SA(1, 0), cA + kstep, voffA); PG8_STAGE(PG8_SB(1, 1), cB + hstep + kstep, voffB);
        PG8_WAIT_V(6); PG8_BAR;
    } else {
        PG8_STAGE(PG8_SB(0, 0), cB, voffB); PG8_STAGE(PG8_SA(0, 0), cA, voffA); PG8_STAGE(PG8_SB(0, 1), cB + hstep, voffB); PG8_STAGE(PG8_SA(0, 1), cA + hstep, voffA);
        if (wr == 1) PG8_BAR;
        PG8_WAIT_V(4); PG8_BAR;
        PG8_STAGE(PG8_SB(1, 0), cB + kstep, voffB); PG8_STAGE(PG8_SA(1, 0), cA + kstep, voffA); PG8_STAGE(PG8_SB(1, 1), cB + hstep + kstep, voffB);
        PG8_WAIT_V(6); PG8_BAR;
    }
    for (;;) {
        const bool has_next = S.next(ui + 1, nxt);
        const char* nA = has_next ? (const char*)g.A + (size_t)nxt.pm * tstep : cA; const char* nB = has_next ? (const char*)g.Bt + (size_t)nxt.pn * tstep : cB;
#pragma unroll 1
        for (int t = 0; t < nt; t += 2) {
            const bool last = (t == nt - 2);
            const char* a1 = cA + (size_t)(t + 1) * kstep;
            const char* a2 = last ? nA : cA + (size_t)(t + 2) * kstep; const char* b2 = last ? nB : cB + (size_t)(t + 2) * kstep;
            const char* a3 = a2 + kstep; const char* b3 = b2 + kstep;
            if (last && has_next) S.a_ready(nxt);
            if constexpr (SP2) {
            PG8_LDB(B0, 0, 0); PG8_LDB(B1, 0, 1); PG8_SCHED; PG8_LDA(At, 0, 0); PG8_STAGE(PG8_SA(1, 1), a1 + hstep, voffA);
            PG8_WAIT_V(8); PG8_WAIT_L(0); PG8_BAR; PG8_MMA(0, 0, At, B0); PG8_MMA(0, 1, At, B1); PG8_BAR; PG8_SCHED;
            PG8_LDA(At, 0, 1); PG8_STAGE(PG8_SB(0, 0), b2, voffB); PG8_STAGE(PG8_SB(0, 1), b2 + hstep, voffB); PG8_STAGE(PG8_SA(0, 0), a2, voffA);
            PG8_WAIT_V(8); PG8_WAIT_L(0); PG8_BAR; PG8_MMA(1, 0, At, B0); PG8_MMA(1, 1, At, B1); PG8_BAR; PG8_SCHED;
            PG8_LDB(B0, 1, 0); PG8_LDB(B1, 1, 1); PG8_SCHED; PG8_LDA(At, 1, 0); PG8_STAGE(PG8_SA(0, 1), a2 + hstep, voffA);
            PG8_WAIT_V(8); PG8_WAIT_L(0); PG8_BAR; PG8_MMA(0, 0, At, B0); PG8_MMA(0, 1, At, B1); PG8_BAR; PG8_SCHED;
            PG8_LDA(At, 1, 1); PG8_STAGE(PG8_SB(1, 0), b3, voffB); PG8_STAGE(PG8_SB(1, 1), b3 + hstep, voffB); PG8_STAGE(PG8_SA(1, 0), a3, voffA);
            PG8_WAIT_V(8); PG8_WAIT_L(0); PG8_BAR; PG8_MMA(1, 0, At, B0); PG8_MMA(1, 1, At, B1); PG8_BAR; PG8_SCHED;
            } else {
            PG8_LDB(B0, 0, 0); PG8_SCHED; PG8_LDA(At, 0, 0); PG8_STAGE(PG8_SA(1, 1), a1 + hstep, voffA);
            PG8_WAIT_L(8); PG8_BAR; PG8_WAIT_L(0); PG8_MMA(0, 0, At, B0); PG8_BAR; PG8_SCHED;
            PG8_LDB(B1, 0, 1); PG8_STAGE(PG8_SB(0, 0), b2, voffB);
            PG8_BAR; PG8_WAIT_L(0); PG8_MMA(0, 1, At, B1); PG8_BAR;
            PG8_LDA(At, 0, 1); PG8_STAGE(PG8_SA(0, 0), a2, voffA);
            PG8_BAR; PG8_WAIT_L(0); PG8_MMA(1, 0, At, B0); PG8_BAR; PG8_SCHED;
            PG8_STAGE(PG8_SB(0, 1), b2 + hstep, voffB);
            PG8_WAIT_V(6); PG8_BAR; PG8_MMA(1, 1, At, B1); PG8_BAR;
            PG8_LDB(B0, 1, 0); PG8_SCHED; PG8_LDA(At, 1, 0); PG8_STAGE(PG8_SA(0, 1), a2 + hstep, voffA);
            PG8_WAIT_L(8); PG8_BAR; PG8_WAIT_L(0); PG8_MMA(0, 0, At, B0); PG8_BAR; PG8_SCHED;
            PG8_LDB(B1, 1, 1); PG8_STAGE(PG8_SB(1, 0), b3, voffB);
            PG8_BAR; PG8_WAIT_L(0); PG8_MMA(0, 1, At, B1); PG8_BAR;
            PG8_LDA(At, 1, 1); PG8_STAGE(PG8_SA(1, 0), a3, voffA);
            PG8_BAR; PG8_WAIT_L(0); PG8_MMA(1, 0, At, B0); PG8_BAR; PG8_SCHED;
            PG8_STAGE(PG8_SB(1, 1), b3 + hstep, voffB);
            PG8_WAIT_V(6); PG8_BAR; PG8_MMA(1, 1, At, B1); PG8_BAR;
            }
        }
        if constexpr (ALIGN_EPI) { if (wr == 0) PG8_BAR; }
        if constexpr (!Epi::AFTER_DRAIN) { E(acc, cur, wr, wc, fr, fq); S.done(cur); }
        if (!has_next) break;
#pragma unroll
        for (int a = 0; a < 2; ++a)
#pragma unroll
            for (int b = 0; b < 2; ++b)
#pragma unroll
                for (int m = 0; m < 4; ++m)
#pragma unroll
                    for (int n = 0; n < 2; ++n) acc[a][b][m][n] = (f32x4){0.f, 0.f, 0.f, 0.f};
        cur = nxt; cA = nA; cB = nB; ++ui;
        if constexpr (ALIGN_EPI) { if (wr == 1) PG8_BAR; }
    }
    PG8_WAIT_V(0);
    if constexpr (!ALIGN_EPI) { if (wr == 0) PG8_BAR; }
    PG8_BAR;
    if constexpr (Epi::AFTER_DRAIN) { E.fused(acc, cur, wr, wc, fr, fq, lds, wid, lane); S.done(cur); }
#undef PG8_SA
#undef PG8_SB
#undef PG8_STAGE
#undef PG8_LDA
#undef PG8_LDB
#undef PG8_MMA
#undef PG8_WAIT_V
#undef PG8_WAIT_L
#undef PG8_BAR
#undef PG8_SCHED
}
}
namespace xb {
#define LAS __attribute__((address_space(3)))
#define XB_TMO      128
#define XB_XCNT(j)  (256  + 64 * (j))
#define XB_XSUB(j)  (1280 + 64 * (j))
#define XB_XGEN(j)  (2304 + 64 * (j))
#define XB_TOP      3328
#define XB_TOPGEN   3392
#define XCD_BAR_WORDS 3456
#define XB_SPIN_CAP (1u << 18)

__device__ __forceinline__ unsigned xb_ld(unsigned* p)              { return __hip_atomic_load(p, __ATOMIC_RELAXED, __HIP_MEMORY_SCOPE_AGENT); }
__device__ __forceinline__ unsigned xb_add(unsigned* p, unsigned v) { return __hip_atomic_fetch_add(p, v, __ATOMIC_RELAXED, __HIP_MEMORY_SCOPE_AGENT); }
__device__ __forceinline__ unsigned xb_xcc_id() { return (unsigned)__builtin_amdgcn_s_getreg((3 << 11) | 20) & 0xFu; }
#define XB_SPIN(cond, bar) do { unsigned _sp = 0; while (cond) { __builtin_amdgcn_s_sleep(1); \
    if ((++_sp & 255u) == 0u) { if (xb_ld(&(bar)[XB_TMO])) break; if (_sp > XB_SPIN_CAP) { atomicAdd(&(bar)[XB_TMO], 1u); break; } } } } while (0)

struct XcdBarrier {
    unsigned* bar; unsigned x;
    volatile LAS unsigned* st;
};

__device__ __forceinline__ XcdBarrier xcd_barrier_post(unsigned* bar, volatile LAS unsigned* st) {
    XcdBarrier b; b.bar = bar; b.x = xb_xcc_id(); b.st = st;
    if (threadIdx.x == 0) (void)xb_add(&bar[XB_XCNT(b.x)], 1u);
    return b;
}
__device__ __forceinline__ void xcd_barrier_complete(unsigned* bar, unsigned x, unsigned& nloc, unsigned& nx) {
    const unsigned G = gridDim.x * gridDim.y * gridDim.z;
    unsigned sum, cnt, mine, sp = 0u;
    for (;;) {
        sum = 0u; cnt = 0u; mine = 0u;
#pragma unroll
        for (unsigned j = 0; j < 16; ++j) { const unsigned c = xb_ld(&bar[XB_XCNT(j)]); sum += c; cnt += (c > 0u) ? 1u : 0u; mine = (j == x) ? c : mine; }
        if (sum == G) break;
        __builtin_amdgcn_s_sleep(1);
        if ((++sp & 255u) == 0u) { if (xb_ld(&bar[XB_TMO])) break; if (sp > XB_SPIN_CAP) { atomicAdd(&bar[XB_TMO], 1u); break; } }
    }
    nloc = mine > 0u ? mine : 1u; nx = cnt > 0u ? cnt : 1u;
}

__device__ __forceinline__ void xcd_barrier(const XcdBarrier& b) {
    asm volatile("s_waitcnt vmcnt(0)" ::: "memory");
    __syncthreads();
    if (threadIdx.x == 0) {
        unsigned* bar = b.bar;
        __builtin_amdgcn_s_waitcnt(0);
        unsigned nloc = b.st[0], nx = b.st[1];
        if (nloc == 0u) { xcd_barrier_complete(bar, b.x, nloc, nx); b.st[0] = nloc; b.st[1] = nx; }
        const unsigned old = xb_add(&bar[XB_XSUB(b.x)], 1u);
        const unsigned gen = old / nloc;
        if (old + 1u == (gen + 1u) * nloc) {
            __builtin_amdgcn_fence(__ATOMIC_RELEASE, "agent");
            asm volatile("s_waitcnt vmcnt(0)" ::: "memory");
            const unsigned og = xb_add(&bar[XB_TOP], 1u);
            const unsigned tg = og / nx;
            if (og + 1u == (tg + 1u) * nx) xb_add(&bar[XB_TOPGEN], 1u);
            else XB_SPIN(xb_ld(&bar[XB_TOPGEN]) == tg, bar);
            __builtin_amdgcn_fence(__ATOMIC_ACQUIRE, "agent");
            xb_add(&bar[XB_XGEN(b.x)], 1u);
            asm volatile("s_waitcnt vmcnt(0)" ::: "memory");
        } else {
            XB_SPIN(xb_ld(&bar[XB_XGEN(b.x)]) == gen, bar);
            __builtin_amdgcn_fence(__ATOMIC_ACQUIRE, "agent");
            asm volatile("s_waitcnt vmcnt(0)" ::: "memory");
        }
    }
    __syncthreads();
}
#undef LAS
}
namespace fk {
using pg8::bf16_t; using pg8::bf16x8; using pg8::f32x4; using pg8::u32x4; using pg8::Unit; using pg8::cvt_pk_bf16; using pg8::f32x2;
typedef unsigned u32x2 __attribute__((ext_vector_type(2)));
constexpr int NTOK = 65536, DM = 1024, FF = 2816, NUP = 5632, HALF_TOK = 32768;
constexpr size_t MiB = (size_t)1 << 20;
constexpr size_t WS_LAM = 0, WS_BAR = 4096, WS_SS = 1 * MiB, WS_LNS = 3 * MiB, WS_COS = 4 * MiB, WS_SIN = 6 * MiB, WS_WSP = 8 * MiB;
constexpr size_t WS_WQKV = 10 * MiB, WS_WO = 16 * MiB, WS_WUV = 18 * MiB, WS_WOUT = 22 * MiB, WS_WUP = 24 * MiB, WS_WDN = 46 * MiB, WS_WG = 57 * MiB, WS_WP = 61 * MiB;
constexpr size_t WS_PB = 64 * MiB, WS_XB = 128 * MiB, WS_R1 = 256 * MiB, WS_R2 = 384 * MiB, WS_G = 256 * MiB, WS_HALO = 432 * MiB;
constexpr float EPS = 1e-6f;

struct Params {
  const float* in[27];
  const float* xin_a; const float* xin_b;
  float* out; unsigned char* ws;
  int ph_lo, ph_hi;
};

__device__ __forceinline__ float rstd_of(float ss) { return 1.0f / sqrtf(ss * (1.0f / 1024.0f) + EPS); }
__device__ __forceinline__ float bf2f(unsigned short b) { return __uint_as_float((unsigned)b << 16); }
__device__ __forceinline__ float sigmoidf_(float x) { return __builtin_amdgcn_rcpf(1.0f + __builtin_amdgcn_exp2f(-1.4426950408889634f * x)); }
__device__ __forceinline__ u32x4 pack8(const f32x4 a, const f32x4 b) { u32x4 w; w.x = cvt_pk_bf16(a[0], a[1]); w.y = cvt_pk_bf16(a[2], a[3]); w.z = cvt_pk_bf16(b[0], b[1]); w.w = cvt_pk_bf16(b[2], b[3]); return w; }
__device__ __forceinline__ void unpack8(const u32x4 w, f32x4& a, f32x4& b) {
  a[0] = __uint_as_float(w.x << 16); a[1] = __uint_as_float(w.x & 0xffff0000u); a[2] = __uint_as_float(w.y << 16); a[3] = __uint_as_float(w.y & 0xffff0000u);
  b[0] = __uint_as_float(w.z << 16); b[1] = __uint_as_float(w.z & 0xffff0000u); b[2] = __uint_as_float(w.w << 16); b[3] = __uint_as_float(w.w & 0xffff0000u); }

__device__ __forceinline__ float sum_fq(float v) {
  auto a = __builtin_amdgcn_permlane16_swap(__float_as_uint(v), __float_as_uint(v), false, false); v = __uint_as_float(a[0]) + __uint_as_float(a[1]);
  auto b = __builtin_amdgcn_permlane32_swap(__float_as_uint(v), __float_as_uint(v), false, false); return __uint_as_float(b[0]) + __uint_as_float(b[1]); }
__device__ __forceinline__ float row_prev(float v) { return __int_as_float(__builtin_amdgcn_update_dpp(0, __float_as_int(v), 0x121, 0xf, 0xf, false)); }
__device__ __forceinline__ float row_next(float v) { return __int_as_float(__builtin_amdgcn_update_dpp(0, __float_as_int(v), 0x12f, 0xf, 0xf, false)); }
#define ACC_T const f32x4 (&acc)[2][2][4][2]
__device__ __forceinline__ int opaque_lane() { int l; asm volatile("v_mbcnt_lo_u32_b32 %0, -1, 0\n\tv_mbcnt_hi_u32_b32 %0, -1, %0" : "=v"(l)); return l; }
#define OPAQUE_LANE() const int ol_ = opaque_lane(); const int fr = ol_ & 15, fq = ol_ >> 4;

struct EpiQKV {
  static constexpr bool PERM = true, AFTER_DRAIN = false;
  bf16_t *Q, *KV; const float* ss; const float* cs; const float* sn;
  __device__ __forceinline__ void operator()(ACC_T, const Unit& u, int wr, int wc, int fr_, int fq_) const { OPAQUE_LANE()
    const int sect = u.pn >> 2; bf16_t* base = KV + (size_t)(sect > 0 ? sect - 1 : 0) * NTOK * DM; if (sect == 0) base = Q;
    const int rowb = u.pm * 256 + wr * 64 + fr; const float qs = (sect == 0 ? 0.18033688011112042f : 1.0f);
    if (sect < 2) {
      f32x4 ct[4], nt[4]; float crs, nrs;
#define QK_LOAD(T, RS, idx) do { const int row_ = rowb + ((idx) >> 2) * 128 + ((idx) & 3) * 16; const int pos_ = row_ < HALF_TOK ? (row_ & 16383) : (row_ & 2047); \
        RS = ss[row_]; T[0] = *(const f32x4*)(cs + pos_ * 32 + 8 * fq); T[1] = *(const f32x4*)(cs + pos_ * 32 + 8 * fq + 4); \
        T[2] = *(const f32x4*)(sn + pos_ * 32 + 8 * fq); T[3] = *(const f32x4*)(sn + pos_ * 32 + 8 * fq + 4); } while (0)
      QK_LOAD(ct, crs, 0);
      const int col = ((u.pn & 3) * 4 + wc) * 64 + 8 * fq;
#pragma unroll
      for (int idx = 0; idx < 8; ++idx) { const int ai = idx >> 2, m = idx & 3; const int row = rowb + ai * 128 + m * 16;
        if (idx < 7) QK_LOAD(nt, nrs, idx + 1);
        const float rs = rstd_of(crs) * qs; bf16_t* rowp = base + (size_t)row * DM;
        u32x4 w1, w2;
        { const f32x4 x1 = acc[ai][0][m][0] * rs, x2 = acc[ai][1][m][0] * rs; const f32x4 o1 = x1 * ct[0] - x2 * ct[2], o2 = x2 * ct[0] + x1 * ct[2];
          w1.x = cvt_pk_bf16(o1[0], o1[1]); w1.y = cvt_pk_bf16(o1[2], o1[3]); w2.x = cvt_pk_bf16(o2[0], o2[1]); w2.y = cvt_pk_bf16(o2[2], o2[3]); }
        { const f32x4 x1 = acc[ai][0][m][1] * rs, x2 = acc[ai][1][m][1] * rs; const f32x4 o1 = x1 * ct[1] - x2 * ct[3], o2 = x2 * ct[1] + x1 * ct[3];
          w1.z = cvt_pk_bf16(o1[0], o1[1]); w1.w = cvt_pk_bf16(o1[2], o1[3]); w2.z = cvt_pk_bf16(o2[0], o2[1]); w2.w = cvt_pk_bf16(o2[2], o2[3]); }
        *(u32x4*)(rowp + col) = w1; *(u32x4*)(rowp + col + 32) = w2;
        asm volatile("" ::: "memory");
#pragma unroll
        for (int t = 0; t < 4; ++t) ct[t] = nt[t];
        crs = nrs; }
#undef QK_LOAD
    } else {
      float rsv[8];
#pragma unroll
      for (int idx = 0; idx < 8; ++idx) rsv[idx] = ss[rowb + (idx >> 2) * 128 + (idx & 3) * 16];
#pragma unroll
      for (int idx = 0; idx < 8; ++idx) { const int ai = idx >> 2, m = idx & 3; const int row = rowb + ai * 128 + m * 16; const float rs = rstd_of(rsv[idx]); bf16_t* rowp = base + (size_t)row * DM;
#pragma unroll
        for (int bj = 0; bj < 2; ++bj) { const int col = (u.pn & 3) * 256 + bj * 128 + wc * 32 + 8 * fq;
          *(u32x4*)(rowp + col) = pack8(acc[ai][bj][m][0] * rs, acc[ai][bj][m][1] * rs); }
        asm volatile("" ::: "memory"); }
    }
  }
};

template <int KIND> struct EpiRes {
  static constexpr bool PERM = true, AFTER_DRAIN = false;
  const float* xa; const float* xb_src; const bf16_t* xsrc; bf16_t* xbo; float* ssn; const float* ss; const bf16_t* pp; int rowoff;
  __device__ __forceinline__ void operator()(ACC_T, const Unit& u, int wr, int wc, int fr_, int fq_) const { OPAQUE_LANE()
    const int colb = u.pn * 256 + wc * 32 + 8 * fq; const int rowb = rowoff + u.pm * 256 + wr * 64 + fr;
    f32x4 cx[4], nx[4]; u32x4 cb[2], nb[2], cp[2], np[2]; float crs = 1.f, nrs = 1.f;
#define RES_LOAD(X, XB_, PPV, RS, idx) do { const int row_ = rowb + ((idx) >> 2) * 128 + ((idx) & 3) * 16; \
      if (KIND == 0) { const float* xr_ = (row_ < HALF_TOK ? xa + (size_t)row_ * DM : xb_src + (size_t)(row_ - HALF_TOK) * DM); \
        X[0] = *(const f32x4*)(xr_ + colb); X[1] = *(const f32x4*)(xr_ + colb + 4); X[2] = *(const f32x4*)(xr_ + colb + 128); X[3] = *(const f32x4*)(xr_ + colb + 132); } \
      else { XB_[0] = *(const u32x4*)(xsrc + (size_t)row_ * DM + colb); XB_[1] = *(const u32x4*)(xsrc + (size_t)row_ * DM + colb + 128); } \
      if (KIND == 2) { PPV[0] = *(const u32x4*)(pp + (size_t)row_ * DM + colb); PPV[1] = *(const u32x4*)(pp + (size_t)row_ * DM + colb + 128); RS = rstd_of(ss[row_]); } } while (0)
    RES_LOAD(cx, cb, cp, crs, 0);
#pragma unroll
    for (int idx = 0; idx < 8; ++idx) {
      const int ai = idx >> 2, m = idx & 3; const int row = rowb + ai * 128 + m * 16;
      if (idx < 7) RES_LOAD(nx, nb, np, nrs, idx + 1);
      float sq = 0.f;
#pragma unroll
      for (int bj = 0; bj < 2; ++bj) { const int col = colb + bj * 128;
        f32x4 d0 = acc[ai][bj][m][0], d1 = acc[ai][bj][m][1];
        if (KIND == 2) { f32x4 p0, p1; unpack8(cp[bj], p0, p1);
#pragma unroll
          for (int j = 0; j < 4; ++j) { d0[j] = sigmoidf_(d0[j] * crs) * p0[j]; d1[j] = sigmoidf_(d1[j] * crs) * p1[j]; } }
        f32x4 a0, a1; if (KIND == 0) { a0 = cx[2 * bj]; a1 = cx[2 * bj + 1]; } else unpack8(cb[bj], a0, a1);
        const f32x4 v0 = a0 + d0, v1 = a1 + d1;
        *(u32x4*)(xbo + (size_t)row * DM + col) = pack8(v0, v1);
        sq += (v0[0] * v0[0] + v0[1] * v0[1]) + (v0[2] * v0[2] + v0[3] * v0[3]) + (v1[0] * v1[0] + v1[1] * v1[1]) + (v1[2] * v1[2] + v1[3] * v1[3]); }
      sq = sum_fq(sq);
      if (fq == 0) atomicAdd(ssn + row, sq);
      asm volatile("" ::: "memory");
      if (KIND == 0) {
#pragma unroll
        for (int t = 0; t < 4; ++t) cx[t] = nx[t]; }
      else { cb[0] = nb[0]; cb[1] = nb[1]; }
      if (KIND == 2) { cp[0] = np[0]; cp[1] = np[1]; crs = nrs; }
    }
#undef RES_LOAD
  }
};

struct EpiStore {
  static constexpr bool PERM = true, AFTER_DRAIN = false;
  bf16_t* O;
  __device__ __forceinline__ void operator()(ACC_T, const Unit& u, int wr, int wc, int fr_, int fq_) const { OPAQUE_LANE()
#pragma unroll
    for (int ai = 0; ai < 2; ++ai)
#pragma unroll
      for (int m = 0; m < 4; ++m) { const int row = u.pm * 256 + ai * 128 + wr * 64 + m * 16 + fr;
#pragma unroll
        for (int bj = 0; bj < 2; ++bj) { const int col = u.pn * 256 + bj * 128 + wc * 32 + 8 * fq;
          *(u32x4*)(O + (size_t)row * DM + col) = pack8(acc[ai][bj][m][0], acc[ai][bj][m][1]); } asm volatile("" ::: "memory"); }
  }
};

struct EpiUV {
  static constexpr bool PERM = true, AFTER_DRAIN = false;
  bf16_t *U, *Vs; const float* ss; float* lns;
  __device__ __forceinline__ void operator()(ACC_T, const Unit& u, int wr, int wc, int fr_, int fq_) const { OPAQUE_LANE()
    const bool isv = u.pn >= 4; bf16_t* base = isv ? Vs : U;
    float rsv[8];
#pragma unroll
    for (int idx = 0; idx < 8; ++idx) rsv[idx] = ss[u.pm * 256 + (idx >> 2) * 128 + wr * 64 + (idx & 3) * 16 + fr];
#pragma unroll
    for (int ai = 0; ai < 2; ++ai)
#pragma unroll
      for (int m = 0; m < 4; ++m) { const int row = u.pm * 256 + ai * 128 + wr * 64 + m * 16 + fr; const float rs = rstd_of(rsv[ai * 4 + m]);
        float s1 = 0.f, s2 = 0.f;
#pragma unroll
        for (int bj = 0; bj < 2; ++bj) { const int col = (u.pn & 3) * 256 + bj * 128 + wc * 32 + 8 * fq;
          const f32x4 v0 = acc[ai][bj][m][0] * rs, v1 = acc[ai][bj][m][1] * rs;
          const f32x2 a = pg8::gelu_pk((f32x2){v0[0], v0[1]}), b = pg8::gelu_pk((f32x2){v0[2], v0[3]}), c = pg8::gelu_pk((f32x2){v1[0], v1[1]}), d = pg8::gelu_pk((f32x2){v1[2], v1[3]});
          s1 += (a.x + a.y) + (b.x + b.y) + (c.x + c.y) + (d.x + d.y);
          s2 += (a.x * a.x + a.y * a.y) + (b.x * b.x + b.y * b.y) + (c.x * c.x + c.y * c.y) + (d.x * d.x + d.y * d.y);
          u32x4 w; w.x = cvt_pk_bf16(a.x, a.y); w.y = cvt_pk_bf16(b.x, b.y); w.z = cvt_pk_bf16(c.x, c.y); w.w = cvt_pk_bf16(d.x, d.y);
          *(u32x4*)(base + (size_t)row * DM + col) = w; asm volatile("" ::: "memory"); }
        if (isv) { s1 = sum_fq(s1); s2 = sum_fq(s2);
          if (fq == 0) { atomicAdd(lns + row, s1); atomicAdd(lns + NTOK + row, s2); } }
        asm volatile("" ::: "memory");
      }
  }
};

struct EpiUp {
  static constexpr bool PERM = true, AFTER_DRAIN = false;
  bf16_t* G; float* HAL; const float* ss; const float* cw; const float* cb; int rowoff;
  __device__ __forceinline__ void operator()(ACC_T, const Unit& u, int wr, int wc, int fr_, int fq_) const { OPAQUE_LANE()
    float rs[2][4];
#pragma unroll
    for (int ai = 0; ai < 2; ++ai)
#pragma unroll
      for (int m = 0; m < 4; ++m) rs[ai][m] = ss[rowoff + u.pm * 256 + ai * 128 + wr * 64 + 16 * m + fr];
#pragma unroll
    for (int n = 0; n < 2; ++n) {
      const int cv = u.pn * 128 + wc * 32 + 8 * fq + 4 * n;
      const f32x4 wv0 = *(const f32x4*)(cw + cv), wv1 = *(const f32x4*)(cw + NUP + cv), wv2 = *(const f32x4*)(cw + 2 * NUP + cv), bv = *(const f32x4*)(cb + cv);
      const f32x4 wg0 = *(const f32x4*)(cw + FF + cv), wg1 = *(const f32x4*)(cw + NUP + FF + cv), wg2 = *(const f32x4*)(cw + 2 * NUP + FF + cv), bg = *(const f32x4*)(cb + FF + cv);
#pragma unroll
      for (int ai = 0; ai < 2; ++ai) {
        const int R0 = u.pm * 256 + ai * 128 + wr * 64; const int blk = R0 >> 6;
        f32x4 av[4], ag[4];
#pragma unroll
        for (int m = 0; m < 4; ++m) { const float r_ = rstd_of(rs[ai][m]); av[m] = acc[ai][0][m][n] * r_; ag[m] = acc[ai][1][m][n] * r_; }
#pragma unroll
        for (int m = 0; m < 4; ++m) {
          f32x4 pv, pg, nv, ng;
#pragma unroll
          for (int j = 0; j < 4; ++j) {
            const float sv = (fr == 15) ? (m > 0 ? av[m > 0 ? m - 1 : 0][j] : 0.f) : av[m][j];
            const float sg = (fr == 15) ? (m > 0 ? ag[m > 0 ? m - 1 : 0][j] : 0.f) : ag[m][j];
            pv[j] = row_prev(sv); pg[j] = row_prev(sg);
            const float tv = (fr == 0) ? (m < 3 ? av[m < 3 ? m + 1 : 3][j] : 0.f) : av[m][j];
            const float tg = (fr == 0) ? (m < 3 ? ag[m < 3 ? m + 1 : 3][j] : 0.f) : ag[m][j];
            nv[j] = row_next(tv); ng[j] = row_next(tg);
          }
          const f32x4 c_v = bv + wv0 * pv + wv1 * av[m] + wv2 * nv, c_g = bg + wg0 * pg + wg1 * ag[m] + wg2 * ng;
          const bool first = (m == 0 && fr == 0), last = (m == 3 && fr == 15);
          if (first) { float* h = HAL + (size_t)(blk * 4) * NUP; *(f32x4*)(h + cv) = av[m]; *(f32x4*)(h + FF + cv) = ag[m]; *(f32x4*)(h + 2 * NUP + cv) = c_v; *(f32x4*)(h + 2 * NUP + FF + cv) = c_g; }
          else if (last) { float* h = HAL + (size_t)(blk * 4) * NUP; *(f32x4*)(h + NUP + cv) = av[m]; *(f32x4*)(h + NUP + FF + cv) = ag[m]; *(f32x4*)(h + 3 * NUP + cv) = c_v; *(f32x4*)(h + 3 * NUP + FF + cv) = c_g; }
          else { u32x2 w; w.x = cvt_pk_bf16(c_g[0] * sigmoidf_(c_g[0]) * c_v[0], c_g[1] * sigmoidf_(c_g[1]) * c_v[1]); w.y = cvt_pk_bf16(c_g[2] * sigmoidf_(c_g[2]) * c_v[2], c_g[3] * sigmoidf_(c_g[3]) * c_v[3]);
            *(u32x2*)(G + (size_t)(R0 + 16 * m + fr) * FF + cv) = w; }
          asm volatile("" ::: "memory");
        }
      }
    }
  }
};
#undef ACC_T
}
namespace at {
using bf16x8 = __attribute__((ext_vector_type(8))) short;
using s16x4 = __attribute__((ext_vector_type(4))) short;
using f32x16 = __attribute__((ext_vector_type(16))) float;
using u32x4 = __attribute__((ext_vector_type(4))) unsigned;
typedef unsigned short bf16_t;
constexpr int D = 128, NW = 8, QBLK = 32, KVBLK = 64, LD = 1024;
constexpr float THR = 11.5f;
constexpr size_t SHM_V = KVBLK * D * 2, SHM_K = KVBLK * D * 2;
constexpr size_t NSLOT = 3, OFF_K = NSLOT * SHM_V, OFF_WS = NSLOT * (SHM_V + SHM_K), OFF_X = 0, ATT_LDS = OFF_WS + NW * 64 * 4;
#define KSWZ(row, colB) ((row) * 256 + ((colB) ^ (((row) & 7) << 4)))
#define SBAR() __builtin_amdgcn_sched_barrier(0)
__device__ __forceinline__ int crow(int r, int hi) { return (r & 3) + 8 * (r >> 2) + 4 * hi; }
__device__ __forceinline__ unsigned cvtpk(float lo, float hi) { unsigned r; asm volatile("v_cvt_pk_bf16_f32 %0, %1, %2" : "=v"(r) : "v"(lo), "v"(hi)); return r; }
template <bool FAST> __device__ __forceinline__ void partialSM(f32x16& p0, f32x16& p1, float& m_reg, float& mn, float& alpha) {
  if constexpr (FAST) {
#pragma unroll
    for (int r = 0; r < 16; ++r) p0[r] = __builtin_amdgcn_exp2f(p0[r]);
    alpha = 1.f; mn = 0.f;
  } else {
  float pmax = p0[0];
#pragma unroll
  for (int r = 1; r < 16; ++r) pmax = fmaxf(pmax, p0[r]);
#pragma unroll
  for (int r = 0; r < 16; ++r) pmax = fmaxf(pmax, p1[r]);
  { auto rr = __builtin_amdgcn_permlane32_swap(__float_as_uint(pmax), __float_as_uint(pmax), false, false);
    pmax = fmaxf(__uint_as_float(rr[0]), __uint_as_float(rr[1])); }
  if (__builtin_expect(__all(pmax - m_reg <= THR), 1)) { mn = m_reg; alpha = 1.f; }
  else { mn = fmaxf(m_reg, pmax); alpha = __builtin_amdgcn_exp2f(m_reg - mn); m_reg = mn; }
#pragma unroll
  for (int r = 0; r < 16; ++r) p0[r] = p0[r] - mn;
#pragma unroll
  for (int r = 0; r < 16; ++r) p1[r] = p1[r] - mn;
#pragma unroll
  for (int r = 0; r < 16; ++r) p0[r] = __builtin_amdgcn_exp2f(p0[r]);
  }
}
__device__ __forceinline__ void finishSM(f32x16& p0, f32x16& p1, float alpha, float& l_reg, bf16x8& pa0, bf16x8& pa1, bf16x8& pa2, bf16x8& pa3) {
#pragma unroll
  for (int r = 0; r < 16; ++r) p1[r] = __builtin_amdgcn_exp2f(p1[r]);
  typedef float f32x2_ __attribute__((ext_vector_type(2)));
  f32x2_ s2 = (f32x2_){p0[0], p0[1]} + (f32x2_){p1[0], p1[1]};
#pragma unroll
  for (int r = 2; r < 16; r += 2) { s2 += (f32x2_){p0[r], p0[r + 1]}; s2 += (f32x2_){p1[r], p1[r + 1]}; }
  float ps = s2[0] + s2[1];
  { auto rr = __builtin_amdgcn_permlane32_swap(__float_as_uint(ps), __float_as_uint(ps), false, false);
    ps = __uint_as_float(rr[0]) + __uint_as_float(rr[1]); }
  l_reg = l_reg * alpha + ps;
#define PK4(P, BASE, OUT) do { unsigned a0 = cvtpk(P[BASE + 0], P[BASE + 1]), a1 = cvtpk(P[BASE + 2], P[BASE + 3]);   \
    unsigned b0 = cvtpk(P[BASE + 4], P[BASE + 5]), b1 = cvtpk(P[BASE + 6], P[BASE + 7]);                              \
    auto r0 = __builtin_amdgcn_permlane32_swap(a0, b0, false, false); auto r1 = __builtin_amdgcn_permlane32_swap(a1, b1, false, false); \
    u32x4 w = {r0[0], r1[0], r0[1], r1[1]}; OUT = *reinterpret_cast<bf16x8*>(&w); } while (0)
  PK4(p0, 0, pa0); PK4(p0, 8, pa1); PK4(p1, 0, pa2); PK4(p1, 8, pa3);
#undef PK4
}
__device__ __forceinline__ void qkt(f32x16& p0, f32x16& p1, const char* Ks, const bf16x8* qr, int r32, int hi, int ms) {
  p0 = f32x16{}; p1 = f32x16{};
#pragma unroll
  for (int d0 = 0; d0 < 4; ++d0) { int cb = (ms * 64 + d0 * 16 + hi * 8) * 2;
    bf16x8 b0 = *reinterpret_cast<const bf16x8*>(Ks + KSWZ(r32, cb));
    bf16x8 b1 = *reinterpret_cast<const bf16x8*>(Ks + KSWZ(32 + r32, cb));
    p0 = __builtin_amdgcn_mfma_f32_32x32x16_bf16(b0, qr[d0], p0, 0, 0, 0);
    p1 = __builtin_amdgcn_mfma_f32_32x32x16_bf16(b1, qr[d0], p1, 0, 0, 0); }
}
__device__ __forceinline__ int v_st(int k, int c) { const int kk = (k & ~0xC) | ((k & 4) << 1) | ((k & 8) >> 1); return ((kk >> 3) * 4 + (c >> 5)) * 512 + ((kk & 7) * 32 + (c & 31)) * 2; }
__device__ __forceinline__ int v_rd_base(int lane) { return ((lane & 3) << 3) | (((lane >> 2) & 3) << 6) | (((lane >> 4) & 1) << 5) | (((lane >> 5) & 1) << 8); }
constexpr int v_rd_off(int d0, int ks, int half) { return d0 * 512 + ks * 4096 + half * 2048; }
typedef short v4i16_t __attribute__((ext_vector_type(4)));
typedef const __attribute__((address_space(3))) char* lds_cptr;
template <int OFF> __device__ __forceinline__ s16x4 tr_read(lds_cptr vb) {
  return __builtin_bit_cast(s16x4, __builtin_amdgcn_ds_read_tr16_b64_v4i16((__attribute__((address_space(3))) v4i16_t*)(vb + OFF)));
}
template <int D0> __device__ __forceinline__ void pv_one(f32x16& od, lds_cptr vb, bf16x8 pa0, bf16x8 pa1, bf16x8 pa2, bf16x8 pa3) {
  const s16x4 l0 = tr_read<v_rd_off(D0, 0, 0)>(vb), h0 = tr_read<v_rd_off(D0, 0, 1)>(vb), l1 = tr_read<v_rd_off(D0, 1, 0)>(vb), h1 = tr_read<v_rd_off(D0, 1, 1)>(vb);
  const s16x4 l2 = tr_read<v_rd_off(D0, 2, 0)>(vb), h2 = tr_read<v_rd_off(D0, 2, 1)>(vb), l3 = tr_read<v_rd_off(D0, 3, 0)>(vb), h3 = tr_read<v_rd_off(D0, 3, 1)>(vb);
#define PK(L, H) (bf16x8){L[0], L[1], L[2], L[3], H[0], H[1], H[2], H[3]}
  od = __builtin_amdgcn_mfma_f32_32x32x16_bf16(pa0, PK(l0, h0), od, 0, 0, 0);
  od = __builtin_amdgcn_mfma_f32_32x32x16_bf16(pa1, PK(l1, h1), od, 0, 0, 0);
  od = __builtin_amdgcn_mfma_f32_32x32x16_bf16(pa2, PK(l2, h2), od, 0, 0, 0);
  od = __builtin_amdgcn_mfma_f32_32x32x16_bf16(pa3, PK(l3, h3), od, 0, 0, 0);
#undef PK
}
__device__ __forceinline__ void pv_d0(f32x16* o, lds_cptr vb, bf16x8 pa0, bf16x8 pa1, bf16x8 pa2, bf16x8 pa3) {
  pv_one<0>(o[0], vb, pa0, pa1, pa2, pa3); pv_one<1>(o[1], vb, pa0, pa1, pa2, pa3); pv_one<2>(o[2], vb, pa0, pa1, pa2, pa3); pv_one<3>(o[3], vb, pa0, pa1, pa2, pa3);
}
template <bool FAST> __device__ __forceinline__ bool diff_unit(const bf16_t* __restrict__ Q, const bf16_t* __restrict__ K, const bf16_t* __restrict__ V, bf16_t* __restrict__ AO,
                                          long tq0, long tk0, int seq, int h, float lam, const float* __restrict__ subg, char* lds) {
  int tid_ = threadIdx.x; asm volatile("" : "+v"(tid_)); const int tid = tid_, wid = tid >> 6, lane = tid & 63, r32 = lane & 31, hi = lane >> 5, pr = wid & 3, ms = wid >> 2;
  char* V_lds = lds; char* K_lds = lds + OFF_K;
  float* wsf = (float*)(lds + OFF_WS) + wid * 64; float* li_l = wsf; float* al_l = wsf + 32;
  float* X = (float*)(lds + OFF_X) + pr * (32 * 128);
  float m_reg = -1e30f, l_reg = 0; f32x16 o[4] = {}; bf16x8 qr[4];
  const bf16_t* Qw = Q + (tq0 + pr * QBLK + r32) * LD + (2 * h + ms) * 64 + hi * 8;
#pragma unroll
  for (int d0 = 0; d0 < 4; ++d0) qr[d0] = *reinterpret_cast<const bf16x8*>(Qw + d0 * 16);
  const bf16_t* Kh = K + tk0 * LD + h * 128; const bf16_t* Vh = V + tk0 * LD + h * 128;
  const int sr = tid >> 4, sc = (tid & 15) * 8, vst0 = v_st(sr, sc), vst1 = v_st(32 + sr, sc);
  const lds_cptr vb0 = (lds_cptr)V_lds + v_rd_base(lane);
  struct { bf16x8 vs0, vs1, ks0, ks1; } sr_[2];
#define SLOAD(i, k0) do { sr_[i].vs0 = *(const bf16x8*)(&Vh[(long)((k0) + sr) * LD + sc]); sr_[i].vs1 = *(const bf16x8*)(&Vh[(long)((k0) + 32 + sr) * LD + sc]); \
    sr_[i].ks0 = *(const bf16x8*)(&Kh[(long)((k0) + sr) * LD + sc]); sr_[i].ks1 = *(const bf16x8*)(&Kh[(long)((k0) + 32 + sr) * LD + sc]); } while (0)
#define SWRITE(off, i) do { *(bf16x8*)(V_lds + (off) + vst0) = sr_[i].vs0;          \
    *(bf16x8*)(V_lds + (off) + vst1) = sr_[i].vs1; int kc = sc * 2;               \
    *(bf16x8*)(K_lds + (off) + KSWZ(sr, kc)) = sr_[i].ks0;                       \
    *(bf16x8*)(K_lds + (off) + KSWZ(32 + sr, kc)) = sr_[i].ks1; } while (0)
#define SWAIT() asm volatile("s_waitcnt vmcnt(4)" ::: "memory")
#define RESC(a) do { if (!FAST) if (__any((a) < 1.f)) { if (hi == 0) al_l[r32] = (a); asm volatile("s_waitcnt lgkmcnt(0)" ::: "memory"); \
    _Pragma("unroll") for (int d = 0; d < 4; ++d) _Pragma("unroll") for (int r = 0; r < 16; ++r) o[d][r] *= al_l[crow(r, hi)]; } } while (0)
  f32x16 pA0, pA1, pB0, pB1; float mnA, mnB, alA, alB; bf16x8 pa0, pa1, pa2, pa3; const int NT = seq / KVBLK;
  constexpr int SE = 0, SO = 1;
  int s0 = 0, s1 = (int)SHM_V, s2 = 2 * (int)SHM_V;
  SLOAD(SE, 0); asm volatile("s_waitcnt vmcnt(0)" ::: "memory"); SWRITE(0, SE); __syncthreads();
  qkt(pA0, pA1, K_lds, qr, r32, hi, ms); partialSM<FAST>(pA0, pA1, m_reg, mnA, alA); RESC(alA);
  SLOAD(SO, KVBLK); if (2 < NT) SLOAD(SE, 2 * KVBLK);
  SWAIT(); SWRITE(s1, SO); __syncthreads();
  for (int j = 1; j + 1 < NT; j += 2) {
    SBAR(); qkt(pB0, pB1, K_lds + s1, qr, r32, hi, ms);
    finishSM(pA0, pA1, alA, l_reg, pa0, pa1, pa2, pa3); SBAR();
    SLOAD(SO, (j + 2) * KVBLK); SBAR();
    SWAIT(); SWRITE(s2, SE);
    pv_d0(o, vb0 + s0, pa0, pa1, pa2, pa3); partialSM<FAST>(pB0, pB1, m_reg, mnB, alB); RESC(alB);
    __syncthreads();
    SBAR(); qkt(pA0, pA1, K_lds + s2, qr, r32, hi, ms);
    finishSM(pB0, pB1, alB, l_reg, pa0, pa1, pa2, pa3); SBAR();
    if (j + 3 < NT) SLOAD(SE, (j + 3) * KVBLK); SBAR();
    SWAIT(); SWRITE(s0, SO);
    pv_d0(o, vb0 + s1, pa0, pa1, pa2, pa3); partialSM<FAST>(pA0, pA1, m_reg, mnA, alA); RESC(alA);
    __syncthreads();
    { const int t = s0; s0 = s2; s2 = s1; s1 = t; }
  }
  SBAR(); qkt(pB0, pB1, K_lds + s1, qr, r32, hi, ms);
  finishSM(pA0, pA1, alA, l_reg, pa0, pa1, pa2, pa3); SBAR();
  pv_d0(o, vb0 + s0, pa0, pa1, pa2, pa3); partialSM<FAST>(pB0, pB1, m_reg, mnB, alB); RESC(alB);
  finishSM(pB0, pB1, alB, l_reg, pa0, pa1, pa2, pa3); SBAR();
  pv_d0(o, vb0 + s1, pa0, pa1, pa2, pa3);
  __syncthreads();
  if constexpr (FAST) { const int bad = !(l_reg > 1e-30f && l_reg < 1e30f); if (__syncthreads_or(bad)) return true; }
  if (hi == 0) li_l[r32] = l_reg; asm volatile("s_waitcnt lgkmcnt(0)" ::: "memory");
  float rli[16];
#pragma unroll
  for (int r = 0; r < 16; ++r) rli[r] = __builtin_amdgcn_rcpf(li_l[crow(r, hi)]);
  if (ms == 1) {
#pragma unroll
    for (int r = 0; r < 16; ++r)
#pragma unroll
      for (int d0 = 0; d0 < 4; ++d0) X[crow(r, hi) * 128 + d0 * 32 + r32] = o[d0][r] * rli[r];
  }
  __syncthreads();
  if (ms == 0) {
    float sg[4];
#pragma unroll
    for (int d0 = 0; d0 < 4; ++d0) sg[d0] = subg[d0 * 32 + r32] * 0.8f;
#pragma unroll
    for (int r = 0; r < 16; ++r) {
      float v[4]; float sq = 0.f;
#pragma unroll
      for (int d0 = 0; d0 < 4; ++d0) { v[d0] = o[d0][r] * rli[r] - lam * X[crow(r, hi) * 128 + d0 * 32 + r32]; sq += v[d0] * v[d0]; }
      sq += __shfl_xor(sq, 1); sq += __shfl_xor(sq, 2); sq += __shfl_xor(sq, 4); sq += __shfl_xor(sq, 8); sq += __shfl_xor(sq, 16);
      const float rs = 1.0f / sqrtf(sq * (1.0f / 128.0f) + 1e-6f);
      bf16_t* orow = AO + (tq0 + pr * QBLK + crow(r, hi)) * LD + h * 128 + r32;
#pragma unroll
      for (int d0 = 0; d0 < 4; ++d0) orow[d0 * 32] = (bf16_t)(cvtpk(v[d0] * rs * sg[d0], 0.f) & 0xffffu);
    }
  }
  __syncthreads();
  return false;
#undef SLOAD
#undef SWRITE
#undef SWAIT
#undef RESC
}
#undef KSWZ
#undef SBAR
}
namespace fk {
#define LAS3 __attribute__((address_space(3)))
constexpr int NWAVES = 8, NTHR = 512;
constexpr int LDS_BYTES = 147456;
constexpr int NPH = 22;

__device__ __forceinline__ int otid() { int t = threadIdx.x; asm volatile("" : "+v"(t)); return t; }
__device__ __forceinline__ float wave_sum(float v) {
#pragma unroll
  for (int o = 1; o < 64; o <<= 1) v += __shfl_xor(v, o);
  return v;
}
__device__ __forceinline__ unsigned f2bf(float f) { unsigned u = __builtin_bit_cast(unsigned, f); return (u + 0x7fffu + ((u >> 16) & 1u)) >> 16; }
__device__ __forceinline__ unsigned pk2(float lo, float hi) { return f2bf(lo) | (f2bf(hi) << 16); }

__device__ __forceinline__ int srcblk(int mode, int n0) {
  if (mode == 1) { const int pn = n0 >> 8; if (pn >= 8) return n0; const int bj = (n0 >> 7) & 1, wc = (n0 >> 5) & 3; return pn * 256 + wc * 64 + bj * 32; }
  if (mode == 2) { const int pn = n0 >> 8, bj = (n0 >> 7) & 1, i = n0 & 127; return bj * FF + pn * 128 + i; }
  return n0;
}
__device__ __forceinline__ void transpose_item(const float* __restrict__ W, int K, int N, const float* __restrict__ gk, int mode, bf16_t* __restrict__ WT, float* scr, int item, int lane) {
  const int nblk = N / 32, kb = item / nblk, nb = item % nblk, k0 = 64 * kb, n0 = 32 * nb, s0 = srcblk(mode, n0);
#pragma unroll 8
  for (int i = 0; i < 32; ++i) { const int kk = 2 * i + (lane >> 5); float w = W[(size_t)(k0 + kk) * N + s0 + (lane & 31)]; if (gk) w *= gk[k0 + kk]; scr[kk * 33 + (lane & 31)] = w; }
  asm volatile("s_waitcnt lgkmcnt(0)" ::: "memory");
  const int c = lane & 7;
#pragma unroll
  for (int j = 0; j < 4; ++j) { const int n = (lane >> 3) + 8 * j; const float* s = scr + (8 * c) * 33 + n;
    u32x4 o; o.x = pk2(s[0 * 33], s[1 * 33]); o.y = pk2(s[2 * 33], s[3 * 33]); o.z = pk2(s[4 * 33], s[5 * 33]); o.w = pk2(s[6 * 33], s[7 * 33]);
    *(u32x4*)(WT + (size_t)(n0 + n) * K + k0 + 8 * c) = o; }
  asm volatile("s_waitcnt lgkmcnt(0)" ::: "memory");
}
__device__ __forceinline__ void row_to_bf16_ss(const float* xrow, bf16_t* orow, float* ssp, int lane) {
  const f32x4* xr = (const f32x4*)xrow + lane; f32x4 v[4]; float s = 0.f;
#pragma unroll
  for (int j = 0; j < 4; ++j) { v[j] = xr[64 * j]; s += (v[j][0] * v[j][0] + v[j][1] * v[j][1]) + (v[j][2] * v[j][2] + v[j][3] * v[j][3]); }
  s = wave_sum(s);
  unsigned long long* o8 = (unsigned long long*)orow + lane;
#pragma unroll
  for (int j = 0; j < 4; ++j) o8[64 * j] = (unsigned long long)pk2(v[j][0], v[j][1]) | ((unsigned long long)pk2(v[j][2], v[j][3]) << 32);
  if (lane == 0) *ssp = s;
}
struct WJob { const float* W; int K, N; const float* gk; int mode; size_t dst; };

__device__ __forceinline__ void prep_phase(const Params& P, char* lds, int vcu, int G) {
  const int tid = otid(), lane = tid & 63, wave = tid >> 6;
  float* scr = (float*)(lds + wave * 16384);
  const int gw = vcu * NWAVES + wave, NGW = G * NWAVES; unsigned char* ws = P.ws;
#define TJOB(Wp, K_, N_, gk_, mode_, dst_) { const int nit = ((K_) / 64) * ((N_) / 32); for (int it = gw; it < nit; it += NGW) transpose_item(Wp, K_, N_, gk_, mode_, (bf16_t*)(ws + (dst_)), scr, it, lane); }
  TJOB(P.in[5], 1024, 3072, P.in[4], 1, WS_WQKV)
  TJOB(P.in[11], 1024, 1024, nullptr, 0, WS_WO)
  TJOB(P.in[12], 1024, 2048, P.in[4] + 1024, 0, WS_WUV)
  TJOB(P.in[17], 1024, 1024, nullptr, 0, WS_WOUT)
#pragma unroll 1
  for (int L = 0; L < 2; ++L) {
    TJOB(P.in[19] + (size_t)L * 1024 * NUP, 1024, NUP, P.in[18] + L * 1024, 2, WS_WUP + (size_t)L * 11 * MiB)
    TJOB(P.in[22] + (size_t)L * FF * 1024, FF, 1024, nullptr, 0, WS_WDN + (size_t)L * (11 * MiB / 2))
    TJOB(P.in[24] + (size_t)L * 1024 * 1024, 1024, 1024, P.in[23] + L * 1024, 0, WS_WG + (size_t)L * 2 * MiB)
    TJOB(P.in[25] + (size_t)L * 256 * 1024, 256, 1024, nullptr, 0, WS_WP + (size_t)L * (MiB / 2))
  }
#undef TJOB
  for (int m = gw; m < NTOK; m += NGW) { const float* xr = m < HALF_TOK ? P.xin_a + (size_t)m * DM : P.xin_b + (size_t)(m - HALF_TOK) * DM;
    row_to_bf16_ss(xr, (bf16_t*)(ws + WS_XB) + (size_t)m * DM, (float*)(ws + WS_SS) + m, lane); }
  const size_t gt = (size_t)vcu * NTHR + tid, GT = (size_t)G * NTHR;
  for (size_t i = gt; i < (size_t)2 * NTOK * 256 / 8; i += GT) { const size_t e = i * 8; const int L = (int)(e / ((size_t)NTOK * 256)); const size_t r = e % ((size_t)NTOK * 256);
    const float* src = r < (size_t)HALF_TOK * 256 ? P.in[2] + (size_t)L * HALF_TOK * 256 + r : P.in[3] + (size_t)L * HALF_TOK * 256 + (r - (size_t)HALF_TOK * 256);
    const f32x4 a = *(const f32x4*)src, b = *(const f32x4*)(src + 4); *(u32x4*)((bf16_t*)(ws + WS_PB) + e) = pack8(a, b); }
  for (size_t i = gt; i < (size_t)16384 * 32; i += GT) { const int d = (int)(i & 31), pos = (int)(i >> 5);
    const float inv = 1.0f / powf(10000.0f, (float)(2 * d) / 64.0f); const float ang = (float)pos * inv;
    const double tw = 6.283185307179586476925; double r = (double)ang; r -= tw * rint(r / tw); const float rf = (float)r;
    ((float*)(ws + WS_COS))[i] = cosf(rf); ((float*)(ws + WS_SIN))[i] = sinf(rf); }
  for (size_t i = gt; i < (size_t)8 * 128 * 128 / 8; i += GT) { const float* src = P.in[15] + i * 8; *(u32x4*)((bf16_t*)(ws + WS_WSP) + i * 8) = pack8(*(const f32x4*)src, *(const f32x4*)(src + 4)); }
  for (size_t i = gt; i < (size_t)6 * NTOK; i += GT) ((float*)(ws + WS_SS))[NTOK + i] = 0.f;
  for (size_t i = gt; i < (size_t)2 * NTOK; i += GT) ((float*)(ws + WS_LNS))[i] = 0.f;
  if (vcu == 0 && tid == 0) { float d1 = 0.f, d2 = 0.f; for (int i = 0; i < 64; ++i) { d1 += P.in[6][i] * P.in[7][i]; d2 += P.in[8][i] * P.in[9][i]; }
    *(float*)(ws + WS_LAM) = expf(d1) - expf(d2) + 0.2f; }
}

__device__ __forceinline__ void sgu_unit(const Params& P, char* lds, int chunk, int g) {
  const int tid = otid(), lane = tid & 63, w = tid >> 6; unsigned char* ws = P.ws;
  bf16_t* vT = (bf16_t*)lds; bf16_t* Wsm = (bf16_t*)(lds + 34816); float* st_mean = (float*)(lds + 69632); float* st_rstd = st_mean + 128;
  bf16_t* U = (bf16_t*)(ws + WS_R1); const bf16_t* Vs = (const bf16_t*)(ws + WS_XB); const float* lns = (const float*)(ws + WS_LNS);
  if (tid < 128) { const int row = chunk * 128 + tid; const float mean = lns[row] * (1.0f / 1024.0f); const float var = lns[NTOK + row] * (1.0f / 1024.0f) - mean * mean;
    st_mean[tid] = mean; st_rstd[tid] = 1.0f / sqrtf(fmaxf(var, 0.f) + EPS); }
  const int c8 = (tid & 15) * 8;
#pragma unroll
  for (int i = 0; i < 4; ++i) { const int p = (tid >> 4) + 32 * i; *(u32x4*)(Wsm + p * 136 + c8) = *(const u32x4*)((const bf16_t*)(ws + WS_WSP) + (size_t)(g * 128 + p) * 128 + c8); }
  __syncthreads();
  { const float* lng = P.in[13] + g * 128 + c8; const float* lnb = P.in[14] + g * 128 + c8;
    const f32x4 g0 = *(const f32x4*)lng, g1 = *(const f32x4*)(lng + 4), b0 = *(const f32x4*)lnb, b1 = *(const f32x4*)(lnb + 4);
#pragma unroll
    for (int i = 0; i < 4; ++i) { const int q = (tid >> 4) + 32 * i; f32x4 x0, x1; unpack8(*(const u32x4*)(Vs + (size_t)(chunk * 128 + q) * DM + g * 128 + c8), x0, x1);
      const float mean = st_mean[q], rs = st_rstd[q];
      x0 = (x0 - mean) * rs * g0 + b0; x1 = (x1 - mean) * rs * g1 + b1;
#pragma unroll
      for (int e = 0; e < 4; ++e) { vT[(c8 + e) * 136 + q] = (bf16_t)f2bf(x0[e]); vT[(c8 + 4 + e) * 136 + q] = (bf16_t)f2bf(x1[e]); } } }
  __syncthreads();
  const int i16 = lane & 15, kg = lane >> 4;
  f32x4 acc[8];
#pragma unroll
  for (int cb = 0; cb < 8; ++cb) acc[cb] = (f32x4){0.f, 0.f, 0.f, 0.f};
#pragma unroll
  for (int ks = 0; ks < 4; ++ks) { const bf16x8 bfrag = *(const bf16x8*)(Wsm + (16 * w + i16) * 136 + ks * 32 + kg * 8);
#pragma unroll
    for (int cb = 0; cb < 8; ++cb) { const bf16x8 afrag = *(const bf16x8*)(vT + (16 * cb + i16) * 136 + ks * 32 + kg * 8);
      acc[cb] = __builtin_amdgcn_mfma_f32_16x16x32_bf16(afrag, bfrag, acc[cb], 0, 0, 0); } }
  const int p = 16 * w + i16; const size_t token = (size_t)chunk * 128 + p; const float bias = P.in[16][g * 128 + p];
#pragma unroll
  for (int cb = 0; cb < 8; ++cb) { bf16_t* up = U + token * DM + g * 128 + 16 * cb + 4 * kg; const u32x2 uu = *(const u32x2*)up;
    const float u0 = __uint_as_float(uu.x << 16), u1 = __uint_as_float(uu.x & 0xffff0000u), u2 = __uint_as_float(uu.y << 16), u3 = __uint_as_float(uu.y & 0xffff0000u);
    u32x2 o; o.x = cvt_pk_bf16(u0 * (acc[cb][0] + bias), u1 * (acc[cb][1] + bias)); o.y = cvt_pk_bf16(u2 * (acc[cb][2] + bias), u3 * (acc[cb][3] + bias)); *(u32x2*)up = o; }
  __syncthreads();
}

__device__ __forceinline__ void fixup_phase(const Params& P, int L, int half, int vcu, int G) {
  unsigned char* ws = P.ws; const float* HAL = (const float*)(ws + WS_HALO); bf16_t* Gb = (bf16_t*)(ws + WS_G);
  const float* cw = P.in[20] + (size_t)L * 3 * NUP; const int S = half == 0 ? 16384 : 2048;
  const size_t gt = (size_t)vcu * NTHR + otid(), GT = (size_t)G * NTHR;
  for (size_t i = gt; i < (size_t)512 * 2 * FF; i += GT) { const int f = (int)(i % FF); const int rb = (int)(i / FF); const int blk = rb >> 1, which = rb & 1;
    const int row = blk * 64 + (which ? 63 : 0); const int pos = row % S;
    const float* h = HAL + (size_t)(blk * 4) * NUP;
    float cv = h[(2 + which) * NUP + f], cg = h[(2 + which) * NUP + FF + f];
    if (which == 0) { if (pos != 0) { const float* hp = HAL + (size_t)((blk - 1) * 4 + 1) * NUP; cv += cw[f] * hp[f]; cg += cw[FF + f] * hp[FF + f]; } }
    else { if (pos != S - 1) { const float* hn = HAL + (size_t)((blk + 1) * 4 + 0) * NUP; cv += cw[2 * NUP + f] * hn[f]; cg += cw[2 * NUP + FF + f] * hn[FF + f]; } }
    Gb[(size_t)row * FF + f] = (bf16_t)f2bf(cg * sigmoidf_(cg) * cv); }
}

__device__ __forceinline__ void final_phase(const Params& P, int vcu, int G) {
  const int t_ = otid(); const int lane = t_ & 63, wave = t_ >> 6; const int gw = vcu * NWAVES + wave, NGW = G * NWAVES;
  const float* ss = (const float*)(P.ws + WS_SS) + (size_t)6 * NTOK; const float* g = P.in[26]; const bf16_t* X = (const bf16_t*)(P.ws + WS_R2);
  for (int m = gw; m < NTOK; m += NGW) { const float rs = rstd_of(ss[m]); const u32x4* xr = (const u32x4*)(X + (size_t)m * DM) + lane; f32x4* yr = (f32x4*)(P.out + (size_t)m * DM);
#pragma unroll
    for (int j = 0; j < 2; ++j) { f32x4 a, b; unpack8(xr[64 * j], a, b); const int c4 = (lane + 64 * j) * 2;
      yr[c4] = a * rs * *((const f32x4*)g + c4); yr[c4 + 1] = b * rs * *((const f32x4*)g + c4 + 1); } }
}

__global__ void __launch_bounds__(NTHR, 2) mega(Params P) {
  extern __shared__ __attribute__((aligned(16))) unsigned char lds_raw[];
  cg::grid_group grid = cg::this_grid();
  LAS3 unsigned char* lds3 = (LAS3 unsigned char*)lds_raw; char* lds = (char*)lds_raw;
  const int G = gridDim.x, bx = blockIdx.x; const int vcu = (G % 8 == 0) ? (bx % 8) * (G / 8) + bx / 8 : bx;
  unsigned char* ws = P.ws; const int lo = P.ph_lo, hi = P.ph_hi;
  volatile LAS3 unsigned* MISC = (volatile LAS3 unsigned*)(lds3 + 139264);
  if (threadIdx.x < 4) MISC[threadIdx.x] = 0u;
  __syncthreads();
  xb::XcdBarrier bar = xb::xcd_barrier_post((unsigned*)(ws + WS_BAR), MISC);
  float* SS = (float*)(ws + WS_SS);
  bf16_t* XB = (bf16_t*)(ws + WS_XB); bf16_t* R1 = (bf16_t*)(ws + WS_R1); bf16_t* R2 = (bf16_t*)(ws + WS_R2);
#ifndef ENMASK
#define ENMASK 0xffffffffu
#endif
#define IN(k) (lo <= (k) && (k) < hi)
#define EN(b) (((ENMASK) >> (b)) & 1u)
#define SEAM(k) do { if (IN(k) && IN((k) + 1)) { if ((k) == 0) grid.sync(); else xb::xcd_barrier(bar); } else __syncthreads(); } while (0)
#define GEMM(EpiT, E, Aptr, Bptr, M_, N_, K_) do { pg8::Gemm g_{(const bf16_t*)(Aptr), (const bf16_t*)(Bptr), M_, N_, K_}; pg8::StaticOrder S_; S_.init(M_, N_, G, bx); \
    pg8::gemm_phase<EpiT, pg8::StaticOrder, true, true>(lds3, g_, S_, E); } while (0)

  if (EN(0) && IN(0)) { prep_phase(P, lds, vcu, G); }
  SEAM(0);
  if (EN(1) && IN(1)) { EpiQKV E{R1, (bf16_t*)P.out, SS, (const float*)(ws + WS_COS), (const float*)(ws + WS_SIN)};
    GEMM(EpiQKV, E, XB, ws + WS_WQKV, NTOK, 3072, 1024); }
  SEAM(1);
  if (EN(2) && IN(2)) { const float lam = *(const float*)(ws + WS_LAM); const float* subg = P.in[10];
    const bf16_t* Q = R1; const bf16_t* K = (const bf16_t*)P.out; const bf16_t* V = K + (size_t)NTOK * DM; bf16_t* AO = R2;
    const int nu = (G == 256) ? 16 : (4096 + G - 1) / G;
#define ATT_UNIT_ARGS(i) \
      int ui; if (G == 256) { const int x = vcu >> 5, j = vcu & 31; ui = ((i) < 8) ? ((2 * x + ((i) >> 2)) * 128 + j + 32 * ((i) & 3)) : (2048 + (16 * x) * 16 + ((i) - 8) * 32 + j); } \
      else { ui = bx + (i) * G; if (ui >= 4096) break; } \
      long tq0, tk0; int seq, h; \
      if (ui < 2048) { const int ph = ui >> 7, qb = ui & 127; tk0 = (long)(ph >> 3) * 16384; tq0 = tk0 + qb * 128; seq = 16384; h = ph & 7; } \
      else { const int v = ui - 2048, pair = v >> 4, qb = v & 15; tk0 = (long)HALF_TOK + (long)(pair >> 3) * 2048; tq0 = tk0 + qb * 128; seq = 2048; h = pair & 7; }
    unsigned long long badmask = 0ull;
#ifdef PROBE_FORCE_SAFE
    badmask = ~0ull;
#endif
#pragma unroll 1
    for (int i = 0; i < nu && i < 64; ++i) { ATT_UNIT_ARGS(i)
      if (at::diff_unit<true>(Q, K, V, AO, tq0, tk0, seq, h, lam, subg, lds)) badmask |= 1ull << i; }
#pragma unroll 1
    for (int i = 0; i < nu && i < 64; ++i) { if (!((badmask >> i) & 1ull)) continue; ATT_UNIT_ARGS(i)
      (void)at::diff_unit<false>(Q, K, V, AO, tq0, tk0, seq, h, lam, subg, lds); }
#undef ATT_UNIT_ARGS
  }
  SEAM(2);
  if (EN(3) && IN(3)) { EpiRes<0> E{P.xin_a, P.xin_b, nullptr, XB, SS + 1 * NTOK, nullptr, nullptr, 0}; GEMM(EpiRes<0>, E, R2, ws + WS_WO, NTOK, 1024, 1024); }
  SEAM(3);
#pragma unroll 1
  for (int L = 0; L < 2; ++L) {
    const int pb = 4 + 10 * L;
    if (L == 1) {
      if (EN(11) && IN(11)) { EpiUV E{R1, XB, SS + 3 * NTOK, (float*)(ws + WS_LNS)}; GEMM(EpiUV, E, R2, ws + WS_WUV, NTOK, 2048, 1024); }
      SEAM(11);
      if (EN(12) && IN(12)) { for (int ui = vcu; ui < 4096; ui += G) sgu_unit(P, lds, ui >> 3, ui & 7); }
      SEAM(12);
      if (EN(13) && IN(13)) { EpiRes<1> E{nullptr, nullptr, R2, XB, SS + 4 * NTOK, nullptr, nullptr, 0}; GEMM(EpiRes<1>, E, R1, ws + WS_WOUT, NTOK, 1024, 1024); }
      SEAM(13);
    }
#pragma unroll 1
    for (int half = 0; half < 2; ++half) {
      const int p0 = pb + 3 * half; const int rowoff = half * HALF_TOK;
      if (EN(4) && IN(p0)) { EpiUp E{(bf16_t*)(ws + WS_G), (float*)(ws + WS_HALO), SS + (size_t)(1 + 3 * L) * NTOK, P.in[20] + (size_t)L * 3 * NUP, P.in[21] + (size_t)L * NUP, rowoff};
        GEMM(EpiUp, E, XB + (size_t)rowoff * DM, ws + WS_WUP + (size_t)L * 11 * MiB, HALF_TOK, NUP, 1024); }
      SEAM(p0);
      if (EN(5) && IN(p0 + 1)) fixup_phase(P, L, half, vcu, G);
      SEAM(p0 + 1);
      if (EN(6) && IN(p0 + 2)) { EpiRes<1> E{nullptr, nullptr, XB, XB, SS + (size_t)(2 + 3 * L) * NTOK, nullptr, nullptr, rowoff};
        GEMM(EpiRes<1>, E, ws + WS_G, ws + WS_WDN + (size_t)L * (11 * MiB / 2), HALF_TOK, 1024, FF); }
      SEAM(p0 + 2);
    }
    const int pp = pb + 6;
    if (EN(10) && IN(pp)) {
      { EpiStore E{R1}; GEMM(EpiStore, E, (bf16_t*)(ws + WS_PB) + (size_t)L * NTOK * 256, ws + WS_WP + (size_t)L * (MiB / 2), NTOK, 1024, 256); }
      __syncthreads();
      { EpiRes<2> E{nullptr, nullptr, XB, R2, SS + (size_t)(3 + 3 * L) * NTOK, SS + (size_t)(2 + 3 * L) * NTOK, R1, 0};
        GEMM(EpiRes<2>, E, XB, ws + WS_WG + (size_t)L * 2 * MiB, NTOK, 1024, 1024); }
    }
    SEAM(pp);
  }
  if (EN(21) && IN(21)) final_phase(P, vcu, G);
#undef IN
#undef SEAM
#undef EN
#undef GEMM
}
}
#ifndef MODE
#define MODE 0
#endif
#ifndef FASTMASK
#define FASTMASK 0x7f
#endif
namespace fk {
__global__ void __launch_bounds__(256) k_resync(const float* __restrict__ x, bf16_t* __restrict__ xb, float* __restrict__ ss) {
  const int lane = threadIdx.x & 63; const int gw = blockIdx.x * 4 + (threadIdx.x >> 6), NGW = gridDim.x * 4;
  for (int m = gw; m < NTOK; m += NGW) row_to_bf16_ss(x + (size_t)m * DM, xb + (size_t)m * DM, ss + m, lane);
}
}
extern "C" void kernel_launch(void* const* d_in, const int* in_sizes, int n_in, void* d_out, int out_size, void* d_ws, size_t ws_size, hipStream_t stream) {
  static int grid = 0;
  if (grid == 0) {
    if (n_in != 27 || out_size != fk::NTOK * fk::DM || ws_size < (size_t)512 * fk::MiB) { fprintf(stderr, "kernel_launch: unexpected shapes n_in %d out %d ws %zu\n", n_in, out_size, ws_size); grid = -1; return; }
    int dev = 0, cus = 0, per_cu = 0; hipGetDevice(&dev); hipDeviceGetAttribute(&cus, hipDeviceAttributeMultiprocessorCount, dev);
    if (hipFuncSetAttribute((const void*)fk::mega, hipFuncAttributeMaxDynamicSharedMemorySize, fk::LDS_BYTES) != hipSuccess) { fprintf(stderr, "kernel_launch: hipFuncSetAttribute failed\n"); grid = -1; return; }
    if (hipOccupancyMaxActiveBlocksPerMultiprocessor(&per_cu, (const void*)fk::mega, fk::NTHR, fk::LDS_BYTES) != hipSuccess || per_cu < 1) { fprintf(stderr, "kernel_launch: occupancy query says %d\n", per_cu); per_cu = 1; }
    (void)hipGetLastError();
    grid = cus * per_cu; if (grid > 256) grid = 256;
    fprintf(stderr, "kernel_launch: grid %d (cus %d per_cu %d) ws %zu\n", grid, cus, per_cu, ws_size);
  }
  if (grid < 0) return;
  fk::Params p{};
  for (int i = 0; i < 27; ++i) p.in[i] = (const float*)d_in[i];
  p.xin_a = (const float*)d_in[0]; p.xin_b = (const float*)d_in[1]; p.out = (float*)d_out; p.ws = (unsigned char*)d_ws;
#if MODE == 0
  hipMemsetAsync((char*)d_ws + fk::WS_BAR, 0, 16384, stream);
  p.ph_lo = 0; p.ph_hi = fk::NPH; void* args[] = {&p};
  hipError_t e = hipLaunchCooperativeKernel((const void*)fk::mega, dim3(grid), dim3(fk::NTHR), args, fk::LDS_BYTES, stream);
  if (e != hipSuccess) fprintf(stderr, "cooperative launch failed: %s (grid %d)\n", hipGetErrorString(e), grid);
#else
  auto runph = [&](int a, int b) { for (int k = a; k <= b; ++k) { p.ph_lo = k; p.ph_hi = k + 1; hipLaunchKernelGGL(fk::mega, dim3(grid), dim3(fk::NTHR), fk::LDS_BYTES, stream, p); } };
  char* nws = (char*)d_ws + 128 * fk::MiB; float* out = (float*)d_out; unsigned char* ws = (unsigned char*)d_ws;
  hipMemsetAsync((char*)d_ws + fk::WS_BAR, 0, 16384, stream);
  runph(0, 0);
  const int first[7] = {1, 4, 10, 11, 14, 20, 21}, last[7] = {3, 9, 10, 13, 19, 20, 21};
  if (!(FASTMASK & 1)) { hipMemcpyAsync(out, d_in[0], (size_t)fk::HALF_TOK * 1024 * 4, hipMemcpyDeviceToDevice, stream); hipMemcpyAsync(out + (size_t)fk::HALF_TOK * 1024, d_in[1], (size_t)fk::HALF_TOK * 1024 * 4, hipMemcpyDeviceToDevice, stream); }
  for (int s = 0; s < 7; ++s) {
    if (FASTMASK & (1 << s)) {
      if (s > 0) fk::k_resync<<<1024, 256, 0, stream>>>(out, (fk::bf16_t*)(ws + (s == 3 ? fk::WS_R2 : fk::WS_XB)), (float*)(ws + fk::WS_SS) + (size_t)s * fk::NTOK);
      runph(first[s], last[s]);
    } else nv::stage(s, d_in, out, nws, stream);
  }
#endif
}
```

```cpp
#include <hip/hip_runtime.h>
#include <hip/hip_cooperative_groups.h>
#include <cstdio>
#include <cstdint>
namespace cg = cooperative_groups;
#define MODE 0
#define FASTMASK 0x7f
namespace pg8 {
#define PG8_LAS __attribute__((address_space(3)))
typedef unsigned short bf16_t;
typedef short bf16x8 __attribute__((ext_vector_type(8)));
typedef float f32x4 __attribute__((ext_vector_type(4)));
typedef unsigned u32x4 __attribute__((ext_vector_type(4)));
constexpr int BM = 256, BK = 64, HALF = 128, HTB = HALF * BK * 2  , STAGE_BYTES = 8 * HTB, NXCD = 8, WGM = 8;

__host__ __device__ __forceinline__ int lds_byte(int r, int c) { const int st = (r >> 4) * 2 + (c >> 5), rr = r & 15, cc = c & 31, ob = rr * 64 + cc * 2; return st * 1024 + (ob ^ (((ob >> 9) & 1) << 5)); }
__host__ __device__ __forceinline__ void stage_rc(int b, int& R, int& C) { const int st = b / 1024, sb = b % 1024, swz = sb ^ (((sb >> 9) & 1) << 5); R = (st >> 1) * 16 + swz / 64; C = (st & 1) * 32 + (swz % 64) / 2; }
__host__ __device__ __forceinline__ int perm32(int rho) { const int n = rho >> 4, i = rho & 15; return 8 * (i >> 2) + 4 * n + (i & 3); }

struct Unit { int pm, pn; };
struct Gemm { const bf16_t* A; const bf16_t* Bt; int M, N, K; };

struct StaticOrder {
    int nM, nN, nwg, G, c;
    __host__ __device__ __forceinline__ void init(int M, int N, int G_, int c_) { nM = M / BM; nN = N / BM; nwg = nM * nN; G = G_; c = c_; }
    __host__ __device__ __forceinline__ bool next(int i, Unit& u) const {
        const long L = (long)i * G + c; if (L >= nwg) return false;
        int wgid = (int)L; { const int q = nwg / NXCD, r = nwg % NXCD, xcd = wgid % NXCD, off = wgid / NXCD; wgid = (xcd < r ? xcd * (q + 1) : r * (q + 1) + (xcd - r) * q) + off; }
        const int nig = WGM * nN, gid = wgid / nig, fm = gid * WGM, gsz = (nM - fm) < WGM ? (nM - fm) : WGM;
        u.pm = fm + ((wgid % nig) % gsz); u.pn = (wgid % nig) / gsz; return true;
    }
    __device__ __forceinline__ void a_ready(const Unit&) const {}
    __device__ __forceinline__ void done(const Unit&) const {}
};

typedef float f32x2cv_t __attribute__((ext_vector_type(2))); typedef __bf16 bf16x2cv_t __attribute__((ext_vector_type(2)));
__device__ __forceinline__ unsigned cvt_pk_bf16(float lo, float hi) { f32x2cv_t v = {lo, hi}; bf16x2cv_t b = __builtin_convertvector(v, bf16x2cv_t); return __builtin_bit_cast(unsigned, b); }
typedef float f32x2 __attribute__((ext_vector_type(2)));
__device__ __forceinline__ f32x2 gelu_pk(f32x2 v) {
    const f32x2 av = __builtin_elementwise_abs(v), d = av * 0.2316418882f + 1.0f;
    f32x2 t; t.x = __builtin_amdgcn_rcpf(d.x); t.y = __builtin_amdgcn_rcpf(d.y);
    f32x2 q = t * 0.5307027145f + (-0.7265760135f); q = q * t + 0.7107068705f; q = q * t + (-0.142248368f); q = q * t + 0.127414796f; q = q * t;
    const f32x2 s = (v * v) * (-0.72134752044f);
    f32x2 e; e.x = __builtin_amdgcn_exp2f(s.x); e.y = __builtin_amdgcn_exp2f(s.y);
    const f32x2 m = v * (q * e), r = v - m;
    f32x2 o; o.x = v.x < 0.f ? m.x : r.x; o.y = v.y < 0.f ? m.y : r.y; return o;
}

template <class Epi, class Sched, bool ALIGN_EPI = false, bool SP2 = false>
__device__ __forceinline__ void gemm_phase(PG8_LAS unsigned char* lds, const Gemm g, const Sched& S, const Epi& E) {
    int tid_ = threadIdx.x; asm volatile("" : "+v"(tid_));
    const int tid = tid_, wid = __builtin_amdgcn_readfirstlane(tid >> 6), lane = tid & 63, wr = wid >> 2, wc = wid & 3, fr = lane & 15, fq = lane >> 4;
    const int K = g.K, nt = K / BK;
    unsigned voffA[2], voffB[2];
#pragma unroll
    for (int i = 0; i < 2; ++i) { int R, C; stage_rc(tid * 16 + i * 8192, R, C); const int Rb = Epi::PERM ? ((R & ~31) + perm32(R & 31)) : R;
        voffA[i] = (unsigned)(R * K + C) * 2u; voffB[i] = (unsigned)(Rb * K + C) * 2u; }
    const size_t kstep = (size_t)(BK * 2);
    const size_t hstep = (size_t)HALF * K * 2;
    const size_t tstep = 2 * hstep;
    const unsigned ldsw = (unsigned)wid * 1024u;
    const int aoff = lds_byte(wr * 64 + fr, fq * 8), boff = lds_byte(wc * 32 + fr, fq * 8);
#define PG8_SA(b, h) (((b) * 2 + (h)) * HTB)
#define PG8_SB(b, h) ((4 + (b) * 2 + (h)) * HTB)
#define PG8_STAGE(bufoff, gbase, voff) do { _Pragma("unroll") for (int _i = 0; _i < 2; ++_i) \
        __builtin_amdgcn_global_load_lds((const unsigned*)((const char*)(gbase) + (voff)[_i]), (PG8_LAS unsigned*)(lds + (bufoff) + ldsw + _i * 8192), 16, 0, 0); } while (0)
#define PG8_LDA(dst, b, h) do { _Pragma("unroll") for (int m = 0; m < 4; ++m) _Pragma("unroll") for (int k = 0; k < 2; ++k) dst[m][k] = *(const PG8_LAS bf16x8*)(lds + PG8_SA(b, h) + aoff + m * 2048 + k * 1024); } while (0)
#define PG8_LDB(dst, b, h) do { _Pragma("unroll") for (int n = 0; n < 2; ++n) _Pragma("unroll") for (int k = 0; k < 2; ++k) dst[n][k] = *(const PG8_LAS bf16x8*)(lds + PG8_SB(b, h) + boff + n * 2048 + k * 1024); } while (0)
#define PG8_MMA(ai, bj, At, Bt) do { __builtin_amdgcn_s_setprio(1); _Pragma("unroll") for (int m = 0; m < 4; ++m) _Pragma("unroll") for (int n = 0; n < 2; ++n) _Pragma("unroll") for (int k = 0; k < 2; ++k) \
        acc[ai][bj][m][n] = __builtin_amdgcn_mfma_f32_16x16x32_bf16(Bt[n][k], At[m][k], acc[ai][bj][m][n], 0, 0, 0); __builtin_amdgcn_s_setprio(0); } while (0)
#define PG8_WAIT_V(n) asm volatile("s_waitcnt vmcnt(" #n ")" ::: "memory")
#define PG8_WAIT_L(n) asm volatile("s_waitcnt lgkmcnt(" #n ")" ::: "memory")
#define PG8_BAR __builtin_amdgcn_s_barrier()
#define PG8_SCHED __builtin_amdgcn_sched_barrier(0)
    Unit cur, nxt; int ui = 0;
    if (!S.next(0, cur)) return;
    f32x4 acc[2][2][4][2];
#pragma unroll
    for (int a = 0; a < 2; ++a)
#pragma unroll
        for (int b = 0; b < 2; ++b)
#pragma unroll
            for (int m = 0; m < 4; ++m)
#pragma unroll
                for (int n = 0; n < 2; ++n) acc[a][b][m][n] = (f32x4){0.f, 0.f, 0.f, 0.f};
    bf16x8 At[4][2], B0[2][2], B1[2][2];
    const char* cA = (const char*)g.A + (size_t)cur.pm * tstep; const char* cB = (const char*)g.Bt + (size_t)cur.pn * tstep;
    S.a_ready(cur);
    if constexpr (SP2) {
        PG8_STAGE(PG8_SB(0, 0), cB, voffB); PG8_STAGE(PG8_SB(0, 1), cB + hstep, voffB); PG8_STAGE(PG8_SA(0, 0), cA, voffA); PG8_STAGE(PG8_SA(0, 1), cA + hstep, voffA);
        if (wr == 1) PG8_BAR;
        PG8_WAIT_V(2); PG8_BAR;
        PG8_STAGE(PG8_SB(1, 0), cB + kstep, voffB); PG8_STAGE(PG8_SA(1, 0), cA + kstep, voffA); PG8_STAGE(PG8_SB(1, 1), cB + hstep + kstep, voffB);
        PG8_WAIT_V(6); PG8_BAR;
    } else {
        PG8_STAGE(PG8_SB(0, 0), cB, voffB); PG8_STAGE(PG8_SA(0, 0), cA, voffA); PG8_STAGE(PG8_SB(0, 1), cB + hstep, voffB); PG8_STAGE(PG8_SA(0, 1), cA + hstep, voffA);
        if (wr == 1) PG8_BAR;
        PG8_WAIT_V(4); PG8_BAR;
        PG8_STAGE(PG8_SB(1, 0), cB + kstep, voffB); PG8_STAGE(PG8_SA(1, 0), cA + kstep, voffA); PG8_STAGE(PG8_SB(1, 1), cB + hstep + kstep, voffB);
        PG8_WAIT_V(6); PG8_BAR;
    }
    for (;;) {
        const bool has_next = S.next(ui + 1, nxt);
        const char* nA = has_next ? (const char*)g.A + (size_t)nxt.pm * tstep : cA; const char* nB = has_next ? (const char*)g.Bt + (size_t)nxt.pn * tstep : cB;
#pragma unroll 1
        for (int t = 0; t < nt; t += 2) {
            const bool last = (t == nt - 2);
            const char* a1 = cA + (size_t)(t + 1) * kstep;
            const char* a2 = last ? nA : cA + (size_t)(t + 2) * kstep; const char* b2 = last ? nB : cB + (size_t)(t + 2) * kstep;
            const char* a3 = a2 + kstep; const char* b3 = b2 + kstep;
            if (last && has_next) S.a_ready(nxt);
            if constexpr (SP2) {
            PG8_LDB(B0, 0, 0); PG8_LDB(B1, 0, 1); PG8_SCHED; PG8_LDA(At, 0, 0); PG8_STAGE(PG8_SA(1, 1), a1 + hstep, voffA);
            PG8_WAIT_V(8); PG8_WAIT_L(0); PG8_BAR; PG8_MMA(0, 0, At, B0); PG8_MMA(0, 1, At, B1); PG8_BAR; PG8_SCHED;
            PG8_LDA(At, 0, 1); PG8_STAGE(PG8_SB(0, 0), b2, voffB); PG8_STAGE(PG8_SB(0, 1), b2 + hstep, voffB); PG8_STAGE(PG8_SA(0, 0), a2, voffA);
            PG8_WAIT_V(8); PG8_WAIT_L(0); PG8_BAR; PG8_MMA(1, 0, At, B0); PG8_MMA(1, 1, At, B1); PG8_BAR; PG8_SCHED;
            PG8_LDB(B0, 1, 0); PG8_LDB(B1, 1, 1); PG8_SCHED; PG8_LDA(At, 1, 0); PG8_STAGE(PG8_SA(0, 1), a2 + hstep, voffA);
            PG8_WAIT_V(8); PG8_WAIT_L(0); PG8_BAR; PG8_MMA(0, 0, At, B0); PG8_MMA(0, 1, At, B1); PG8_BAR; PG8_SCHED;
            PG8_LDA(At, 1, 1); PG8_STAGE(PG8_SB(1, 0), b3, voffB); PG8_STAGE(PG8_SB(1, 1), b3 + hstep, voffB); PG8_STAGE(PG8_SA(1, 0), a3, voffA);
            PG8_WAIT_V(8); PG8_WAIT_L(0); PG8_BAR; PG8_MMA(1, 0, At, B0); PG8_MMA(1, 1, At, B1); PG8_BAR; PG8_SCHED;
            } else {
            PG8_LDB(B0, 0, 0); PG8_SCHED; PG8_LDA(At, 0, 0); PG8_STAGE(PG8_SA(1, 1), a1 + hstep, voffA);
            PG8_WAIT_L(8); PG8_BAR; PG8_WAIT_L(0); PG8_MMA(0, 0, At, B0); PG8_BAR; PG8_SCHED;
            PG8_LDB(B1, 0, 1); PG8_STAGE(PG8_SB(0, 0), b2, voffB);
            PG8_BAR; PG8_WAIT_L(0); PG8_MMA(0, 1, At, B1); PG8_BAR;
            PG8_LDA(At, 0, 1); PG8_STAGE(PG8_SA(0, 0), a2, voffA);
            PG8_BAR; PG8_WAIT_L(0); PG8_MMA(1, 0, At, B0); PG8_BAR; PG8_SCHED;
            PG8_STAGE(PG8_SB(0, 1), b2 + hstep, voffB);
            PG8_WAIT_V(6); PG8_BAR; PG8_MMA(1, 1, At, B1); PG8_BAR;
            PG8_LDB(B0, 1, 0); PG8_SCHED; PG8_LDA(At, 1, 0); PG8_STAGE(PG8_SA(0, 1), a2 + hstep, voffA);
            PG8_WAIT_L(8); PG8_BAR; PG8_WAIT_L(0); PG8_MMA(0, 0, At, B0); PG8_BAR; PG8_SCHED;
            PG8_LDB(B1, 1, 1); PG8_STAGE(PG8_SB(1, 0), b3, voffB);
            PG8_BAR; PG8_WAIT_L(0); PG8_MMA(0, 1, At, B1); PG8_BAR;
            PG8_LDA(At, 1, 1); PG8_STAGE(PG8_SA(1, 0), a3, voffA);
            PG8_BAR; PG8_WAIT_L(0); PG8_MMA(1, 0, At, B0); PG8_BAR; PG8_SCHED;
            PG8_STAGE(PG8_SB(1, 1), b3 + hstep, voffB);
            PG8_WAIT_V(6); PG8_BAR; PG8_MMA(1, 1, At, B1); PG8_BAR;
            }
        }
        if constexpr (ALIGN_EPI) { if (wr == 0) PG8_BAR; }
        if constexpr (!Epi::AFTER_DRAIN) { E(acc, cur, wr, wc, fr, fq); S.done(cur); }
        if (!has_next) break;
#pragma unroll
        for (int a = 0; a < 2; ++a)
#pragma unroll
            for (int b = 0; b < 2; ++b)
#pragma unroll
                for (int m = 0; m < 4; ++m)
#pragma unroll
                    for (int n = 0; n < 2; ++n) acc[a][b][m][n] = (f32x4){0.f, 0.f, 0.f, 0.f};
        cur = nxt; cA = nA; cB = nB; ++ui;
        if constexpr (ALIGN_EPI) { if (wr == 1) PG8_BAR; }
    }
    PG8_WAIT_V(0);
    if constexpr (!ALIGN_EPI) { if (wr == 0) PG8_BAR; }
    PG8_BAR;
    if constexpr (Epi::AFTER_DRAIN) { E.fused(acc, cur, wr, wc, fr, fq, lds, wid, lane); S.done(cur); }
#undef PG8_SA
#undef PG8_SB
#undef PG8_STAGE
#undef PG8_LDA
#undef PG8_LDB
#undef PG8_MMA
#undef PG8_WAIT_V
#undef PG8_WAIT_L
#undef PG8_BAR
#undef PG8_SCHED
}
}
namespace xb {
#define LAS __attribute__((address_space(3)))
#define XB_TMO      128
#define XB_XCNT(j)  (256  + 64 * (j))
#define XB_XSUB(j)  (1280 + 64 * (j))
#define XB_XGEN(j)  (2304 + 64 * (j))
#define XB_TOP      3328
#define XB_TOPGEN   3392
#define XCD_BAR_WORDS 3456
#define XB_SPIN_CAP (1u << 18)

__device__ __forceinline__ unsigned xb_ld(unsigned* p)              { return __hip_atomic_load(p, __ATOMIC_RELAXED, __HIP_MEMORY_SCOPE_AGENT); }
__device__ __forceinline__ unsigned xb_add(unsigned* p, unsigned v) { return __hip_atomic_fetch_add(p, v, __ATOMIC_RELAXED, __HIP_MEMORY_SCOPE_AGENT); }
__device__ __forceinline__ unsigned xb_xcc_id() { return (unsigned)__builtin_amdgcn_s_getreg((3 << 11) | 20) & 0xFu; }
#define XB_SPIN(cond, bar) do { unsigned _sp = 0; while (cond) { __builtin_amdgcn_s_sleep(1); \
    if ((++_sp & 255u) == 0u) { if (xb_ld(&(bar)[XB_TMO])) break; if (_sp > XB_SPIN_CAP) { atomicAdd(&(bar)[XB_TMO], 1u); break; } } } } while (0)

struct XcdBarrier {
    unsigned* bar; unsigned x;
    volatile LAS unsigned* st;
};

__device__ __forceinline__ XcdBarrier xcd_barrier_post(unsigned* bar, volatile LAS unsigned* st) {
    XcdBarrier b; b.bar = bar; b.x = xb_xcc_id(); b.st = st;
    if (threadIdx.x == 0) (void)xb_add(&bar[XB_XCNT(b.x)], 1u);
    return b;
}
__device__ __forceinline__ void xcd_barrier_complete(unsigned* bar, unsigned x, unsigned& nloc, unsigned& nx) {
    const unsigned G = gridDim.x * gridDim.y * gridDim.z;
    unsigned sum, cnt, mine, sp = 0u;
    for (;;) {
        sum = 0u; cnt = 0u; mine = 0u;
#pragma unroll
        for (unsigned j = 0; j < 16; ++j) { const unsigned c = xb_ld(&bar[XB_XCNT(j)]); sum += c; cnt += (c > 0u) ? 1u : 0u; mine = (j == x) ? c : mine; }
        if (sum == G) break;
        __builtin_amdgcn_s_sleep(1);
        if ((++sp & 255u) == 0u) { if (xb_ld(&bar[XB_TMO])) break; if (sp > XB_SPIN_CAP) { atomicAdd(&bar[XB_TMO], 1u); break; } }
    }
    nloc = mine > 0u ? mine : 1u; nx = cnt > 0u ? cnt : 1u;
}

__device__ __forceinline__ void xcd_barrier(const XcdBarrier& b) {
    asm volatile("s_waitcnt vmcnt(0)" ::: "memory");
    __syncthreads();
    if (threadIdx.x == 0) {
        unsigned* bar = b.bar;
        __builtin_amdgcn_s_waitcnt(0);
        unsigned nloc = b.st[0], nx = b.st[1];
        if (nloc == 0u) { xcd_barrier_complete(bar, b.x, nloc, nx); b.st[0] = nloc; b.st[1] = nx; }
        const unsigned old = xb_add(&bar[XB_XSUB(b.x)], 1u);
        const unsigned gen = old / nloc;
        if (old + 1u == (gen + 1u) * nloc) {
            __builtin_amdgcn_fence(__ATOMIC_RELEASE, "agent");
            asm volatile("s_waitcnt vmcnt(0)" ::: "memory");
            const unsigned og = xb_add(&bar[XB_TOP], 1u);
            const unsigned tg = og / nx;
            if (og + 1u == (tg + 1u) * nx) xb_add(&bar[XB_TOPGEN], 1u);
            else XB_SPIN(xb_ld(&bar[XB_TOPGEN]) == tg, bar);
            __builtin_amdgcn_fence(__ATOMIC_ACQUIRE, "agent");
            xb_add(&bar[XB_XGEN(b.x)], 1u);
            asm volatile("s_waitcnt vmcnt(0)" ::: "memory");
        } else {
            XB_SPIN(xb_ld(&bar[XB_XGEN(b.x)]) == gen, bar);
            __builtin_amdgcn_fence(__ATOMIC_ACQUIRE, "agent");
            asm volatile("s_waitcnt vmcnt(0)" ::: "memory");
        }
    }
    __syncthreads();
}
#undef LAS
}
namespace fk {
using pg8::bf16_t; using pg8::bf16x8; using pg8::f32x4; using pg8::u32x4; using pg8::Unit; using pg8::cvt_pk_bf16; using pg8::f32x2;
typedef unsigned u32x2 __attribute__((ext_vector_type(2)));
constexpr int NTOK = 65536, DM = 1024, FF = 2816, NUP = 5632, HALF_TOK = 32768;
constexpr size_t MiB = (size_t)1 << 20;
constexpr size_t WS_LAM = 0, WS_BAR = 4096, WS_SS = 1 * MiB, WS_LNS = 3 * MiB, WS_COS = 4 * MiB, WS_SIN = 6 * MiB, WS_WSP = 8 * MiB;
constexpr size_t WS_WQKV = 10 * MiB, WS_WO = 16 * MiB, WS_WUV = 18 * MiB, WS_WOUT = 22 * MiB, WS_WUP = 24 * MiB, WS_WDN = 46 * MiB, WS_WG = 57 * MiB, WS_WP = 61 * MiB;
constexpr size_t WS_PB = 64 * MiB, WS_XB = 128 * MiB, WS_R1 = 256 * MiB, WS_R2 = 384 * MiB, WS_G = 256 * MiB, WS_HALO = 432 * MiB;
constexpr float EPS = 1e-6f;

struct Params {
  const float* in[27];
  const float* xin_a; const float* xin_b;
  float* out; unsigned char* ws;
  int ph_lo, ph_hi;
};

__device__ __forceinline__ float rstd_of(float ss) { return 1.0f / sqrtf(ss * (1.0f / 1024.0f) + EPS); }
__device__ __forceinline__ float bf2f(unsigned short b) { return __uint_as_float((unsigned)b << 16); }
__device__ __forceinline__ float sigmoidf_(float x) { return __builtin_amdgcn_rcpf(1.0f + __builtin_amdgcn_exp2f(-1.4426950408889634f * x)); }
__device__ __forceinline__ u32x4 pack8(const f32x4 a, const f32x4 b) { u32x4 w; w.x = cvt_pk_bf16(a[0], a[1]); w.y = cvt_pk_bf16(a[2], a[3]); w.z = cvt_pk_bf16(b[0], b[1]); w.w = cvt_pk_bf16(b[2], b[3]); return w; }
__device__ __forceinline__ void unpack8(const u32x4 w, f32x4& a, f32x4& b) {
  a[0] = __uint_as_float(w.x << 16); a[1] = __uint_as_float(w.x & 0xffff0000u); a[2] = __uint_as_float(w.y << 16); a[3] = __uint_as_float(w.y & 0xffff0000u);
  b[0] = __uint_as_float(w.z << 16); b[1] = __uint_as_float(w.z & 0xffff0000u); b[2] = __uint_as_float(w.w << 16); b[3] = __uint_as_float(w.w & 0xffff0000u); }

__device__ __forceinline__ float sum_fq(float v) {
  auto a = __builtin_amdgcn_permlane16_swap(__float_as_uint(v), __float_as_uint(v), false, false); v = __uint_as_float(a[0]) + __uint_as_float(a[1]);
  auto b = __builtin_amdgcn_permlane32_swap(__float_as_uint(v), __float_as_uint(v), false, false); return __uint_as_float(b[0]) + __uint_as_float(b[1]); }
__device__ __forceinline__ float row_prev(float v) { return __int_as_float(__builtin_amdgcn_update_dpp(0, __float_as_int(v), 0x121, 0xf, 0xf, false)); }
__device__ __forceinline__ float row_next(float v) { return __int_as_float(__builtin_amdgcn_update_dpp(0, __float_as_int(v), 0x12f, 0xf, 0xf, false)); }
#define ACC_T const f32x4 (&acc)[2][2][4][2]
__device__ __forceinline__ int opaque_lane() { int l; asm volatile("v_mbcnt_lo_u32_b32 %0, -1, 0\n\tv_mbcnt_hi_u32_b32 %0, -1, %0" : "=v"(l)); return l; }
#define OPAQUE_LANE() const int ol_ = opaque_lane(); const int fr = ol_ & 15, fq = ol_ >> 4;

struct EpiQKV {
  static constexpr bool PERM = true, AFTER_DRAIN = false;
  bf16_t *Q, *KV; const float* ss; const float* cs; const float* sn;
  __device__ __forceinline__ void operator()(ACC_T, const Unit& u, int wr, int wc, int fr_, int fq_) const { OPAQUE_LANE()
    const int sect = u.pn >> 2; bf16_t* base = KV + (size_t)(sect > 0 ? sect - 1 : 0) * NTOK * DM; if (sect == 0) base = Q;
    const int rowb = u.pm * 256 + wr * 64 + fr; const float qs = (sect == 0 ? 0.18033688011112042f : 1.0f);
    if (sect < 2) {
      f32x4 ct[4], nt[4]; float crs, nrs;
#define QK_LOAD(T, RS, idx) do { const int row_ = rowb + ((idx) >> 2) * 128 + ((idx) & 3) * 16; const int pos_ = row_ < HALF_TOK ? (row_ & 16383) : (row_ & 2047); \
        RS = ss[row_]; T[0] = *(const f32x4*)(cs + pos_ * 32 + 8 * fq); T[1] = *(const f32x4*)(cs + pos_ * 32 + 8 * fq + 4); \
        T[2] = *(const f32x4*)(sn + pos_ * 32 + 8 * fq); T[3] = *(const f32x4*)(sn + pos_ * 32 + 8 * fq + 4); } while (0)
      QK_LOAD(ct, crs, 0);
      const int col = ((u.pn & 3) * 4 + wc) * 64 + 8 * fq;
#pragma unroll
      for (int idx = 0; idx < 8; ++idx) { const int ai = idx >> 2, m = idx & 3; const int row = rowb + ai * 128 + m * 16;
        if (idx < 7) QK_LOAD(nt, nrs, idx + 1);
        const float rs = rstd_of(crs) * qs; bf16_t* rowp = base + (size_t)row * DM;
        u32x4 w1, w2;
        { const f32x4 x1 = acc[ai][0][m][0] * rs, x2 = acc[ai][1][m][0] * rs; const f32x4 o1 = x1 * ct[0] - x2 * ct[2], o2 = x2 * ct[0] + x1 * ct[2];
          w1.x = cvt_pk_bf16(o1[0], o1[1]); w1.y = cvt_pk_bf16(o1[2], o1[3]); w2.x = cvt_pk_bf16(o2[0], o2[1]); w2.y = cvt_pk_bf16(o2[2], o2[3]); }
        { const f32x4 x1 = acc[ai][0][m][1] * rs, x2 = acc[ai][1][m][1] * rs; const f32x4 o1 = x1 * ct[1] - x2 * ct[3], o2 = x2 * ct[1] + x1 * ct[3];
          w1.z = cvt_pk_bf16(o1[0], o1[1]); w1.w = cvt_pk_bf16(o1[2], o1[3]); w2.z = cvt_pk_bf16(o2[0], o2[1]); w2.w = cvt_pk_bf16(o2[2], o2[3]); }
        *(u32x4*)(rowp + col) = w1; *(u32x4*)(rowp + col + 32) = w2;
        asm volatile("" ::: "memory");
#pragma unroll
        for (int t = 0; t < 4; ++t) ct[t] = nt[t];
        crs = nrs; }
#undef QK_LOAD
    } else {
      float rsv[8];
#pragma unroll
      for (int idx = 0; idx < 8; ++idx) rsv[idx] = ss[rowb + (idx >> 2) * 128 + (idx & 3) * 16];
#pragma unroll
      for (int idx = 0; idx < 8; ++idx) { const int ai = idx >> 2, m = idx & 3; const int row = rowb + ai * 128 + m * 16; const float rs = rstd_of(rsv[idx]); bf16_t* rowp = base + (size_t)row * DM;
#pragma unroll
        for (int bj = 0; bj < 2; ++bj) { const int col = (u.pn & 3) * 256 + bj * 128 + wc * 32 + 8 * fq;
          *(u32x4*)(rowp + col) = pack8(acc[ai][bj][m][0] * rs, acc[ai][bj][m][1] * rs); }
        asm volatile("" ::: "memory"); }
    }
  }
};

template <int KIND> struct EpiRes {
  static constexpr bool PERM = true, AFTER_DRAIN = false;
  const float* xa; const float* xb_src; const bf16_t* xsrc; bf16_t* xbo; float* ssn; const float* ss; const bf16_t* pp; int rowoff;
  __device__ __forceinline__ void operator()(ACC_T, const Unit& u, int wr, int wc, int fr_, int fq_) const { OPAQUE_LANE()
    const int colb = u.pn * 256 + wc * 32 + 8 * fq; const int rowb = rowoff + u.pm * 256 + wr * 64 + fr;
    f32x4 cx[4], nx[4]; u32x4 cb[2], nb[2], cp[2], np[2]; float crs = 1.f, nrs = 1.f;
#define RES_LOAD(X, XB_, PPV, RS, idx) do { const int row_ = rowb + ((idx) >> 2) * 128 + ((idx) & 3) * 16; \
      if (KIND == 0) { const float* xr_ = (row_ < HALF_TOK ? xa + (size_t)row_ * DM : xb_src + (size_t)(row_ - HALF_TOK) * DM); \
        X[0] = *(const f32x4*)(xr_ + colb); X[1] = *(const f32x4*)(xr_ + colb + 4); X[2] = *(const f32x4*)(xr_ + colb + 128); X[3] = *(const f32x4*)(xr_ + colb + 132); } \
      else { XB_[0] = *(const u32x4*)(xsrc + (size_t)row_ * DM + colb); XB_[1] = *(const u32x4*)(xsrc + (size_t)row_ * DM + colb + 128); } \
      if (KIND == 2) { PPV[0] = *(const u32x4*)(pp + (size_t)row_ * DM + colb); PPV[1] = *(const u32x4*)(pp + (size_t)row_ * DM + colb + 128); RS = rstd_of(ss[row_]); } } while (0)
    RES_LOAD(cx, cb, cp, crs, 0);
#pragma unroll
    for (int idx = 0; idx < 8; ++idx) {
      const int ai = idx >> 2, m = idx & 3; const int row = rowb + ai * 128 + m * 16;
      if (idx < 7) RES_LOAD(nx, nb, np, nrs, idx + 1);
      float sq = 0.f;
#pragma unroll
      for (int bj = 0; bj < 2; ++bj) { const int col = colb + bj * 128;
        f32x4 d0 = acc[ai][bj][m][0], d1 = acc[ai][bj][m][1];
        if (KIND == 2) { f32x4 p0, p1; unpack8(cp[bj], p0, p1);
#pragma unroll
          for (int j = 0; j < 4; ++j) { d0[j] = sigmoidf_(d0[j] * crs) * p0[j]; d1[j] = sigmoidf_(d1[j] * crs) * p1[j]; } }
        f32x4 a0, a1; if (KIND == 0) { a0 = cx[2 * bj]; a1 = cx[2 * bj + 1]; } else unpack8(cb[bj], a0, a1);
        const f32x4 v0 = a0 + d0, v1 = a1 + d1;
        *(u32x4*)(xbo + (size_t)row * DM + col) = pack8(v0, v1);
        sq += (v0[0] * v0[0] + v0[1] * v0[1]) + (v0[2] * v0[2] + v0[3] * v0[3]) + (v1[0] * v1[0] + v1[1] * v1[1]) + (v1[2] * v1[2] + v1[3] * v1[3]); }
      sq = sum_fq(sq);
      if (fq == 0) atomicAdd(ssn + row, sq);
      asm volatile("" ::: "memory");
      if (KIND == 0) {
#pragma unroll
        for (int t = 0; t < 4; ++t) cx[t] = nx[t]; }
      else { cb[0] = nb[0]; cb[1] = nb[1]; }
      if (KIND == 2) { cp[0] = np[0]; cp[1] = np[1]; crs = nrs; }
    }
#undef RES_LOAD
  }
};

struct EpiStore {
  static constexpr bool PERM = true, AFTER_DRAIN = false;
  bf16_t* O;
  __device__ __forceinline__ void operator()(ACC_T, const Unit& u, int wr, int wc, int fr_, int fq_) const { OPAQUE_LANE()
#pragma unroll
    for (int ai = 0; ai < 2; ++ai)
#pragma unroll
      for (int m = 0; m < 4; ++m) { const int row = u.pm * 256 + ai * 128 + wr * 64 + m * 16 + fr;
#pragma unroll
        for (int bj = 0; bj < 2; ++bj) { const int col = u.pn * 256 + bj * 128 + wc * 32 + 8 * fq;
          *(u32x4*)(O + (size_t)row * DM + col) = pack8(acc[ai][bj][m][0], acc[ai][bj][m][1]); } asm volatile("" ::: "memory"); }
  }
};

struct EpiUV {
  static constexpr bool PERM = true, AFTER_DRAIN = false;
  bf16_t *U, *Vs; const float* ss; float* lns;
  __device__ __forceinline__ void operator()(ACC_T, const Unit& u, int wr, int wc, int fr_, int fq_) const { OPAQUE_LANE()
    const bool isv = u.pn >= 4; bf16_t* base = isv ? Vs : U;
    float rsv[8];
#pragma unroll
    for (int idx = 0; idx < 8; ++idx) rsv[idx] = ss[u.pm * 256 + (idx >> 2) * 128 + wr * 64 + (idx & 3) * 16 + fr];
#pragma unroll
    for (int ai = 0; ai < 2; ++ai)
#pragma unroll
      for (int m = 0; m < 4; ++m) { const int row = u.pm * 256 + ai * 128 + wr * 64 + m * 16 + fr; const float rs = rstd_of(rsv[ai * 4 + m]);
        float s1 = 0.f, s2 = 0.f;
#pragma unroll
        for (int bj = 0; bj < 2; ++bj) { const int col = (u.pn & 3) * 256 + bj * 128 + wc * 32 + 8 * fq;
          const f32x4 v0 = acc[ai][bj][m][0] * rs, v1 = acc[ai][bj][m][1] * rs;
          const f32x2 a = pg8::gelu_pk((f32x2){v0[0], v0[1]}), b = pg8::gelu_pk((f32x2){v0[2], v0[3]}), c = pg8::gelu_pk((f32x2){v1[0], v1[1]}), d = pg8::gelu_pk((f32x2){v1[2], v1[3]});
          s1 += (a.x + a.y) + (b.x + b.y) + (c.x + c.y) + (d.x + d.y);
          s2 += (a.x * a.x + a.y * a.y) + (b.x * b.x + b.y * b.y) + (c.x * c.x + c.y * c.y) + (d.x * d.x + d.y * d.y);
          u32x4 w; w.x = cvt_pk_bf16(a.x, a.y); w.y = cvt_pk_bf16(b.x, b.y); w.z = cvt_pk_bf16(c.x, c.y); w.w = cvt_pk_bf16(d.x, d.y);
          *(u32x4*)(base + (size_t)row * DM + col) = w; asm volatile("" ::: "memory"); }
        if (isv) { s1 = sum_fq(s1); s2 = sum_fq(s2);
          if (fq == 0) { atomicAdd(lns + row, s1); atomicAdd(lns + NTOK + row, s2); } }
        asm volatile("" ::: "memory");
      }
  }
};

struct EpiUp {
  static constexpr bool PERM = true, AFTER_DRAIN = false;
  bf16_t* G; float* HAL; const float* ss; const float* cw; const float* cb; int rowoff;
  __device__ __forceinline__ void operator()(ACC_T, const Unit& u, int wr, int wc, int fr_, int fq_) const { OPAQUE_LANE()
    float rs[2][4];
#pragma unroll
    for (int ai = 0; ai < 2; ++ai)
#pragma unroll
      for (int m = 0; m < 4; ++m) rs[ai][m] = ss[rowoff + u.pm * 256 + ai * 128 + wr * 64 + 16 * m + fr];
#pragma unroll
    for (int n = 0; n < 2; ++n) {
      const int cv = u.pn * 128 + wc * 32 + 8 * fq + 4 * n;
      const f32x4 wv0 = *(const f32x4*)(cw + cv), wv1 = *(const f32x4*)(cw + NUP + cv), wv2 = *(const f32x4*)(cw + 2 * NUP + cv), bv = *(const f32x4*)(cb + cv);
      const f32x4 wg0 = *(const f32x4*)(cw + FF + cv), wg1 = *(const f32x4*)(cw + NUP + FF + cv), wg2 = *(const f32x4*)(cw + 2 * NUP + FF + cv), bg = *(const f32x4*)(cb + FF + cv);
#pragma unroll
      for (int ai = 0; ai < 2; ++ai) {
        const int R0 = u.pm * 256 + ai * 128 + wr * 64; const int blk = R0 >> 6;
        f32x4 av[4], ag[4];
#pragma unroll
        for (int m = 0; m < 4; ++m) { const float r_ = rstd_of(rs[ai][m]); av[m] = acc[ai][0][m][n] * r_; ag[m] = acc[ai][1][m][n] * r_; }
#pragma unroll
        for (int m = 0; m < 4; ++m) {
          f32x4 pv, pg, nv, ng;
#pragma unroll
          for (int j = 0; j < 4; ++j) {
            const float sv = (fr == 15) ? (m > 0 ? av[m > 0 ? m - 1 : 0][j] : 0.f) : av[m][j];
            const float sg = (fr == 15) ? (m > 0 ? ag[m > 0 ? m - 1 : 0][j] : 0.f) : ag[m][j];
            pv[j] = row_prev(sv); pg[j] = row_prev(sg);
            const float tv = (fr == 0) ? (m < 3 ? av[m < 3 ? m + 1 : 3][j] : 0.f) : av[m][j];
            const float tg = (fr == 0) ? (m < 3 ? ag[m < 3 ? m + 1 : 3][j] : 0.f) : ag[m][j];
            nv[j] = row_next(tv); ng[j] = row_next(tg);
          }
          const f32x4 c_v = bv + wv0 * pv + wv1 * av[m] + wv2 * nv, c_g = bg + wg0 * pg + wg1 * ag[m] + wg2 * ng;
          const bool first = (m == 0 && fr == 0), last = (m == 3 && fr == 15);
          if (first) { float* h = HAL + (size_t)(blk * 4) * NUP; *(f32x4*)(h + cv) = av[m]; *(f32x4*)(h + FF + cv) = ag[m]; *(f32x4*)(h + 2 * NUP + cv) = c_v; *(f32x4*)(h + 2 * NUP + FF + cv) = c_g; }
          else if (last) { float* h = HAL + (size_t)(blk * 4) * NUP; *(f32x4*)(h + NUP + cv) = av[m]; *(f32x4*)(h + NUP + FF + cv) = ag[m]; *(f32x4*)(h + 3 * NUP + cv) = c_v; *(f32x4*)(h + 3 * NUP + FF + cv) = c_g; }
          else { u32x2 w; w.x = cvt_pk_bf16(c_g[0] * sigmoidf_(c_g[0]) * c_v[0], c_g[1] * sigmoidf_(c_g[1]) * c_v[1]); w.y = cvt_pk_bf16(c_g[2] * sigmoidf_(c_g[2]) * c_v[2], c_g[3] * sigmoidf_(c_g[3]) * c_v[3]);
            *(u32x2*)(G + (size_t)(R0 + 16 * m + fr) * FF + cv) = w; }
          asm volatile("" ::: "memory");
        }
      }
    }
  }
};
#undef ACC_T
}
namespace at {
using bf16x8 = __attribute__((ext_vector_type(8))) short;
using s16x4 = __attribute__((ext_vector_type(4))) short;
using f32x16 = __attribute__((ext_vector_type(16))) float;
using u32x4 = __attribute__((ext_vector_type(4))) unsigned;
typedef unsigned short bf16_t;
constexpr int D = 128, NW = 8, QBLK = 32, KVBLK = 64, LD = 1024;
constexpr float THR = 11.5f;
constexpr size_t SHM_V = KVBLK * D * 2, SHM_K = KVBLK * D * 2;
constexpr size_t NSLOT = 3, OFF_K = NSLOT * SHM_V, OFF_WS = NSLOT * (SHM_V + SHM_K), OFF_X = 0, ATT_LDS = OFF_WS + NW * 64 * 4;
#define KSWZ(row, colB) ((row) * 256 + ((colB) ^ (((row) & 7) << 4)))
#define SBAR() __builtin_amdgcn_sched_barrier(0)
__device__ __forceinline__ int crow(int r, int hi) { return (r & 3) + 8 * (r >> 2) + 4 * hi; }
typedef float f32x2c_t __attribute__((ext_vector_type(2))); typedef __bf16 bf16x2c_t __attribute__((ext_vector_type(2)));
__device__ __forceinline__ unsigned cvtpk(float lo, float hi) { f32x2c_t v = {lo, hi}; bf16x2c_t b = __builtin_convertvector(v, bf16x2c_t); return __builtin_bit_cast(unsigned, b); }
template <bool FAST> __device__ __forceinline__ void partialSM(f32x16& p0, f32x16& p1, float& m_reg, float& mn, float& alpha) {
  if constexpr (FAST) {
#pragma unroll
    for (int r = 0; r < 16; ++r) p0[r] = __builtin_amdgcn_exp2f(p0[r]);
    alpha = 1.f; mn = 0.f;
  } else {
  float pmax = p0[0];
#pragma unroll
  for (int r = 1; r < 16; ++r) pmax = fmaxf(pmax, p0[r]);
#pragma unroll
  for (int r = 0; r < 16; ++r) pmax = fmaxf(pmax, p1[r]);
  { auto rr = __builtin_amdgcn_permlane32_swap(__float_as_uint(pmax), __float_as_uint(pmax), false, false);
    pmax = fmaxf(__uint_as_float(rr[0]), __uint_as_float(rr[1])); }
  if (__builtin_expect(__all(pmax - m_reg <= THR), 1)) { mn = m_reg; alpha = 1.f; }
  else { mn = fmaxf(m_reg, pmax); alpha = __builtin_amdgcn_exp2f(m_reg - mn); m_reg = mn; }
#pragma unroll
  for (int r = 0; r < 16; ++r) p0[r] = p0[r] - mn;
#pragma unroll
  for (int r = 0; r < 16; ++r) p1[r] = p1[r] - mn;
#pragma unroll
  for (int r = 0; r < 16; ++r) p0[r] = __builtin_amdgcn_exp2f(p0[r]);
  }
}
__device__ __forceinline__ void finishSM(f32x16& p0, f32x16& p1, float alpha, float& l_reg, bf16x8& pa0, bf16x8& pa1, bf16x8& pa2, bf16x8& pa3) {
#pragma unroll
  for (int r = 0; r < 16; ++r) p1[r] = __builtin_amdgcn_exp2f(p1[r]);
  typedef float f32x2_ __attribute__((ext_vector_type(2)));
  f32x2_ s2 = (f32x2_){p0[0], p0[1]} + (f32x2_){p1[0], p1[1]};
#pragma unroll
  for (int r = 2; r < 16; r += 2) { s2 += (f32x2_){p0[r], p0[r + 1]}; s2 += (f32x2_){p1[r], p1[r + 1]}; }
  float ps = s2[0] + s2[1];
  { auto rr = __builtin_amdgcn_permlane32_swap(__float_as_uint(ps), __float_as_uint(ps), false, false);
    ps = __uint_as_float(rr[0]) + __uint_as_float(rr[1]); }
  l_reg = l_reg * alpha + ps;
#define PK4(P, BASE, OUT) do { unsigned a0 = cvtpk(P[BASE + 0], P[BASE + 1]), a1 = cvtpk(P[BASE + 2], P[BASE + 3]);   \
    unsigned b0 = cvtpk(P[BASE + 4], P[BASE + 5]), b1 = cvtpk(P[BASE + 6], P[BASE + 7]);                              \
    auto r0 = __builtin_amdgcn_permlane32_swap(a0, b0, false, false); auto r1 = __builtin_amdgcn_permlane32_swap(a1, b1, false, false); \
    u32x4 w = {r0[0], r1[0], r0[1], r1[1]}; OUT = *reinterpret_cast<bf16x8*>(&w); } while (0)
  PK4(p0, 0, pa0); PK4(p0, 8, pa1); PK4(p1, 0, pa2); PK4(p1, 8, pa3);
#undef PK4
}
__device__ __forceinline__ void qkt(f32x16& p0, f32x16& p1, const char* Ks, const bf16x8* qr, int r32, int hi, int ms) {
  p0 = f32x16{}; p1 = f32x16{};
#pragma unroll
  for (int d0 = 0; d0 < 4; ++d0) { int cb = (ms * 64 + d0 * 16 + hi * 8) * 2;
    bf16x8 b0 = *reinterpret_cast<const bf16x8*>(Ks + KSWZ(r32, cb));
    bf16x8 b1 = *reinterpret_cast<const bf16x8*>(Ks + KSWZ(32 + r32, cb));
    p0 = __builtin_amdgcn_mfma_f32_32x32x16_bf16(b0, qr[d0], p0, 0, 0, 0);
    p1 = __builtin_amdgcn_mfma_f32_32x32x16_bf16(b1, qr[d0], p1, 0, 0, 0); }
}
__device__ __forceinline__ int v_st(int k, int c) { const int kk = (k & ~0xC) | ((k & 4) << 1) | ((k & 8) >> 1); return ((kk >> 3) * 4 + (c >> 5)) * 512 + ((kk & 7) * 32 + (c & 31)) * 2; }
__device__ __forceinline__ int v_rd_base(int lane) { return ((lane & 3) << 3) | (((lane >> 2) & 3) << 6) | (((lane >> 4) & 1) << 5) | (((lane >> 5) & 1) << 8); }
constexpr int v_rd_off(int d0, int ks, int half) { return d0 * 512 + ks * 4096 + half * 2048; }
typedef short v4i16_t __attribute__((ext_vector_type(4)));
typedef const __attribute__((address_space(3))) char* lds_cptr;
template <int OFF> __device__ __forceinline__ s16x4 tr_read(lds_cptr vb) {
  return __builtin_bit_cast(s16x4, __builtin_amdgcn_ds_read_tr16_b64_v4i16((__attribute__((address_space(3))) v4i16_t*)(vb + OFF)));
}
template <int D0> __device__ __forceinline__ void pv_one(f32x16& od, lds_cptr vb, bf16x8 pa0, bf16x8 pa1, bf16x8 pa2, bf16x8 pa3) {
  const s16x4 l0 = tr_read<v_rd_off(D0, 0, 0)>(vb), h0 = tr_read<v_rd_off(D0, 0, 1)>(vb), l1 = tr_read<v_rd_off(D0, 1, 0)>(vb), h1 = tr_read<v_rd_off(D0, 1, 1)>(vb);
  const s16x4 l2 = tr_read<v_rd_off(D0, 2, 0)>(vb), h2 = tr_read<v_rd_off(D0, 2, 1)>(vb), l3 = tr_read<v_rd_off(D0, 3, 0)>(vb), h3 = tr_read<v_rd_off(D0, 3, 1)>(vb);
#define PK(L, H) (bf16x8){L[0], L[1], L[2], L[3], H[0], H[1], H[2], H[3]}
  od = __builtin_amdgcn_mfma_f32_32x32x16_bf16(pa0, PK(l0, h0), od, 0, 0, 0);
  od = __builtin_amdgcn_mfma_f32_32x32x16_bf16(pa1, PK(l1, h1), od, 0, 0, 0);
  od = __builtin_amdgcn_mfma_f32_32x32x16_bf16(pa2, PK(l2, h2), od, 0, 0, 0);
  od = __builtin_amdgcn_mfma_f32_32x32x16_bf16(pa3, PK(l3, h3), od, 0, 0, 0);
#undef PK
}
__device__ __forceinline__ void pv_d0(f32x16* o, lds_cptr vb, bf16x8 pa0, bf16x8 pa1, bf16x8 pa2, bf16x8 pa3) {
  pv_one<0>(o[0], vb, pa0, pa1, pa2, pa3); pv_one<1>(o[1], vb, pa0, pa1, pa2, pa3); pv_one<2>(o[2], vb, pa0, pa1, pa2, pa3); pv_one<3>(o[3], vb, pa0, pa1, pa2, pa3);
}
template <bool FAST> __device__ __forceinline__ bool diff_unit(const bf16_t* __restrict__ Q, const bf16_t* __restrict__ K, const bf16_t* __restrict__ V, bf16_t* __restrict__ AO,
                                          long tq0, long tk0, int seq, int h, float lam, const float* __restrict__ subg, char* lds) {
  int tid_ = threadIdx.x; asm volatile("" : "+v"(tid_)); const int tid = tid_, wid = tid >> 6, lane = tid & 63, r32 = lane & 31, hi = lane >> 5, pr = wid & 3, ms = wid >> 2;
  char* V_lds = lds; char* K_lds = lds + OFF_K;
  float* wsf = (float*)(lds + OFF_WS) + wid * 64; float* li_l = wsf; float* al_l = wsf + 32;
  float* X = (float*)(lds + OFF_X) + pr * (32 * 128);
  float m_reg = -1e30f, l_reg = 0; f32x16 o[4] = {}; bf16x8 qr[4];
  const bf16_t* Qw = Q + (tq0 + pr * QBLK + r32) * LD + (2 * h + ms) * 64 + hi * 8;
#pragma unroll
  for (int d0 = 0; d0 < 4; ++d0) qr[d0] = *reinterpret_cast<const bf16x8*>(Qw + d0 * 16);
  const bf16_t* Kh = K + tk0 * LD + h * 128; const bf16_t* Vh = V + tk0 * LD + h * 128;
  const int sr = tid >> 4, sc = (tid & 15) * 8, vst0 = v_st(sr, sc), vst1 = v_st(32 + sr, sc);
  const lds_cptr vb0 = (lds_cptr)V_lds + v_rd_base(lane);
  struct { bf16x8 vs0, vs1, ks0, ks1; } sr_[2];
#define SLOAD(i, k0) do { sr_[i].vs0 = *(const bf16x8*)(&Vh[(long)((k0) + sr) * LD + sc]); sr_[i].vs1 = *(const bf16x8*)(&Vh[(long)((k0) + 32 + sr) * LD + sc]); \
    sr_[i].ks0 = *(const bf16x8*)(&Kh[(long)((k0) + sr) * LD + sc]); sr_[i].ks1 = *(const bf16x8*)(&Kh[(long)((k0) + 32 + sr) * LD + sc]); } while (0)
#define SWRITE(off, i) do { *(bf16x8*)(V_lds + (off) + vst0) = sr_[i].vs0;          \
    *(bf16x8*)(V_lds + (off) + vst1) = sr_[i].vs1; int kc = sc * 2;               \
    *(bf16x8*)(K_lds + (off) + KSWZ(sr, kc)) = sr_[i].ks0;                       \
    *(bf16x8*)(K_lds + (off) + KSWZ(32 + sr, kc)) = sr_[i].ks1; } while (0)
#define SWAIT() asm volatile("s_waitcnt vmcnt(4)" ::: "memory")
#define RESC(a) do { if (!FAST) if (__any((a) < 1.f)) { if (hi == 0) al_l[r32] = (a); asm volatile("s_waitcnt lgkmcnt(0)" ::: "memory"); \
    _Pragma("unroll") for (int d = 0; d < 4; ++d) _Pragma("unroll") for (int r = 0; r < 16; ++r) o[d][r] *= al_l[crow(r, hi)]; } } while (0)
  f32x16 pA0, pA1, pB0, pB1; float mnA, mnB, alA, alB; bf16x8 pa0, pa1, pa2, pa3; const int NT = seq / KVBLK;
  constexpr int SE = 0, SO = 1;
  int s0 = 0, s1 = (int)SHM_V, s2 = 2 * (int)SHM_V;
  SLOAD(SE, 0); asm volatile("s_waitcnt vmcnt(0)" ::: "memory"); SWRITE(0, SE); __syncthreads();
  qkt(pA0, pA1, K_lds, qr, r32, hi, ms); partialSM<FAST>(pA0, pA1, m_reg, mnA, alA); RESC(alA);
  SLOAD(SO, KVBLK); if (2 < NT) SLOAD(SE, 2 * KVBLK);
  SWAIT(); SWRITE(s1, SO); __syncthreads();
  for (int j = 1; j + 1 < NT; j += 2) {
    SBAR(); qkt(pB0, pB1, K_lds + s1, qr, r32, hi, ms);
    finishSM(pA0, pA1, alA, l_reg, pa0, pa1, pa2, pa3); SBAR();
    SLOAD(SO, (j + 2) * KVBLK); SBAR();
    SWAIT(); SWRITE(s2, SE);
    pv_d0(o, vb0 + s0, pa0, pa1, pa2, pa3); partialSM<FAST>(pB0, pB1, m_reg, mnB, alB); RESC(alB);
    __syncthreads();
    SBAR(); qkt(pA0, pA1, K_lds + s2, qr, r32, hi, ms);
    finishSM(pB0, pB1, alB, l_reg, pa0, pa1, pa2, pa3); SBAR();
    if (j + 3 < NT) SLOAD(SE, (j + 3) * KVBLK); SBAR();
    SWAIT(); SWRITE(s0, SO);
    pv_d0(o, vb0 + s1, pa0, pa1, pa2, pa3); partialSM<FAST>(pA0, pA1, m_reg, mnA, alA); RESC(alA);
    __syncthreads();
    { const int t = s0; s0 = s2; s2 = s1; s1 = t; }
  }
  SBAR(); qkt(pB0, pB1, K_lds + s1, qr, r32, hi, ms);
  finishSM(pA0, pA1, alA, l_reg, pa0, pa1, pa2, pa3); SBAR();
  pv_d0(o, vb0 + s0, pa0, pa1, pa2, pa3); partialSM<FAST>(pB0, pB1, m_reg, mnB, alB); RESC(alB);
  finishSM(pB0, pB1, alB, l_reg, pa0, pa1, pa2, pa3); SBAR();
  pv_d0(o, vb0 + s1, pa0, pa1, pa2, pa3);
  __syncthreads();
  if constexpr (FAST) { const int bad = !(l_reg > 1e-30f && l_reg < 1e30f); if (__syncthreads_or(bad)) return true; }
  if (hi == 0) li_l[r32] = l_reg; asm volatile("s_waitcnt lgkmcnt(0)" ::: "memory");
  float rli[16];
#pragma unroll
  for (int r = 0; r < 16; ++r) rli[r] = __builtin_amdgcn_rcpf(li_l[crow(r, hi)]);
  if (ms == 1) {
#pragma unroll
    for (int r = 0; r < 16; ++r)
#pragma unroll
      for (int d0 = 0; d0 < 4; ++d0) X[crow(r, hi) * 128 + d0 * 32 + r32] = o[d0][r] * rli[r];
  }
  __syncthreads();
  if (ms == 0) {
    bf16_t* S = (bf16_t*)(lds + 65536) + pr * (32 * 128);
    float sg[4];
#pragma unroll
    for (int d0 = 0; d0 < 4; ++d0) sg[d0] = subg[d0 * 32 + r32] * 0.8f;
#pragma unroll
    for (int r = 0; r < 16; ++r) {
      float v[4]; float sq = 0.f;
#pragma unroll
      for (int d0 = 0; d0 < 4; ++d0) { v[d0] = o[d0][r] * rli[r] - lam * X[crow(r, hi) * 128 + d0 * 32 + r32]; sq += v[d0] * v[d0]; }
      sq += __shfl_xor(sq, 1); sq += __shfl_xor(sq, 2); sq += __shfl_xor(sq, 4); sq += __shfl_xor(sq, 8); sq += __shfl_xor(sq, 16);
      const float rs = 1.0f / sqrtf(sq * (1.0f / 128.0f) + 1e-6f);
      bf16_t* srow = S + crow(r, hi) * 128 + r32;
#pragma unroll
      for (int d0 = 0; d0 < 4; ++d0) srow[d0 * 32] = (bf16_t)(cvtpk(v[d0] * rs * sg[d0], 0.f) & 0xffffu);
    }
    asm volatile("s_waitcnt lgkmcnt(0)" ::: "memory");
#pragma unroll
    for (int i = 0; i < 8; ++i) { const int row = i * 4 + (lane >> 4), ch = lane & 15; const u32x4 w = *(const u32x4*)(S + row * 128 + ch * 8);
      *(u32x4*)(AO + (tq0 + pr * QBLK + row) * LD + h * 128 + ch * 8) = w; }
  }
  __syncthreads();
  return false;
#undef SLOAD
#undef SWRITE
#undef SWAIT
#undef RESC
}
#undef KSWZ
#undef SBAR
}
namespace fk {
#define LAS3 __attribute__((address_space(3)))
constexpr int NWAVES = 8, NTHR = 512;
constexpr int LDS_BYTES = 147456;
constexpr int NPH = 22;

__device__ __forceinline__ int otid() { int t = threadIdx.x; asm volatile("" : "+v"(t)); return t; }
__device__ __forceinline__ float wave_sum(float v) {
#pragma unroll
  for (int o = 1; o < 64; o <<= 1) v += __shfl_xor(v, o);
  return v;
}
__device__ __forceinline__ unsigned f2bf(float f) { unsigned u = __builtin_bit_cast(unsigned, f); return (u + 0x7fffu + ((u >> 16) & 1u)) >> 16; }
__device__ __forceinline__ unsigned pk2(float lo, float hi) { return f2bf(lo) | (f2bf(hi) << 16); }

__device__ __forceinline__ int srcblk(int mode, int n0) {
  if (mode == 1) { const int pn = n0 >> 8; if (pn >= 8) return n0; const int bj = (n0 >> 7) & 1, wc = (n0 >> 5) & 3; return pn * 256 + wc * 64 + bj * 32; }
  if (mode == 2) { const int pn = n0 >> 8, bj = (n0 >> 7) & 1, i = n0 & 127; return bj * FF + pn * 128 + i; }
  return n0;
}
__device__ __forceinline__ void transpose_item(const float* __restrict__ W, int K, int N, const float* __restrict__ gk, int mode, bf16_t* __restrict__ WT, float* scr, int item, int lane) {
  const int nblk = N / 32, kb = item / nblk, nb = item % nblk, k0 = 64 * kb, n0 = 32 * nb, s0 = srcblk(mode, n0);
#pragma unroll 8
  for (int i = 0; i < 32; ++i) { const int kk = 2 * i + (lane >> 5); float w = W[(size_t)(k0 + kk) * N + s0 + (lane & 31)]; if (gk) w *= gk[k0 + kk]; scr[kk * 33 + (lane & 31)] = w; }
  asm volatile("s_waitcnt lgkmcnt(0)" ::: "memory");
  const int c = lane & 7;
#pragma unroll
  for (int j = 0; j < 4; ++j) { const int n = (lane >> 3) + 8 * j; const float* s = scr + (8 * c) * 33 + n;
    u32x4 o; o.x = pk2(s[0 * 33], s[1 * 33]); o.y = pk2(s[2 * 33], s[3 * 33]); o.z = pk2(s[4 * 33], s[5 * 33]); o.w = pk2(s[6 * 33], s[7 * 33]);
    *(u32x4*)(WT + (size_t)(n0 + n) * K + k0 + 8 * c) = o; }
  asm volatile("s_waitcnt lgkmcnt(0)" ::: "memory");
}
__device__ __forceinline__ void row_to_bf16_ss(const float* xrow, bf16_t* orow, float* ssp, int lane) {
  const f32x4* xr = (const f32x4*)xrow + lane; f32x4 v[4]; float s = 0.f;
#pragma unroll
  for (int j = 0; j < 4; ++j) { v[j] = xr[64 * j]; s += (v[j][0] * v[j][0] + v[j][1] * v[j][1]) + (v[j][2] * v[j][2] + v[j][3] * v[j][3]); }
  s = wave_sum(s);
  unsigned long long* o8 = (unsigned long long*)orow + lane;
#pragma unroll
  for (int j = 0; j < 4; ++j) o8[64 * j] = (unsigned long long)pk2(v[j][0], v[j][1]) | ((unsigned long long)pk2(v[j][2], v[j][3]) << 32);
  if (lane == 0) *ssp = s;
}
struct WJob { const float* W; int K, N; const float* gk; int mode; size_t dst; };

__device__ __forceinline__ void prep_phase(const Params& P, char* lds, int vcu, int G) {
  const int tid = otid(), lane = tid & 63, wave = tid >> 6;
  float* scr = (float*)(lds + wave * 16384);
  const int gw = vcu * NWAVES + wave, NGW = G * NWAVES; unsigned char* ws = P.ws;
#define TITEM(Wp, K_, N_, gk_, mode_, dst_, r_) transpose_item(Wp, K_, N_, gk_, mode_, (bf16_t*)(ws + (dst_)), scr, r_, lane)
  for (int it = gw; it < 13312; it += NGW) {
    int r = it;
    if (r < 1536) { TITEM(P.in[5], 1024, 3072, P.in[4], 1, WS_WQKV, r); continue; } r -= 1536;
    if (r < 512) { TITEM(P.in[11], 1024, 1024, nullptr, 0, WS_WO, r); continue; } r -= 512;
    if (r < 1024) { TITEM(P.in[12], 1024, 2048, P.in[4] + 1024, 0, WS_WUV, r); continue; } r -= 1024;
    if (r < 512) { TITEM(P.in[17], 1024, 1024, nullptr, 0, WS_WOUT, r); continue; } r -= 512;
    const int L = r >= 4864 ? 1 : 0; r -= L * 4864;
    if (r < 2816) { TITEM(P.in[19] + (size_t)L * 1024 * NUP, 1024, NUP, P.in[18] + L * 1024, 2, WS_WUP + (size_t)L * 11 * MiB, r); continue; } r -= 2816;
    if (r < 1408) { TITEM(P.in[22] + (size_t)L * FF * 1024, FF, 1024, nullptr, 0, WS_WDN + (size_t)L * (11 * MiB / 2), r); continue; } r -= 1408;
    if (r < 512) { TITEM(P.in[24] + (size_t)L * 1024 * 1024, 1024, 1024, P.in[23] + L * 1024, 0, WS_WG + (size_t)L * 2 * MiB, r); continue; } r -= 512;
    TITEM(P.in[25] + (size_t)L * 256 * 1024, 256, 1024, nullptr, 0, WS_WP + (size_t)L * (MiB / 2), r);
  }
#undef TITEM
  for (int m = gw; m < NTOK; m += NGW) { const float* xr = m < HALF_TOK ? P.xin_a + (size_t)m * DM : P.xin_b + (size_t)(m - HALF_TOK) * DM;
    row_to_bf16_ss(xr, (bf16_t*)(ws + WS_XB) + (size_t)m * DM, (float*)(ws + WS_SS) + m, lane); }
  const size_t gt = (size_t)vcu * NTHR + tid, GT = (size_t)G * NTHR;
  for (size_t i = gt; i < (size_t)2 * NTOK * 256 / 8; i += GT) { const size_t e = i * 8; const int L = (int)(e / ((size_t)NTOK * 256)); const size_t r = e % ((size_t)NTOK * 256);
    const float* src = r < (size_t)HALF_TOK * 256 ? P.in[2] + (size_t)L * HALF_TOK * 256 + r : P.in[3] + (size_t)L * HALF_TOK * 256 + (r - (size_t)HALF_TOK * 256);
    const f32x4 a = *(const f32x4*)src, b = *(const f32x4*)(src + 4); *(u32x4*)((bf16_t*)(ws + WS_PB) + e) = pack8(a, b); }
  for (size_t i = gt; i < (size_t)16384 * 32; i += GT) { const int d = (int)(i & 31), pos = (int)(i >> 5);
    const float inv = 1.0f / powf(10000.0f, (float)(2 * d) / 64.0f); const float ang = (float)pos * inv;
    const double tw = 6.283185307179586476925; double r = (double)ang; r -= tw * rint(r / tw); const float rf = (float)r;
    ((float*)(ws + WS_COS))[i] = cosf(rf); ((float*)(ws + WS_SIN))[i] = sinf(rf); }
  for (size_t i = gt; i < (size_t)8 * 128 * 128 / 8; i += GT) { const float* src = P.in[15] + i * 8; *(u32x4*)((bf16_t*)(ws + WS_WSP) + i * 8) = pack8(*(const f32x4*)src, *(const f32x4*)(src + 4)); }
  for (size_t i = gt; i < (size_t)6 * NTOK; i += GT) ((float*)(ws + WS_SS))[NTOK + i] = 0.f;
  for (size_t i = gt; i < (size_t)2 * NTOK; i += GT) ((float*)(ws + WS_LNS))[i] = 0.f;
  if (vcu == 0 && tid == 0) { float d1 = 0.f, d2 = 0.f; for (int i = 0; i < 64; ++i) { d1 += P.in[6][i] * P.in[7][i]; d2 += P.in[8][i] * P.in[9][i]; }
    *(float*)(ws + WS_LAM) = expf(d1) - expf(d2) + 0.2f; }
}

__device__ __forceinline__ void sgu_phase(const Params& P, char* lds, int vcu, int G) {
  const int tid = otid(), lane = tid & 63, w = tid >> 6; unsigned char* ws = P.ws;
  bf16_t* vT = (bf16_t*)lds; bf16_t* Wsm = (bf16_t*)(lds + 34816);
  bf16_t* U = (bf16_t*)(ws + WS_R1); const bf16_t* Vs = (const bf16_t*)(ws + WS_XB); const float* lns = (const float*)(ws + WS_LNS);
  const int c8 = (tid & 15) * 8, q0 = tid >> 4; const int i16 = lane & 15, kg = lane >> 4; const int p = 16 * w + i16;
  int gcur = -1; f32x4 g0, g1, b0, b1; float bias = 0.f;
  u32x4 nv[4]; float ns1[4], ns2[4];
#define SGU_PREF(ui_) do { const int ch_ = (ui_) >> 3, g_ = (ui_) & 7; _Pragma("unroll") for (int i = 0; i < 4; ++i) { const int row_ = ch_ * 128 + q0 + 32 * i; \
      nv[i] = *(const u32x4*)(Vs + (size_t)row_ * DM + g_ * 128 + c8); ns1[i] = lns[row_]; ns2[i] = lns[NTOK + row_]; } } while (0)
  int ui = vcu; if (ui < 4096) SGU_PREF(ui);
#pragma unroll 1
  for (; ui < 4096; ui += G) {
    const int chunk = ui >> 3, g = ui & 7;
    u32x4 cv[4]; float cs1[4], cs2[4];
#pragma unroll
    for (int i = 0; i < 4; ++i) { cv[i] = nv[i]; cs1[i] = ns1[i]; cs2[i] = ns2[i]; }
    if (g != gcur) {
      __syncthreads();
#pragma unroll
      for (int i = 0; i < 4; ++i) { const int pp_ = q0 + 32 * i; *(u32x4*)(Wsm + pp_ * 136 + c8) = *(const u32x4*)((const bf16_t*)(ws + WS_WSP) + (size_t)(g * 128 + pp_) * 128 + c8); }
      const float* lng = P.in[13] + g * 128 + c8; const float* lnb = P.in[14] + g * 128 + c8;
      g0 = *(const f32x4*)lng; g1 = *(const f32x4*)(lng + 4); b0 = *(const f32x4*)lnb; b1 = *(const f32x4*)(lnb + 4); bias = P.in[16][g * 128 + p]; gcur = g;
    }
    if (ui + G < 4096) SGU_PREF(ui + G);
    const size_t token = (size_t)chunk * 128 + p; u32x2 uu[8];
#pragma unroll
    for (int cb = 0; cb < 8; ++cb) uu[cb] = *(const u32x2*)(U + token * DM + g * 128 + 16 * cb + 4 * kg);
#pragma unroll
    for (int i = 0; i < 4; ++i) { const int q = q0 + 32 * i; f32x4 x0, x1; unpack8(cv[i], x0, x1);
      const float mean = cs1[i] * (1.0f / 1024.0f); const float var = cs2[i] * (1.0f / 1024.0f) - mean * mean; const float rs = 1.0f / sqrtf(fmaxf(var, 0.f) + EPS);
      x0 = (x0 - mean) * rs * g0 + b0; x1 = (x1 - mean) * rs * g1 + b1;
#pragma unroll
      for (int e = 0; e < 4; ++e) { vT[(c8 + e) * 136 + q] = (bf16_t)f2bf(x0[e]); vT[(c8 + 4 + e) * 136 + q] = (bf16_t)f2bf(x1[e]); } }
    __syncthreads();
    f32x4 acc[8];
#pragma unroll
    for (int cb = 0; cb < 8; ++cb) acc[cb] = (f32x4){0.f, 0.f, 0.f, 0.f};
#pragma unroll
    for (int ks = 0; ks < 4; ++ks) { const bf16x8 bfrag = *(const bf16x8*)(Wsm + (16 * w + i16) * 136 + ks * 32 + kg * 8);
#pragma unroll
      for (int cb = 0; cb < 8; ++cb) { const bf16x8 afrag = *(const bf16x8*)(vT + (16 * cb + i16) * 136 + ks * 32 + kg * 8);
        acc[cb] = __builtin_amdgcn_mfma_f32_16x16x32_bf16(afrag, bfrag, acc[cb], 0, 0, 0); } }
#pragma unroll
    for (int cb = 0; cb < 8; ++cb) { bf16_t* up = U + token * DM + g * 128 + 16 * cb + 4 * kg;
      const float u0 = __uint_as_float(uu[cb].x << 16), u1 = __uint_as_float(uu[cb].x & 0xffff0000u), u2 = __uint_as_float(uu[cb].y << 16), u3 = __uint_as_float(uu[cb].y & 0xffff0000u);
      u32x2 o; o.x = cvt_pk_bf16(u0 * (acc[cb][0] + bias), u1 * (acc[cb][1] + bias)); o.y = cvt_pk_bf16(u2 * (acc[cb][2] + bias), u3 * (acc[cb][3] + bias)); *(u32x2*)up = o; }
    __syncthreads();
  }
#undef SGU_PREF
}

__device__ __forceinline__ void fixup_phase(const Params& P, int L, int half, int vcu, int G) {
  unsigned char* ws = P.ws; const float* HAL = (const float*)(ws + WS_HALO); bf16_t* Gb = (bf16_t*)(ws + WS_G);
  const float* cw = P.in[20] + (size_t)L * 3 * NUP; const int S = half == 0 ? 16384 : 2048;
  const size_t gt = (size_t)vcu * NTHR + otid(), GT = (size_t)G * NTHR;
  for (size_t i = gt; i < (size_t)512 * 2 * (FF / 4); i += GT) { const int f = (int)(i % (FF / 4)) * 4; const int rb = (int)(i / (FF / 4)); const int blk = rb >> 1, which = rb & 1;
    const int row = blk * 64 + (which ? 63 : 0); const int pos = row % S;
    const float* h = HAL + (size_t)(blk * 4) * NUP;
    f32x4 cv = *(const f32x4*)(h + (2 + which) * NUP + f), cg = *(const f32x4*)(h + (2 + which) * NUP + FF + f);
    if (which == 0) { if (pos != 0) { const float* hp = HAL + (size_t)((blk - 1) * 4 + 1) * NUP; cv += *(const f32x4*)(cw + f) * *(const f32x4*)(hp + f); cg += *(const f32x4*)(cw + FF + f) * *(const f32x4*)(hp + FF + f); } }
    else { if (pos != S - 1) { const float* hn = HAL + (size_t)((blk + 1) * 4 + 0) * NUP; cv += *(const f32x4*)(cw + 2 * NUP + f) * *(const f32x4*)(hn + f); cg += *(const f32x4*)(cw + 2 * NUP + FF + f) * *(const f32x4*)(hn + FF + f); } }
    u32x2 w; w.x = cvt_pk_bf16(cg[0] * sigmoidf_(cg[0]) * cv[0], cg[1] * sigmoidf_(cg[1]) * cv[1]); w.y = cvt_pk_bf16(cg[2] * sigmoidf_(cg[2]) * cv[2], cg[3] * sigmoidf_(cg[3]) * cv[3]);
    *(u32x2*)(Gb + (size_t)row * FF + f) = w; }
}

__device__ __forceinline__ void final_phase(const Params& P, int vcu, int G) {
  const int t_ = otid(); const int lane = t_ & 63, wave = t_ >> 6; const int gw = vcu * NWAVES + wave, NGW = G * NWAVES;
  const float* ss = (const float*)(P.ws + WS_SS) + (size_t)6 * NTOK; const bf16_t* X = (const bf16_t*)(P.ws + WS_R2);
  const f32x4* g4 = (const f32x4*)P.in[26]; const f32x4 ga0 = g4[lane * 2], ga1 = g4[lane * 2 + 1], gb0 = g4[(lane + 64) * 2], gb1 = g4[(lane + 64) * 2 + 1];
  for (int m0 = gw * 4; m0 < NTOK; m0 += NGW * 4) {
    u32x4 xa[4], xb_[4]; float sv[4];
#pragma unroll
    for (int r = 0; r < 4; ++r) { const u32x4* xr = (const u32x4*)(X + (size_t)(m0 + r) * DM) + lane; xa[r] = xr[0]; xb_[r] = xr[64]; sv[r] = ss[m0 + r]; }
#pragma unroll
    for (int r = 0; r < 4; ++r) { const float rs = rstd_of(sv[r]); f32x4* yr = (f32x4*)(P.out + (size_t)(m0 + r) * DM); f32x4 a, b;
      unpack8(xa[r], a, b); yr[lane * 2] = a * rs * ga0; yr[lane * 2 + 1] = b * rs * ga1;
      unpack8(xb_[r], a, b); yr[(lane + 64) * 2] = a * rs * gb0; yr[(lane + 64) * 2 + 1] = b * rs * gb1; } }
}

__global__ void __launch_bounds__(NTHR, 2) mega(Params P) {
  extern __shared__ __attribute__((aligned(16))) unsigned char lds_raw[];
  cg::grid_group grid = cg::this_grid();
  LAS3 unsigned char* lds3 = (LAS3 unsigned char*)lds_raw; char* lds = (char*)lds_raw;
  const int G = gridDim.x, bx = blockIdx.x; const int vcu = (G % 8 == 0) ? (bx % 8) * (G / 8) + bx / 8 : bx;
  unsigned char* ws = P.ws; const int lo = P.ph_lo, hi = P.ph_hi;
  volatile LAS3 unsigned* MISC = (volatile LAS3 unsigned*)(lds3 + 139264);
  if (threadIdx.x < 4) MISC[threadIdx.x] = 0u;
  __syncthreads();
  if (blockIdx.x == 0) for (int i = threadIdx.x; i < XCD_BAR_WORDS; i += NTHR) ((unsigned*)(ws + WS_BAR))[i] = 0u;
  xb::XcdBarrier bar; bar.bar = (unsigned*)(ws + WS_BAR); bar.x = 0; bar.st = MISC;
  float* SS = (float*)(ws + WS_SS);
  bf16_t* XB = (bf16_t*)(ws + WS_XB); bf16_t* R1 = (bf16_t*)(ws + WS_R1); bf16_t* R2 = (bf16_t*)(ws + WS_R2);
#ifndef ENMASK
#define ENMASK 0xffffffffu
#endif
#define IN(k) (lo <= (k) && (k) < hi)
#define EN(b) (((ENMASK) >> (b)) & 1u)
#ifdef PROBE_TA
#ifndef PROBE_DIV
#define PROBE_DIV 2000.0f
#endif
  unsigned long long tp0 = (PROBE_TA == 0) ? __builtin_amdgcn_s_memrealtime() : 0ull, tp1 = 0;
#define STAMP0(k) do { if ((k) == PROBE_TA) tp0 = __builtin_amdgcn_s_memrealtime(); } while (0)
#define STAMP1(k) do { if ((k) == PROBE_TB) tp1 = __builtin_amdgcn_s_memrealtime(); } while (0)
#else
#define STAMP0(k) do {} while (0)
#define STAMP1(k) do {} while (0)
#endif
#define SEAM(k) do { if (IN(k) && IN((k) + 1)) { if ((k) == 0) { grid.sync(); bar = xb::xcd_barrier_post((unsigned*)(ws + WS_BAR), MISC); } else xb::xcd_barrier(bar); } else __syncthreads(); STAMP1(k); STAMP0((k) + 1); } while (0)
#define GEMM(EpiT, E, Aptr, Bptr, M_, N_, K_) do { pg8::Gemm g_{(const bf16_t*)(Aptr), (const bf16_t*)(Bptr), M_, N_, K_}; pg8::StaticOrder S_; S_.init(M_, N_, G, bx); \
    pg8::gemm_phase<EpiT, pg8::StaticOrder, true, true>(lds3, g_, S_, E); } while (0)

  if (EN(0) && IN(0)) { prep_phase(P, lds, vcu, G); }
  SEAM(0);
  if (EN(1) && IN(1)) { EpiQKV E{R1, (bf16_t*)P.out, SS, (const float*)(ws + WS_COS), (const float*)(ws + WS_SIN)};
    GEMM(EpiQKV, E, XB, ws + WS_WQKV, NTOK, 3072, 1024); }
  SEAM(1);
  if (EN(2) && IN(2)) { const float lam = *(const float*)(ws + WS_LAM); const float* subg = P.in[10];
    const bf16_t* Q = R1; const bf16_t* K = (const bf16_t*)P.out; const bf16_t* V = K + (size_t)NTOK * DM; bf16_t* AO = R2;
    const int nu = (G == 256) ? 16 : (4096 + G - 1) / G;
#define ATT_UNIT_ARGS(i) \
      int ui; if (G == 256) { const int x = vcu >> 5, j = vcu & 31; ui = ((i) < 8) ? ((2 * x + ((i) >> 2)) * 128 + j + 32 * ((i) & 3)) : (2048 + (16 * x) * 16 + ((i) - 8) * 32 + j); } \
      else { ui = bx + (i) * G; if (ui >= 4096) break; } \
      long tq0, tk0; int seq, h; \
      if (ui < 2048) { const int ph = ui >> 7, qb = ui & 127; tk0 = (long)(ph >> 3) * 16384; tq0 = tk0 + qb * 128; seq = 16384; h = ph & 7; } \
      else { const int v = ui - 2048, pair = v >> 4, qb = v & 15; tk0 = (long)HALF_TOK + (long)(pair >> 3) * 2048; tq0 = tk0 + qb * 128; seq = 2048; h = pair & 7; }
    unsigned long long badmask = 0ull;
#ifdef PROBE_FORCE_SAFE
    badmask = ~0ull;
#endif
#pragma unroll 1
    for (int i = 0; i < nu && i < 64; ++i) { ATT_UNIT_ARGS(i)
      if (at::diff_unit<true>(Q, K, V, AO, tq0, tk0, seq, h, lam, subg, lds)) badmask |= 1ull << i; }
#pragma unroll 1
    for (int i = 0; i < nu && i < 64; ++i) { if (!((badmask >> i) & 1ull)) continue; ATT_UNIT_ARGS(i)
      (void)at::diff_unit<false>(Q, K, V, AO, tq0, tk0, seq, h, lam, subg, lds); }
#undef ATT_UNIT_ARGS
  }
  SEAM(2);
  if (EN(3) && IN(3)) { EpiRes<0> E{P.xin_a, P.xin_b, nullptr, XB, SS + 1 * NTOK, nullptr, nullptr, 0}; GEMM(EpiRes<0>, E, R2, ws + WS_WO, NTOK, 1024, 1024); }
  SEAM(3);
#pragma unroll 1
  for (int L = 0; L < 2; ++L) {
    const int pb = 4 + 10 * L;
    if (L == 1) {
      if (EN(11) && IN(11)) { EpiUV E{R1, XB, SS + 3 * NTOK, (float*)(ws + WS_LNS)}; GEMM(EpiUV, E, R2, ws + WS_WUV, NTOK, 2048, 1024); }
      SEAM(11);
      if (EN(12) && IN(12)) sgu_phase(P, lds, vcu, G);
      SEAM(12);
      if (EN(13) && IN(13)) { EpiRes<1> E{nullptr, nullptr, R2, XB, SS + 4 * NTOK, nullptr, nullptr, 0}; GEMM(EpiRes<1>, E, R1, ws + WS_WOUT, NTOK, 1024, 1024); }
      SEAM(13);
    }
#pragma unroll 1
    for (int half = 0; half < 2; ++half) {
      const int p0 = pb + 3 * half; const int rowoff = half * HALF_TOK;
      if (EN(4) && IN(p0)) { EpiUp E{(bf16_t*)(ws + WS_G), (float*)(ws + WS_HALO), SS + (size_t)(1 + 3 * L) * NTOK, P.in[20] + (size_t)L * 3 * NUP, P.in[21] + (size_t)L * NUP, rowoff};
        GEMM(EpiUp, E, XB + (size_t)rowoff * DM, ws + WS_WUP + (size_t)L * 11 * MiB, HALF_TOK, NUP, 1024); }
      SEAM(p0);
      if (EN(5) && IN(p0 + 1)) fixup_phase(P, L, half, vcu, G);
      SEAM(p0 + 1);
      if (EN(6) && IN(p0 + 2)) { EpiRes<1> E{nullptr, nullptr, XB, XB, SS + (size_t)(2 + 3 * L) * NTOK, nullptr, nullptr, rowoff};
        GEMM(EpiRes<1>, E, ws + WS_G, ws + WS_WDN + (size_t)L * (11 * MiB / 2), HALF_TOK, 1024, FF); }
      SEAM(p0 + 2);
    }
    const int pp = pb + 6;
    if (EN(10) && IN(pp)) {
      { EpiStore E{R1}; GEMM(EpiStore, E, (bf16_t*)(ws + WS_PB) + (size_t)L * NTOK * 256, ws + WS_WP + (size_t)L * (MiB / 2), NTOK, 1024, 256); }
      __syncthreads();
      { EpiRes<2> E{nullptr, nullptr, XB, R2, SS + (size_t)(3 + 3 * L) * NTOK, SS + (size_t)(2 + 3 * L) * NTOK, R1, 0};
        GEMM(EpiRes<2>, E, XB, ws + WS_WG + (size_t)L * 2 * MiB, NTOK, 1024, 1024); }
    }
    SEAM(pp);
  }
  if (EN(21) && IN(21)) final_phase(P, vcu, G);
#ifdef PROBE_TA
#ifndef PROBE_DIV
#define PROBE_DIV 2000.0f
#endif
  __syncthreads();
#ifdef PROBE_END
  asm volatile("s_waitcnt vmcnt(0)" ::: "memory"); tp1 = __builtin_amdgcn_s_memrealtime();
#endif
  if (bx == 0 && threadIdx.x == 0) { asm volatile("s_waitcnt vmcnt(0)" ::: "memory"); P.out[0] += (float)(tp1 - tp0) * (1.0f / PROBE_DIV); }
#endif
#undef IN
#undef SEAM
#undef EN
#undef GEMM
}
}
#ifndef MODE
#define MODE 0
#endif
#ifndef FASTMASK
#define FASTMASK 0x7f
#endif
namespace fk {
__global__ void __launch_bounds__(256) k_resync(const float* __restrict__ x, bf16_t* __restrict__ xb, float* __restrict__ ss) {
  const int lane = threadIdx.x & 63; const int gw = blockIdx.x * 4 + (threadIdx.x >> 6), NGW = gridDim.x * 4;
  for (int m = gw; m < NTOK; m += NGW) row_to_bf16_ss(x + (size_t)m * DM, xb + (size_t)m * DM, ss + m, lane);
}
}
extern "C" void kernel_launch(void* const* d_in, const int* in_sizes, int n_in, void* d_out, int out_size, void* d_ws, size_t ws_size, hipStream_t stream) {
  static int grid = 0;
  if (grid == 0) {
    if (n_in != 27 || out_size != fk::NTOK * fk::DM || ws_size < (size_t)512 * fk::MiB) { fprintf(stderr, "kernel_launch: unexpected shapes n_in %d out %d ws %zu\n", n_in, out_size, ws_size); grid = -1; return; }
    int dev = 0, cus = 0, per_cu = 0; hipGetDevice(&dev); hipDeviceGetAttribute(&cus, hipDeviceAttributeMultiprocessorCount, dev);
    if (hipFuncSetAttribute((const void*)fk::mega, hipFuncAttributeMaxDynamicSharedMemorySize, fk::LDS_BYTES) != hipSuccess) { fprintf(stderr, "kernel_launch: hipFuncSetAttribute failed\n"); grid = -1; return; }
    if (hipOccupancyMaxActiveBlocksPerMultiprocessor(&per_cu, (const void*)fk::mega, fk::NTHR, fk::LDS_BYTES) != hipSuccess || per_cu < 1) { fprintf(stderr, "kernel_launch: occupancy query says %d\n", per_cu); per_cu = 1; }
    (void)hipGetLastError();
    grid = cus * per_cu; if (grid > 256) grid = 256;
    fprintf(stderr, "kernel_launch: grid %d (cus %d per_cu %d) ws %zu\n", grid, cus, per_cu, ws_size);
  }
  if (grid < 0) return;
  fk::Params p{};
  for (int i = 0; i < 27; ++i) p.in[i] = (const float*)d_in[i];
  p.xin_a = (const float*)d_in[0]; p.xin_b = (const float*)d_in[1]; p.out = (float*)d_out; p.ws = (unsigned char*)d_ws;
#if MODE == 0
  p.ph_lo = 0; p.ph_hi = fk::NPH; void* args[] = {&p};
  hipError_t e = hipLaunchCooperativeKernel((const void*)fk::mega, dim3(grid), dim3(fk::NTHR), args, fk::LDS_BYTES, stream);
  if (e != hipSuccess) fprintf(stderr, "cooperative launch failed: %s (grid %d)\n", hipGetErrorString(e), grid);
#else
  auto runph = [&](int a, int b) { for (int k = a; k <= b; ++k) { p.ph_lo = k; p.ph_hi = k + 1; hipLaunchKernelGGL(fk::mega, dim3(grid), dim3(fk::NTHR), fk::LDS_BYTES, stream, p); } };
  char* nws = (char*)d_ws + 128 * fk::MiB; float* out = (float*)d_out; unsigned char* ws = (unsigned char*)d_ws;
  hipMemsetAsync((char*)d_ws + fk::WS_BAR, 0, 16384, stream);
  runph(0, 0);
  const int first[7] = {1, 4, 10, 11, 14, 20, 21}, last[7] = {3, 9, 10, 13, 19, 20, 21};
  if (!(FASTMASK & 1)) { hipMemcpyAsync(out, d_in[0], (size_t)fk::HALF_TOK * 1024 * 4, hipMemcpyDeviceToDevice, stream); hipMemcpyAsync(out + (size_t)fk::HALF_TOK * 1024, d_in[1], (size_t)fk::HALF_TOK * 1024 * 4, hipMemcpyDeviceToDevice, stream); }
  for (int s = 0; s < 7; ++s) {
    if (FASTMASK & (1 << s)) {
      if (s > 0) fk::k_resync<<<1024, 256, 0, stream>>>(out, (fk::bf16_t*)(ws + (s == 3 ? fk::WS_R2 : fk::WS_XB)), (float*)(ws + fk::WS_SS) + (size_t)s * fk::NTOK);
      runph(first[s], last[s]);
    } else nv::stage(s, d_in, out, nws, stream);
  }
#endif
}
```

```cpp
#include <hip/hip_runtime.h>
#include <hip/hip_cooperative_groups.h>
#include <cstdio>
#include <cstdint>
namespace cg = cooperative_groups;
#define MODE 0
#define FASTMASK 0x7f
namespace pg8 {
#define PG8_LAS __attribute__((address_space(3)))
typedef unsigned short bf16_t;
typedef short bf16x8 __attribute__((ext_vector_type(8)));
typedef float f32x4 __attribute__((ext_vector_type(4)));
typedef unsigned u32x4 __attribute__((ext_vector_type(4)));
constexpr int BM = 256, BK = 64, HALF = 128, HTB = HALF * BK * 2  , STAGE_BYTES = 8 * HTB, NXCD = 8, WGM = 8;

__host__ __device__ __forceinline__ int lds_byte(int r, int c) { const int st = (r >> 4) * 2 + (c >> 5), rr = r & 15, cc = c & 31, ob = rr * 64 + cc * 2; return st * 1024 + (ob ^ (((ob >> 9) & 1) << 5)); }
__host__ __device__ __forceinline__ void stage_rc(int b, int& R, int& C) { const int st = b / 1024, sb = b % 1024, swz = sb ^ (((sb >> 9) & 1) << 5); R = (st >> 1) * 16 + swz / 64; C = (st & 1) * 32 + (swz % 64) / 2; }
__host__ __device__ __forceinline__ int perm32(int rho) { const int n = rho >> 4, i = rho & 15; return 8 * (i >> 2) + 4 * n + (i & 3); }

struct Unit { int pm, pn; };
struct Gemm { const bf16_t* A; const bf16_t* Bt; int M, N, K; };

struct StaticOrder {
    int nM, nN, nwg, G, c;
    __host__ __device__ __forceinline__ void init(int M, int N, int G_, int c_) { nM = M / BM; nN = N / BM; nwg = nM * nN; G = G_; c = c_; }
    __host__ __device__ __forceinline__ bool next(int i, Unit& u) const {
        const long L = (long)i * G + c; if (L >= nwg) return false;
        int wgid = (int)L; { const int q = nwg / NXCD, r = nwg % NXCD, xcd = wgid % NXCD, off = wgid / NXCD; wgid = (xcd < r ? xcd * (q + 1) : r * (q + 1) + (xcd - r) * q) + off; }
        const int nig = WGM * nN, gid = wgid / nig, fm = gid * WGM, gsz = (nM - fm) < WGM ? (nM - fm) : WGM;
        u.pm = fm + ((wgid % nig) % gsz); u.pn = (wgid % nig) / gsz; return true;
    }
    __device__ __forceinline__ void a_ready(const Unit&) const {}
    __device__ __forceinline__ void done(const Unit&) const {}
};

typedef float f32x2cv_t __attribute__((ext_vector_type(2))); typedef __bf16 bf16x2cv_t __attribute__((ext_vector_type(2)));
__device__ __forceinline__ unsigned cvt_pk_bf16(float lo, float hi) { f32x2cv_t v = {lo, hi}; bf16x2cv_t b = __builtin_convertvector(v, bf16x2cv_t); return __builtin_bit_cast(unsigned, b); }
typedef float f32x2 __attribute__((ext_vector_type(2)));
__device__ __forceinline__ f32x2 gelu_pk(f32x2 v) {
    const f32x2 av = __builtin_elementwise_abs(v), d = av * 0.2316418882f + 1.0f;
    f32x2 t; t.x = __builtin_amdgcn_rcpf(d.x); t.y = __builtin_amdgcn_rcpf(d.y);
    f32x2 q = t * 0.5307027145f + (-0.7265760135f); q = q * t + 0.7107068705f; q = q * t + (-0.142248368f); q = q * t + 0.127414796f; q = q * t;
    const f32x2 s = (v * v) * (-0.72134752044f);
    f32x2 e; e.x = __builtin_amdgcn_exp2f(s.x); e.y = __builtin_amdgcn_exp2f(s.y);
    const f32x2 m = v * (q * e), r = v - m;
    f32x2 o; o.x = v.x < 0.f ? m.x : r.x; o.y = v.y < 0.f ? m.y : r.y; return o;
}

template <class Epi, class Sched, bool ALIGN_EPI = false, bool SP2 = false>
__device__ __forceinline__ void gemm_phase(PG8_LAS unsigned char* lds, const Gemm g, const Sched& S, const Epi& E) {
    int tid_ = threadIdx.x; asm volatile("" : "+v"(tid_));
    const int tid = tid_, wid = __builtin_amdgcn_readfirstlane(tid >> 6), lane = tid & 63, wr = wid >> 2, wc = wid & 3, fr = lane & 15, fq = lane >> 4;
    const int K = g.K, nt = K / BK;
    unsigned voffA[2], voffB[2];
#pragma unroll
    for (int i = 0; i < 2; ++i) { int R, C; stage_rc(tid * 16 + i * 8192, R, C); const int Rb = Epi::PERM ? ((R & ~31) + perm32(R & 31)) : R;
        voffA[i] = (unsigned)(R * K + C) * 2u; voffB[i] = (unsigned)(Rb * K + C) * 2u; }
    const size_t kstep = (size_t)(BK * 2);
    const size_t hstep = (size_t)HALF * K * 2;
    const size_t tstep = 2 * hstep;
    const unsigned ldsw = (unsigned)wid * 1024u;
    const int aoff = lds_byte(wr * 64 + fr, fq * 8), boff = lds_byte(wc * 32 + fr, fq * 8);
#define PG8_SA(b, h) (((b) * 2 + (h)) * HTB)
#define PG8_SB(b, h) ((4 + (b) * 2 + (h)) * HTB)
#define PG8_STAGE(bufoff, gbase, voff) do { _Pragma("unroll") for (int _i = 0; _i < 2; ++_i) \
        __builtin_amdgcn_global_load_lds((const unsigned*)((const char*)(gbase) + (voff)[_i]), (PG8_LAS unsigned*)(lds + (bufoff) + ldsw + _i * 8192), 16, 0, 0); } while (0)
#define PG8_LDA(dst, b, h) do { _Pragma("unroll") for (int m = 0; m < 4; ++m) _Pragma("unroll") for (int k = 0; k < 2; ++k) dst[m][k] = *(const PG8_LAS bf16x8*)(lds + PG8_SA(b, h) + aoff + m * 2048 + k * 1024); } while (0)
#define PG8_LDB(dst, b, h) do { _Pragma("unroll") for (int n = 0; n < 2; ++n) _Pragma("unroll") for (int k = 0; k < 2; ++k) dst[n][k] = *(const PG8_LAS bf16x8*)(lds + PG8_SB(b, h) + boff + n * 2048 + k * 1024); } while (0)
#define PG8_MMA(ai, bj, At, Bt) do { __builtin_amdgcn_s_setprio(1); _Pragma("unroll") for (int m = 0; m < 4; ++m) _Pragma("unroll") for (int n = 0; n < 2; ++n) _Pragma("unroll") for (int k = 0; k < 2; ++k) \
        acc[ai][bj][m][n] = __builtin_amdgcn_mfma_f32_16x16x32_bf16(Bt[n][k], At[m][k], acc[ai][bj][m][n], 0, 0, 0); __builtin_amdgcn_s_setprio(0); } while (0)
#define PG8_WAIT_V(n) asm volatile("s_waitcnt vmcnt(" #n ")" ::: "memory")
#define PG8_WAIT_L(n) asm volatile("s_waitcnt lgkmcnt(" #n ")" ::: "memory")
#define PG8_BAR __builtin_amdgcn_s_barrier()
#define PG8_SCHED __builtin_amdgcn_sched_barrier(0)
    Unit cur, nxt; int ui = 0;
    if (!S.next(0, cur)) return;
    f32x4 acc[2][2][4][2];
#pragma unroll
    for (int a = 0; a < 2; ++a)
#pragma unroll
        for (int b = 0; b < 2; ++b)
#pragma unroll
            for (int m = 0; m < 4; ++m)
#pragma unroll
                for (int n = 0; n < 2; ++n) acc[a][b][m][n] = (f32x4){0.f, 0.f, 0.f, 0.f};
    bf16x8 At[4][2], B0[2][2], B1[2][2];
    const char* cA = (const char*)g.A + (size_t)cur.pm * tstep; const char* cB = (const char*)g.Bt + (size_t)cur.pn * tstep;
    S.a_ready(cur);
    if constexpr (SP2) {
        PG8_STAGE(PG8_SB(0, 0), cB, voffB); PG8_STAGE(PG8_SB(0, 1), cB + hstep, voffB); PG8_STAGE(PG8_SA(0, 0), cA, voffA); PG8_STAGE(PG8_SA(0, 1), cA + hstep, voffA);
        if (wr == 1) PG8_BAR;
        PG8_WAIT_V(2); PG8_BAR;
        PG8_STAGE(PG8_SB(1, 0), cB + kstep, voffB); PG8_STAGE(PG8_SA(1, 0), cA + kstep, voffA); PG8_STAGE(PG8_SB(1, 1), cB + hstep + kstep, voffB);
        PG8_WAIT_V(6); PG8_BAR;
    } else {
        PG8_STAGE(PG8_SB(0, 0), cB, voffB); PG8_STAGE(PG8_SA(0, 0), cA, voffA); PG8_STAGE(PG8_SB(0, 1), cB + hstep, voffB); PG8_STAGE(PG8_SA(0, 1), cA + hstep, voffA);
        if (wr == 1) PG8_BAR;
        PG8_WAIT_V(4); PG8_BAR;
        PG8_STAGE(PG8_SB(1, 0), cB + kstep, voffB); PG8_STAGE(PG8_SA(1, 0), cA + kstep, voffA); PG8_STAGE(PG8_SB(1, 1), cB + hstep + kstep, voffB);
        PG8_WAIT_V(6); PG8_BAR;
    }
    for (;;) {
        const bool has_next = S.next(ui + 1, nxt);
        const char* nA = has_next ? (const char*)g.A + (size_t)nxt.pm * tstep : cA; const char* nB = has_next ? (const char*)g.Bt + (size_t)nxt.pn * tstep : cB;
#pragma unroll 1
        for (int t = 0; t < nt; t += 2) {
            const bool last = (t == nt - 2);
            const char* a1 = cA + (size_t)(t + 1) * kstep;
            const char* a2 = last ? nA : cA + (size_t)(t + 2) * kstep; const char* b2 = last ? nB : cB + (size_t)(t + 2) * kstep;
            const char* a3 = a2 + kstep; const char* b3 = b2 + kstep;
            if (last && has_next) S.a_ready(nxt);
            if constexpr (SP2) {
            PG8_LDB(B0, 0, 0); PG8_LDB(B1, 0, 1); PG8_SCHED; PG8_LDA(At, 0, 0); PG8_STAGE(PG8_SA(1, 1), a1 + hstep, voffA);
            PG8_WAIT_V(8); PG8_WAIT_L(0); PG8_BAR; PG8_MMA(0, 0, At, B0); PG8_MMA(0, 1, At, B1); PG8_BAR; PG8_SCHED;
            PG8_LDA(At, 0, 1); PG8_STAGE(PG8_SB(0, 0), b2, voffB); PG8_STAGE(PG8_SB(0, 1), b2 + hstep, voffB); PG8_STAGE(PG8_SA(0, 0), a2, voffA);
            PG8_WAIT_V(8); PG8_WAIT_L(0); PG8_BAR; PG8_MMA(1, 0, At, B0); PG8_MMA(1, 1, At, B1); PG8_BAR; PG8_SCHED;
            PG8_LDB(B0, 1, 0); PG8_LDB(B1, 1, 1); PG8_SCHED; PG8_LDA(At, 1, 0); PG8_STAGE(PG8_SA(0, 1), a2 + hstep, voffA);
            PG8_WAIT_V(8); PG8_WAIT_L(0); PG8_BAR; PG8_MMA(0, 0, At, B0); PG8_MMA(0, 1, At, B1); PG8_BAR; PG8_SCHED;
            PG8_LDA(At, 1, 1); PG8_STAGE(PG8_SB(1, 0), b3, voffB); PG8_STAGE(PG8_SB(1, 1), b3 + hstep, voffB); PG8_STAGE(PG8_SA(1, 0), a3, voffA);
            PG8_WAIT_V(8); PG8_WAIT_L(0); PG8_BAR; PG8_MMA(1, 0, At, B0); PG8_MMA(1, 1, At, B1); PG8_BAR; PG8_SCHED;
            } else {
            PG8_LDB(B0, 0, 0); PG8_SCHED; PG8_LDA(At, 0, 0); PG8_STAGE(PG8_SA(1, 1), a1 + hstep, voffA);
            PG8_WAIT_L(8); PG8_BAR; PG8_WAIT_L(0); PG8_MMA(0, 0, At, B0); PG8_BAR; PG8_SCHED;
            PG8_LDB(B1, 0, 1); PG8_STAGE(PG8_SB(0, 0), b2, voffB);
            PG8_BAR; PG8_WAIT_L(0); PG8_MMA(0, 1, At, B1); PG8_BAR;
            PG8_LDA(At, 0, 1); PG8_STAGE(PG8_SA(0, 0), a2, voffA);
            PG8_BAR; PG8_WAIT_L(0); PG8_MMA(1, 0, At, B0); PG8_BAR; PG8_SCHED;
            PG8_STAGE(PG8_SB(0, 1), b2 + hstep, voffB);
            PG8_WAIT_V(6); PG8_BAR; PG8_MMA(1, 1, At, B1); PG8_BAR;
            PG8_LDB(B0, 1, 0); PG8_SCHED; PG8_LDA(At, 1, 0); PG8_STAGE(PG8_SA(0, 1), a2 + hstep, voffA);
            PG8_WAIT_L(8); PG8_BAR; PG8_WAIT_L(0); PG8_MMA(0, 0, At, B0); PG8_BAR; PG8_SCHED;
            PG8_LDB(B1, 1, 1); PG8_STAGE(PG8_SB(1, 0), b3, voffB);
            PG8_BAR; PG8_WAIT_L(0); PG8_MMA(0, 1, At, B1); PG8_BAR;
            PG8_LDA(At, 1, 1); PG8_STAGE(PG8_SA(1, 0), a3, voffA);
            PG8_BAR; PG8_WAIT_L(0); PG8_MMA(1, 0, At, B0); PG8_BAR; PG8_SCHED;
            PG8_STAGE(PG8_SB(1, 1), b3 + hstep, voffB);
            PG8_WAIT_V(6); PG8_BAR; PG8_MMA(1, 1, At, B1); PG8_BAR;
            }
        }
        if constexpr (ALIGN_EPI) { if (wr == 0) PG8_BAR; }
        if constexpr (!Epi::AFTER_DRAIN) { E(acc, cur, wr, wc, fr, fq); S.done(cur); }
        if (!has_next) break;
#pragma unroll
        for (int a = 0; a < 2; ++a)
#pragma unroll
            for (int b = 0; b < 2; ++b)
#pragma unroll
                for (int m = 0; m < 4; ++m)
#pragma unroll
                    for (int n = 0; n < 2; ++n) acc[a][b][m][n] = (f32x4){0.f, 0.f, 0.f, 0.f};
        cur = nxt; cA = nA; cB = nB; ++ui;
        if constexpr (ALIGN_EPI) { if (wr == 1) PG8_BAR; }
    }
    PG8_WAIT_V(0);
    if constexpr (!ALIGN_EPI) { if (wr == 0) PG8_BAR; }
    PG8_BAR;
    if constexpr (Epi::AFTER_DRAIN) { E.fused(acc, cur, wr, wc, fr, fq, lds, wid, lane); S.done(cur); }
#undef PG8_SA
#undef PG8_SB
#undef PG8_STAGE
#undef PG8_LDA
#undef PG8_LDB
#undef PG8_MMA
#undef PG8_WAIT_V
#undef PG8_WAIT_L
#undef PG8_BAR
#undef PG8_SCHED
}
}
namespace xb {
#define LAS __attribute__((address_space(3)))
#define XB_TMO      128
#define XB_XCNT(j)  (256  + 64 * (j))
#define XB_XSUB(j)  (1280 + 64 * (j))
#define XB_XGEN(j)  (2304 + 64 * (j))
#define XB_TOP      3328
#define XB_TOPGEN   3392
#define XCD_BAR_WORDS 3456
#define XB_SPIN_CAP (1u << 18)

__device__ __forceinline__ unsigned xb_ld(unsigned* p)              { return __hip_atomic_load(p, __ATOMIC_RELAXED, __HIP_MEMORY_SCOPE_AGENT); }
__device__ __forceinline__ unsigned xb_add(unsigned* p, unsigned v) { return __hip_atomic_fetch_add(p, v, __ATOMIC_RELAXED, __HIP_MEMORY_SCOPE_AGENT); }
__device__ __forceinline__ unsigned xb_xcc_id() { return (unsigned)__builtin_amdgcn_s_getreg((3 << 11) | 20) & 0xFu; }
#define XB_SPIN(cond, bar) do { unsigned _sp = 0; while (cond) { __builtin_amdgcn_s_sleep(1); \
    if ((++_sp & 255u) == 0u) { if (xb_ld(&(bar)[XB_TMO])) break; if (_sp > XB_SPIN_CAP) { atomicAdd(&(bar)[XB_TMO], 1u); break; } } } } while (0)

struct XcdBarrier {
    unsigned* bar; unsigned x;
    volatile LAS unsigned* st;
};

__device__ __forceinline__ XcdBarrier xcd_barrier_post(unsigned* bar, volatile LAS unsigned* st) {
    XcdBarrier b; b.bar = bar; b.x = xb_xcc_id(); b.st = st;
    if (threadIdx.x == 0) (void)xb_add(&bar[XB_XCNT(b.x)], 1u);
    return b;
}
__device__ __forceinline__ void xcd_barrier_complete(unsigned* bar, unsigned x, unsigned& nloc, unsigned& nx) {
    const unsigned G = gridDim.x * gridDim.y * gridDim.z;
    unsigned sum, cnt, mine, sp = 0u;
    for (;;) {
        sum = 0u; cnt = 0u; mine = 0u;
#pragma unroll
        for (unsigned j = 0; j < 16; ++j) { const unsigned c = xb_ld(&bar[XB_XCNT(j)]); sum += c; cnt += (c > 0u) ? 1u : 0u; mine = (j == x) ? c : mine; }
        if (sum == G) break;
        __builtin_amdgcn_s_sleep(1);
        if ((++sp & 255u) == 0u) { if (xb_ld(&bar[XB_TMO])) break; if (sp > XB_SPIN_CAP) { atomicAdd(&bar[XB_TMO], 1u); break; } }
    }
    nloc = mine > 0u ? mine : 1u; nx = cnt > 0u ? cnt : 1u;
}

__device__ __forceinline__ void xcd_barrier(const XcdBarrier& b) {
    asm volatile("s_waitcnt vmcnt(0)" ::: "memory");
    __syncthreads();
    if (threadIdx.x == 0) {
        unsigned* bar = b.bar;
        __builtin_amdgcn_s_waitcnt(0);
        unsigned nloc = b.st[0], nx = b.st[1];
        if (nloc == 0u) { xcd_barrier_complete(bar, b.x, nloc, nx); b.st[0] = nloc; b.st[1] = nx; }
        const unsigned old = xb_add(&bar[XB_XSUB(b.x)], 1u);
        const unsigned gen = old / nloc;
        if (old + 1u == (gen + 1u) * nloc) {
            __builtin_amdgcn_fence(__ATOMIC_RELEASE, "agent");
            asm volatile("s_waitcnt vmcnt(0)" ::: "memory");
            const unsigned og = xb_add(&bar[XB_TOP], 1u);
            const unsigned tg = og / nx;
            if (og + 1u == (tg + 1u) * nx) xb_add(&bar[XB_TOPGEN], 1u);
            else XB_SPIN(xb_ld(&bar[XB_TOPGEN]) == tg, bar);
            __builtin_amdgcn_fence(__ATOMIC_ACQUIRE, "agent");
            xb_add(&bar[XB_XGEN(b.x)], 1u);
            asm volatile("s_waitcnt vmcnt(0)" ::: "memory");
        } else {
            XB_SPIN(xb_ld(&bar[XB_XGEN(b.x)]) == gen, bar);
            __builtin_amdgcn_fence(__ATOMIC_ACQUIRE, "agent");
            asm volatile("s_waitcnt vmcnt(0)" ::: "memory");
        }
    }
    __syncthreads();
}
#undef LAS
}
namespace fk {
using pg8::bf16_t; using pg8::bf16x8; using pg8::f32x4; using pg8::u32x4; using pg8::Unit; using pg8::cvt_pk_bf16; using pg8::f32x2;
typedef unsigned u32x2 __attribute__((ext_vector_type(2)));
constexpr int NTOK = 65536, DM = 1024, FF = 2816, NUP = 5632, HALF_TOK = 32768;
constexpr size_t MiB = (size_t)1 << 20;
constexpr size_t WS_LAM = 0, WS_BAR = 4096, WS_SS = 1 * MiB, WS_LNS = 3 * MiB, WS_COS = 4 * MiB, WS_SIN = 6 * MiB, WS_WSP = 8 * MiB;
constexpr size_t WS_WQKV = 10 * MiB, WS_WO = 16 * MiB, WS_WUV = 18 * MiB, WS_WOUT = 22 * MiB, WS_WUP = 24 * MiB, WS_WDN = 46 * MiB, WS_WG = 57 * MiB, WS_WP = 61 * MiB;
constexpr size_t WS_PB = 64 * MiB, WS_XB = 128 * MiB, WS_R1 = 256 * MiB, WS_R2 = 384 * MiB, WS_G = 256 * MiB, WS_HALO = 432 * MiB;
constexpr float EPS = 1e-6f;

struct Params {
  const float* in[27];
  const float* xin_a; const float* xin_b;
  float* out; unsigned char* ws;
  int ph_lo, ph_hi;
};

__device__ __forceinline__ float rstd_of(float ss) { return 1.0f / sqrtf(ss * (1.0f / 1024.0f) + EPS); }
__device__ __forceinline__ float bf2f(unsigned short b) { return __uint_as_float((unsigned)b << 16); }
__device__ __forceinline__ float sigmoidf_(float x) { return __builtin_amdgcn_rcpf(1.0f + __builtin_amdgcn_exp2f(-1.4426950408889634f * x)); }
__device__ __forceinline__ u32x4 pack8(const f32x4 a, const f32x4 b) { u32x4 w; w.x = cvt_pk_bf16(a[0], a[1]); w.y = cvt_pk_bf16(a[2], a[3]); w.z = cvt_pk_bf16(b[0], b[1]); w.w = cvt_pk_bf16(b[2], b[3]); return w; }
__device__ __forceinline__ void unpack8(const u32x4 w, f32x4& a, f32x4& b) {
  a[0] = __uint_as_float(w.x << 16); a[1] = __uint_as_float(w.x & 0xffff0000u); a[2] = __uint_as_float(w.y << 16); a[3] = __uint_as_float(w.y & 0xffff0000u);
  b[0] = __uint_as_float(w.z << 16); b[1] = __uint_as_float(w.z & 0xffff0000u); b[2] = __uint_as_float(w.w << 16); b[3] = __uint_as_float(w.w & 0xffff0000u); }

__device__ __forceinline__ float sum_fq(float v) {
  auto a = __builtin_amdgcn_permlane16_swap(__float_as_uint(v), __float_as_uint(v), false, false); v = __uint_as_float(a[0]) + __uint_as_float(a[1]);
  auto b = __builtin_amdgcn_permlane32_swap(__float_as_uint(v), __float_as_uint(v), false, false); return __uint_as_float(b[0]) + __uint_as_float(b[1]); }
__device__ __forceinline__ float row_prev(float v) { return __int_as_float(__builtin_amdgcn_update_dpp(0, __float_as_int(v), 0x121, 0xf, 0xf, false)); }
__device__ __forceinline__ float row_next(float v) { return __int_as_float(__builtin_amdgcn_update_dpp(0, __float_as_int(v), 0x12f, 0xf, 0xf, false)); }
#define ACC_T const f32x4 (&acc)[2][2][4][2]
__device__ __forceinline__ int opaque_lane() { int l; asm volatile("v_mbcnt_lo_u32_b32 %0, -1, 0\n\tv_mbcnt_hi_u32_b32 %0, -1, %0" : "=v"(l)); return l; }
#define OPAQUE_LANE() const int ol_ = opaque_lane(); const int fr = ol_ & 15, fq = ol_ >> 4;

struct EpiQKV {
  static constexpr bool PERM = true, AFTER_DRAIN = false;
  bf16_t *Q, *KV; const float* ss; const float* cs; const float* sn;
  __device__ __forceinline__ void operator()(ACC_T, const Unit& u, int wr, int wc, int fr_, int fq_) const { OPAQUE_LANE()
    const int sect = u.pn >> 2; bf16_t* base = KV + (size_t)(sect > 0 ? sect - 1 : 0) * NTOK * DM; if (sect == 0) base = Q;
    const int rowb = u.pm * 256 + wr * 64 + fr; const float qs = (sect == 0 ? 0.18033688011112042f : 1.0f);
    if (sect < 2) {
      f32x4 ct[4], nt[4]; float crs, nrs;
#define QK_LOAD(T, RS, idx) do { const int row_ = rowb + ((idx) >> 2) * 128 + ((idx) & 3) * 16; const int pos_ = row_ < HALF_TOK ? (row_ & 16383) : (row_ & 2047); \
        RS = ss[row_]; T[0] = *(const f32x4*)(cs + pos_ * 32 + 8 * fq); T[1] = *(const f32x4*)(cs + pos_ * 32 + 8 * fq + 4); \
        T[2] = *(const f32x4*)(sn + pos_ * 32 + 8 * fq); T[3] = *(const f32x4*)(sn + pos_ * 32 + 8 * fq + 4); } while (0)
      QK_LOAD(ct, crs, 0);
      const int col = ((u.pn & 3) * 4 + wc) * 64 + 8 * fq;
#pragma unroll
      for (int idx = 0; idx < 8; ++idx) { const int ai = idx >> 2, m = idx & 3; const int row = rowb + ai * 128 + m * 16;
        if (idx < 7) QK_LOAD(nt, nrs, idx + 1);
        const float rs = rstd_of(crs) * qs; bf16_t* rowp = base + (size_t)row * DM;
        u32x4 w1, w2;
        { const f32x4 x1 = acc[ai][0][m][0] * rs, x2 = acc[ai][1][m][0] * rs; const f32x4 o1 = x1 * ct[0] - x2 * ct[2], o2 = x2 * ct[0] + x1 * ct[2];
          w1.x = cvt_pk_bf16(o1[0], o1[1]); w1.y = cvt_pk_bf16(o1[2], o1[3]); w2.x = cvt_pk_bf16(o2[0], o2[1]); w2.y = cvt_pk_bf16(o2[2], o2[3]); }
        { const f32x4 x1 = acc[ai][0][m][1] * rs, x2 = acc[ai][1][m][1] * rs; const f32x4 o1 = x1 * ct[1] - x2 * ct[3], o2 = x2 * ct[1] + x1 * ct[3];
          w1.z = cvt_pk_bf16(o1[0], o1[1]); w1.w = cvt_pk_bf16(o1[2], o1[3]); w2.z = cvt_pk_bf16(o2[0], o2[1]); w2.w = cvt_pk_bf16(o2[2], o2[3]); }
        *(u32x4*)(rowp + col) = w1; *(u32x4*)(rowp + col + 32) = w2;
        asm volatile("" ::: "memory");
#pragma unroll
        for (int t = 0; t < 4; ++t) ct[t] = nt[t];
        crs = nrs; }
#undef QK_LOAD
    } else {
      float rsv[8];
#pragma unroll
      for (int idx = 0; idx < 8; ++idx) rsv[idx] = ss[rowb + (idx >> 2) * 128 + (idx & 3) * 16];
#pragma unroll
      for (int idx = 0; idx < 8; ++idx) { const int ai = idx >> 2, m = idx & 3; const int row = rowb + ai * 128 + m * 16; const float rs = rstd_of(rsv[idx]); bf16_t* rowp = base + (size_t)row * DM;
#pragma unroll
        for (int bj = 0; bj < 2; ++bj) { const int col = (u.pn & 3) * 256 + bj * 128 + wc * 32 + 8 * fq;
          *(u32x4*)(rowp + col) = pack8(acc[ai][bj][m][0] * rs, acc[ai][bj][m][1] * rs); }
        asm volatile("" ::: "memory"); }
    }
  }
};

template <int KIND> struct EpiRes {
  static constexpr bool PERM = true, AFTER_DRAIN = false;
  const float* xa; const float* xb_src; const bf16_t* xsrc; bf16_t* xbo; float* ssn; const float* ss; const bf16_t* pp; int rowoff;
  __device__ __forceinline__ void operator()(ACC_T, const Unit& u, int wr, int wc, int fr_, int fq_) const { OPAQUE_LANE()
    const int colb = u.pn * 256 + wc * 32 + 8 * fq; const int rowb = rowoff + u.pm * 256 + wr * 64 + fr;
    f32x4 cx[4], nx[4]; u32x4 cb[2], nb[2], cp[2], np[2]; float crs = 1.f, nrs = 1.f;
#define RES_LOAD(X, XB_, PPV, RS, idx) do { const int row_ = rowb + ((idx) >> 2) * 128 + ((idx) & 3) * 16; \
      if (KIND == 0) { const float* xr_ = (row_ < HALF_TOK ? xa + (size_t)row_ * DM : xb_src + (size_t)(row_ - HALF_TOK) * DM); \
        X[0] = __builtin_nontemporal_load((const f32x4*)(xr_ + colb)); X[1] = __builtin_nontemporal_load((const f32x4*)(xr_ + colb + 4)); X[2] = __builtin_nontemporal_load((const f32x4*)(xr_ + colb + 128)); X[3] = __builtin_nontemporal_load((const f32x4*)(xr_ + colb + 132)); } \
      else { XB_[0] = *(const u32x4*)(xsrc + (size_t)row_ * DM + colb); XB_[1] = *(const u32x4*)(xsrc + (size_t)row_ * DM + colb + 128); } \
      if (KIND == 2) { PPV[0] = *(const u32x4*)(pp + (size_t)row_ * DM + colb); PPV[1] = *(const u32x4*)(pp + (size_t)row_ * DM + colb + 128); RS = rstd_of(ss[row_]); } } while (0)
    RES_LOAD(cx, cb, cp, crs, 0);
#pragma unroll
    for (int idx = 0; idx < 8; ++idx) {
      const int ai = idx >> 2, m = idx & 3; const int row = rowb + ai * 128 + m * 16;
      if (idx < 7) RES_LOAD(nx, nb, np, nrs, idx + 1);
      float sq = 0.f;
#pragma unroll
      for (int bj = 0; bj < 2; ++bj) { const int col = colb + bj * 128;
        f32x4 d0 = acc[ai][bj][m][0], d1 = acc[ai][bj][m][1];
        if (KIND == 2) { f32x4 p0, p1; unpack8(cp[bj], p0, p1);
#pragma unroll
          for (int j = 0; j < 4; ++j) { d0[j] = sigmoidf_(d0[j] * crs) * p0[j]; d1[j] = sigmoidf_(d1[j] * crs) * p1[j]; } }
        f32x4 a0, a1; if (KIND == 0) { a0 = cx[2 * bj]; a1 = cx[2 * bj + 1]; } else unpack8(cb[bj], a0, a1);
        const f32x4 v0 = a0 + d0, v1 = a1 + d1;
        *(u32x4*)(xbo + (size_t)row * DM + col) = pack8(v0, v1);
        sq += (v0[0] * v0[0] + v0[1] * v0[1]) + (v0[2] * v0[2] + v0[3] * v0[3]) + (v1[0] * v1[0] + v1[1] * v1[1]) + (v1[2] * v1[2] + v1[3] * v1[3]); }
      sq = sum_fq(sq);
      if (fq == 0) atomicAdd(ssn + row, sq);
      asm volatile("" ::: "memory");
      if (KIND == 0) {
#pragma unroll
        for (int t = 0; t < 4; ++t) cx[t] = nx[t]; }
      else { cb[0] = nb[0]; cb[1] = nb[1]; }
      if (KIND == 2) { cp[0] = np[0]; cp[1] = np[1]; crs = nrs; }
    }
#undef RES_LOAD
  }
};

struct EpiStore {
  static constexpr bool PERM = true, AFTER_DRAIN = false;
  bf16_t* O;
  __device__ __forceinline__ void operator()(ACC_T, const Unit& u, int wr, int wc, int fr_, int fq_) const { OPAQUE_LANE()
#pragma unroll
    for (int ai = 0; ai < 2; ++ai)
#pragma unroll
      for (int m = 0; m < 4; ++m) { const int row = u.pm * 256 + ai * 128 + wr * 64 + m * 16 + fr;
#pragma unroll
        for (int bj = 0; bj < 2; ++bj) { const int col = u.pn * 256 + bj * 128 + wc * 32 + 8 * fq;
          *(u32x4*)(O + (size_t)row * DM + col) = pack8(acc[ai][bj][m][0], acc[ai][bj][m][1]); } asm volatile("" ::: "memory"); }
  }
};

struct EpiUV {
  static constexpr bool PERM = true, AFTER_DRAIN = false;
  bf16_t *U, *Vs; const float* ss; float* lns;
  __device__ __forceinline__ void operator()(ACC_T, const Unit& u, int wr, int wc, int fr_, int fq_) const { OPAQUE_LANE()
    const bool isv = u.pn >= 4; bf16_t* base = isv ? Vs : U;
    float rsv[8];
#pragma unroll
    for (int idx = 0; idx < 8; ++idx) rsv[idx] = ss[u.pm * 256 + (idx >> 2) * 128 + wr * 64 + (idx & 3) * 16 + fr];
#pragma unroll
    for (int ai = 0; ai < 2; ++ai)
#pragma unroll
      for (int m = 0; m < 4; ++m) { const int row = u.pm * 256 + ai * 128 + wr * 64 + m * 16 + fr; const float rs = rstd_of(rsv[ai * 4 + m]);
        float s1 = 0.f, s2 = 0.f;
#pragma unroll
        for (int bj = 0; bj < 2; ++bj) { const int col = (u.pn & 3) * 256 + bj * 128 + wc * 32 + 8 * fq;
          const f32x4 v0 = acc[ai][bj][m][0] * rs, v1 = acc[ai][bj][m][1] * rs;
          const f32x2 a = pg8::gelu_pk((f32x2){v0[0], v0[1]}), b = pg8::gelu_pk((f32x2){v0[2], v0[3]}), c = pg8::gelu_pk((f32x2){v1[0], v1[1]}), d = pg8::gelu_pk((f32x2){v1[2], v1[3]});
          s1 += (a.x + a.y) + (b.x + b.y) + (c.x + c.y) + (d.x + d.y);
          s2 += (a.x * a.x + a.y * a.y) + (b.x * b.x + b.y * b.y) + (c.x * c.x + c.y * c.y) + (d.x * d.x + d.y * d.y);
          u32x4 w; w.x = cvt_pk_bf16(a.x, a.y); w.y = cvt_pk_bf16(b.x, b.y); w.z = cvt_pk_bf16(c.x, c.y); w.w = cvt_pk_bf16(d.x, d.y);
          *(u32x4*)(base + (size_t)row * DM + col) = w; asm volatile("" ::: "memory"); }
        if (isv) { s1 = sum_fq(s1); s2 = sum_fq(s2);
          if (fq == 0) { atomicAdd(lns + row, s1); atomicAdd(lns + NTOK + row, s2); } }
        asm volatile("" ::: "memory");
      }
  }
};

struct EpiUp {
  static constexpr bool PERM = true, AFTER_DRAIN = false;
  bf16_t* G; float* HAL; const float* ss; const float* cw; const float* cb; int rowoff;
  __device__ __forceinline__ void operator()(ACC_T, const Unit& u, int wr, int wc, int fr_, int fq_) const { OPAQUE_LANE()
    float rs[2][4];
#pragma unroll
    for (int ai = 0; ai < 2; ++ai)
#pragma unroll
      for (int m = 0; m < 4; ++m) rs[ai][m] = ss[rowoff + u.pm * 256 + ai * 128 + wr * 64 + 16 * m + fr];
#pragma unroll
    for (int n = 0; n < 2; ++n) {
      const int cv = u.pn * 128 + wc * 32 + 8 * fq + 4 * n;
      const f32x4 wv0 = *(const f32x4*)(cw + cv), wv1 = *(const f32x4*)(cw + NUP + cv), wv2 = *(const f32x4*)(cw + 2 * NUP + cv), bv = *(const f32x4*)(cb + cv);
      const f32x4 wg0 = *(const f32x4*)(cw + FF + cv), wg1 = *(const f32x4*)(cw + NUP + FF + cv), wg2 = *(const f32x4*)(cw + 2 * NUP + FF + cv), bg = *(const f32x4*)(cb + FF + cv);
#pragma unroll
      for (int ai = 0; ai < 2; ++ai) {
        const int R0 = u.pm * 256 + ai * 128 + wr * 64; const int blk = R0 >> 6;
        f32x4 av[4], ag[4];
#pragma unroll
        for (int m = 0; m < 4; ++m) { const float r_ = rstd_of(rs[ai][m]); av[m] = acc[ai][0][m][n] * r_; ag[m] = acc[ai][1][m][n] * r_; }
#pragma unroll
        for (int m = 0; m < 4; ++m) {
          f32x4 pv, pg, nv, ng;
#pragma unroll
          for (int j = 0; j < 4; ++j) {
            const float sv = (fr == 15) ? (m > 0 ? av[m > 0 ? m - 1 : 0][j] : 0.f) : av[m][j];
            const float sg = (fr == 15) ? (m > 0 ? ag[m > 0 ? m - 1 : 0][j] : 0.f) : ag[m][j];
            pv[j] = row_prev(sv); pg[j] = row_prev(sg);
            const float tv = (fr == 0) ? (m < 3 ? av[m < 3 ? m + 1 : 3][j] : 0.f) : av[m][j];
            const float tg = (fr == 0) ? (m < 3 ? ag[m < 3 ? m + 1 : 3][j] : 0.f) : ag[m][j];
            nv[j] = row_next(tv); ng[j] = row_next(tg);
          }
          const f32x4 c_v = bv + wv0 * pv + wv1 * av[m] + wv2 * nv, c_g = bg + wg0 * pg + wg1 * ag[m] + wg2 * ng;
          const bool first = (m == 0 && fr == 0), last = (m == 3 && fr == 15);
          if (first) { float* h = HAL + (size_t)(blk * 4) * NUP; *(f32x4*)(h + cv) = av[m]; *(f32x4*)(h + FF + cv) = ag[m]; *(f32x4*)(h + 2 * NUP + cv) = c_v; *(f32x4*)(h + 2 * NUP + FF + cv) = c_g; }
          else if (last) { float* h = HAL + (size_t)(blk * 4) * NUP; *(f32x4*)(h + NUP + cv) = av[m]; *(f32x4*)(h + NUP + FF + cv) = ag[m]; *(f32x4*)(h + 3 * NUP + cv) = c_v; *(f32x4*)(h + 3 * NUP + FF + cv) = c_g; }
          else { u32x2 w; w.x = cvt_pk_bf16(c_g[0] * sigmoidf_(c_g[0]) * c_v[0], c_g[1] * sigmoidf_(c_g[1]) * c_v[1]); w.y = cvt_pk_bf16(c_g[2] * sigmoidf_(c_g[2]) * c_v[2], c_g[3] * sigmoidf_(c_g[3]) * c_v[3]);
            *(u32x2*)(G + (size_t)(R0 + 16 * m + fr) * FF + cv) = w; }
          asm volatile("" ::: "memory");
        }
      }
    }
  }
};
#undef ACC_T
}
namespace at {
using bf16x8 = __attribute__((ext_vector_type(8))) short;
using s16x4 = __attribute__((ext_vector_type(4))) short;
using f32x16 = __attribute__((ext_vector_type(16))) float;
using u32x4 = __attribute__((ext_vector_type(4))) unsigned;
typedef unsigned short bf16_t;
constexpr int D = 128, NW = 8, QBLK = 32, KVBLK = 64, LD = 1024;
constexpr float THR = 11.5f;
constexpr size_t SHM_V = KVBLK * D * 2, SHM_K = KVBLK * D * 2;
constexpr size_t NSLOT = 3, OFF_K = NSLOT * SHM_V, OFF_WS = NSLOT * (SHM_V + SHM_K), OFF_X = 0, ATT_LDS = OFF_WS + NW * 64 * 4;
#define KSWZ(row, colB) ((row) * 256 + ((colB) ^ (((row) & 7) << 4)))
#define SBAR() __builtin_amdgcn_sched_barrier(0)
__device__ __forceinline__ int crow(int r, int hi) { return (r & 3) + 8 * (r >> 2) + 4 * hi; }
typedef float f32x2c_t __attribute__((ext_vector_type(2))); typedef __bf16 bf16x2c_t __attribute__((ext_vector_type(2)));
__device__ __forceinline__ unsigned cvtpk(float lo, float hi) { f32x2c_t v = {lo, hi}; bf16x2c_t b = __builtin_convertvector(v, bf16x2c_t); return __builtin_bit_cast(unsigned, b); }
template <bool FAST> __device__ __forceinline__ void partialSM(f32x16& p0, f32x16& p1, float& m_reg, float& mn, float& alpha) {
  if constexpr (FAST) {
#pragma unroll
    for (int r = 0; r < 16; ++r) p0[r] = __builtin_amdgcn_exp2f(p0[r]);
    alpha = 1.f; mn = 0.f;
  } else {
  float pmax = p0[0];
#pragma unroll
  for (int r = 1; r < 16; ++r) pmax = fmaxf(pmax, p0[r]);
#pragma unroll
  for (int r = 0; r < 16; ++r) pmax = fmaxf(pmax, p1[r]);
  { auto rr = __builtin_amdgcn_permlane32_swap(__float_as_uint(pmax), __float_as_uint(pmax), false, false);
    pmax = fmaxf(__uint_as_float(rr[0]), __uint_as_float(rr[1])); }
  if (__builtin_expect(__all(pmax - m_reg <= THR), 1)) { mn = m_reg; alpha = 1.f; }
  else { mn = fmaxf(m_reg, pmax); alpha = __builtin_amdgcn_exp2f(m_reg - mn); m_reg = mn; }
#pragma unroll
  for (int r = 0; r < 16; ++r) p0[r] = p0[r] - mn;
#pragma unroll
  for (int r = 0; r < 16; ++r) p1[r] = p1[r] - mn;
#pragma unroll
  for (int r = 0; r < 16; ++r) p0[r] = __builtin_amdgcn_exp2f(p0[r]);
  }
}
__device__ __forceinline__ void finishSM(f32x16& p0, f32x16& p1, float alpha, float& l_reg, bf16x8& pa0, bf16x8& pa1, bf16x8& pa2, bf16x8& pa3) {
#pragma unroll
  for (int r = 0; r < 16; ++r) p1[r] = __builtin_amdgcn_exp2f(p1[r]);
  typedef float f32x2_ __attribute__((ext_vector_type(2)));
  f32x2_ s2 = (f32x2_){p0[0], p0[1]} + (f32x2_){p1[0], p1[1]};
#pragma unroll
  for (int r = 2; r < 16; r += 2) { s2 += (f32x2_){p0[r], p0[r + 1]}; s2 += (f32x2_){p1[r], p1[r + 1]}; }
  float ps = s2[0] + s2[1];
  { auto rr = __builtin_amdgcn_permlane32_swap(__float_as_uint(ps), __float_as_uint(ps), false, false);
    ps = __uint_as_float(rr[0]) + __uint_as_float(rr[1]); }
  l_reg = l_reg * alpha + ps;
#define PK4(P, BASE, OUT) do { unsigned a0 = cvtpk(P[BASE + 0], P[BASE + 1]), a1 = cvtpk(P[BASE + 2], P[BASE + 3]);   \
    unsigned b0 = cvtpk(P[BASE + 4], P[BASE + 5]), b1 = cvtpk(P[BASE + 6], P[BASE + 7]);                              \
    auto r0 = __builtin_amdgcn_permlane32_swap(a0, b0, false, false); auto r1 = __builtin_amdgcn_permlane32_swap(a1, b1, false, false); \
    u32x4 w = {r0[0], r1[0], r0[1], r1[1]}; OUT = *reinterpret_cast<bf16x8*>(&w); } while (0)
  PK4(p0, 0, pa0); PK4(p0, 8, pa1); PK4(p1, 0, pa2); PK4(p1, 8, pa3);
#undef PK4
}
__device__ __forceinline__ void qkt(f32x16& p0, f32x16& p1, const char* Ks, const bf16x8* qr, int r32, int hi, int ms) {
  p0 = f32x16{}; p1 = f32x16{};
#pragma unroll
  for (int d0 = 0; d0 < 4; ++d0) { int cb = (ms * 64 + d0 * 16 + hi * 8) * 2;
    bf16x8 b0 = *reinterpret_cast<const bf16x8*>(Ks + KSWZ(r32, cb));
    bf16x8 b1 = *reinterpret_cast<const bf16x8*>(Ks + KSWZ(32 + r32, cb));
    p0 = __builtin_amdgcn_mfma_f32_32x32x16_bf16(b0, qr[d0], p0, 0, 0, 0);
    p1 = __builtin_amdgcn_mfma_f32_32x32x16_bf16(b1, qr[d0], p1, 0, 0, 0); }
}
__device__ __forceinline__ int v_st(int k, int c) { const int kk = (k & ~0xC) | ((k & 4) << 1) | ((k & 8) >> 1); return ((kk >> 3) * 4 + (c >> 5)) * 512 + ((kk & 7) * 32 + (c & 31)) * 2; }
__device__ __forceinline__ int v_rd_base(int lane) { return ((lane & 3) << 3) | (((lane >> 2) & 3) << 6) | (((lane >> 4) & 1) << 5) | (((lane >> 5) & 1) << 8); }
constexpr int v_rd_off(int d0, int ks, int half) { return d0 * 512 + ks * 4096 + half * 2048; }
typedef short v4i16_t __attribute__((ext_vector_type(4)));
typedef const __attribute__((address_space(3))) char* lds_cptr;
template <int OFF> __device__ __forceinline__ s16x4 tr_read(lds_cptr vb) {
  return __builtin_bit_cast(s16x4, __builtin_amdgcn_ds_read_tr16_b64_v4i16((__attribute__((address_space(3))) v4i16_t*)(vb + OFF)));
}
template <int D0> __device__ __forceinline__ void pv_one(f32x16& od, lds_cptr vb, bf16x8 pa0, bf16x8 pa1, bf16x8 pa2, bf16x8 pa3) {
  const s16x4 l0 = tr_read<v_rd_off(D0, 0, 0)>(vb), h0 = tr_read<v_rd_off(D0, 0, 1)>(vb), l1 = tr_read<v_rd_off(D0, 1, 0)>(vb), h1 = tr_read<v_rd_off(D0, 1, 1)>(vb);
  const s16x4 l2 = tr_read<v_rd_off(D0, 2, 0)>(vb), h2 = tr_read<v_rd_off(D0, 2, 1)>(vb), l3 = tr_read<v_rd_off(D0, 3, 0)>(vb), h3 = tr_read<v_rd_off(D0, 3, 1)>(vb);
#define PK(L, H) (bf16x8){L[0], L[1], L[2], L[3], H[0], H[1], H[2], H[3]}
  od = __builtin_amdgcn_mfma_f32_32x32x16_bf16(pa0, PK(l0, h0), od, 0, 0, 0);
  od = __builtin_amdgcn_mfma_f32_32x32x16_bf16(pa1, PK(l1, h1), od, 0, 0, 0);
  od = __builtin_amdgcn_mfma_f32_32x32x16_bf16(pa2, PK(l2, h2), od, 0, 0, 0);
  od = __builtin_amdgcn_mfma_f32_32x32x16_bf16(pa3, PK(l3, h3), od, 0, 0, 0);
#undef PK
}
__device__ __forceinline__ void pv_d0(f32x16* o, lds_cptr vb, bf16x8 pa0, bf16x8 pa1, bf16x8 pa2, bf16x8 pa3) {
  pv_one<0>(o[0], vb, pa0, pa1, pa2, pa3); pv_one<1>(o[1], vb, pa0, pa1, pa2, pa3); pv_one<2>(o[2], vb, pa0, pa1, pa2, pa3); pv_one<3>(o[3], vb, pa0, pa1, pa2, pa3);
}
template <bool FAST> __device__ __forceinline__ bool diff_unit(const bf16_t* __restrict__ Q, const bf16_t* __restrict__ K, const bf16_t* __restrict__ V, bf16_t* __restrict__ AO,
                                          long tq0, long tk0, int seq, int h, float lam, const float* __restrict__ subg, char* lds) {
  int tid_ = threadIdx.x; asm volatile("" : "+v"(tid_)); const int tid = tid_, wid = tid >> 6, lane = tid & 63, r32 = lane & 31, hi = lane >> 5, pr = wid & 3, ms = wid >> 2;
  char* V_lds = lds; char* K_lds = lds + OFF_K;
  float* wsf = (float*)(lds + OFF_WS) + wid * 64; float* li_l = wsf; float* al_l = wsf + 32;
  float* X = (float*)(lds + OFF_X) + pr * (32 * 128);
  float m_reg = -1e30f, l_reg = 0; f32x16 o[4] = {}; bf16x8 qr[4];
  const bf16_t* Qw = Q + (tq0 + pr * QBLK + r32) * LD + (2 * h + ms) * 64 + hi * 8;
#pragma unroll
  for (int d0 = 0; d0 < 4; ++d0) qr[d0] = *reinterpret_cast<const bf16x8*>(Qw + d0 * 16);
  const bf16_t* Kh = K + tk0 * LD + h * 128; const bf16_t* Vh = V + tk0 * LD + h * 128;
  const int sr = tid >> 4, sc = (tid & 15) * 8, vst0 = v_st(sr, sc), vst1 = v_st(32 + sr, sc);
  const lds_cptr vb0 = (lds_cptr)V_lds + v_rd_base(lane);
  struct { bf16x8 vs0, vs1, ks0, ks1; } sr_[2];
#define SLOAD(i, k0) do { sr_[i].vs0 = *(const bf16x8*)(&Vh[(long)((k0) + sr) * LD + sc]); sr_[i].vs1 = *(const bf16x8*)(&Vh[(long)((k0) + 32 + sr) * LD + sc]); \
    sr_[i].ks0 = *(const bf16x8*)(&Kh[(long)((k0) + sr) * LD + sc]); sr_[i].ks1 = *(const bf16x8*)(&Kh[(long)((k0) + 32 + sr) * LD + sc]); } while (0)
#define SWRITE(off, i) do { *(bf16x8*)(V_lds + (off) + vst0) = sr_[i].vs0;          \
    *(bf16x8*)(V_lds + (off) + vst1) = sr_[i].vs1; int kc = sc * 2;               \
    *(bf16x8*)(K_lds + (off) + KSWZ(sr, kc)) = sr_[i].ks0;                       \
    *(bf16x8*)(K_lds + (off) + KSWZ(32 + sr, kc)) = sr_[i].ks1; } while (0)
#define SWAIT() asm volatile("s_waitcnt vmcnt(4)" ::: "memory")
#define RESC(a) do { if (!FAST) if (__any((a) < 1.f)) { if (hi == 0) al_l[r32] = (a); asm volatile("s_waitcnt lgkmcnt(0)" ::: "memory"); \
    _Pragma("unroll") for (int d = 0; d < 4; ++d) _Pragma("unroll") for (int r = 0; r < 16; ++r) o[d][r] *= al_l[crow(r, hi)]; } } while (0)
  f32x16 pA0, pA1, pB0, pB1; float mnA, mnB, alA, alB; bf16x8 pa0, pa1, pa2, pa3; const int NT = seq / KVBLK;
  constexpr int SE = 0, SO = 1;
  int s0 = 0, s1 = (int)SHM_V, s2 = 2 * (int)SHM_V;
  SLOAD(SE, 0); asm volatile("s_waitcnt vmcnt(0)" ::: "memory"); SWRITE(0, SE); __syncthreads();
  qkt(pA0, pA1, K_lds, qr, r32, hi, ms); partialSM<FAST>(pA0, pA1, m_reg, mnA, alA); RESC(alA);
  SLOAD(SO, KVBLK); if (2 < NT) SLOAD(SE, 2 * KVBLK);
  SWAIT(); SWRITE(s1, SO); __syncthreads();
  for (int j = 1; j + 1 < NT; j += 2) {
    SBAR(); qkt(pB0, pB1, K_lds + s1, qr, r32, hi, ms);
    finishSM(pA0, pA1, alA, l_reg, pa0, pa1, pa2, pa3); SBAR();
    SLOAD(SO, (j + 2) * KVBLK); SBAR();
    SWAIT(); SWRITE(s2, SE);
    pv_d0(o, vb0 + s0, pa0, pa1, pa2, pa3); partialSM<FAST>(pB0, pB1, m_reg, mnB, alB); RESC(alB);
    __syncthreads();
    SBAR(); qkt(pA0, pA1, K_lds + s2, qr, r32, hi, ms);
    finishSM(pB0, pB1, alB, l_reg, pa0, pa1, pa2, pa3); SBAR();
    if (j + 3 < NT) SLOAD(SE, (j + 3) * KVBLK); SBAR();
    SWAIT(); SWRITE(s0, SO);
    pv_d0(o, vb0 + s1, pa0, pa1, pa2, pa3); partialSM<FAST>(pA0, pA1, m_reg, mnA, alA); RESC(alA);
    __syncthreads();
    { const int t = s0; s0 = s2; s2 = s1; s1 = t; }
  }
  SBAR(); qkt(pB0, pB1, K_lds + s1, qr, r32, hi, ms);
  finishSM(pA0, pA1, alA, l_reg, pa0, pa1, pa2, pa3); SBAR();
  pv_d0(o, vb0 + s0, pa0, pa1, pa2, pa3); partialSM<FAST>(pB0, pB1, m_reg, mnB, alB); RESC(alB);
  finishSM(pB0, pB1, alB, l_reg, pa0, pa1, pa2, pa3); SBAR();
  pv_d0(o, vb0 + s1, pa0, pa1, pa2, pa3);
  __syncthreads();
  if constexpr (FAST) { const int bad = !(l_reg > 1e-30f && l_reg < 1e30f); if (__syncthreads_or(bad)) return true; }
  if (hi == 0) li_l[r32] = l_reg; asm volatile("s_waitcnt lgkmcnt(0)" ::: "memory");
  float rli[16];
#pragma unroll
  for (int r = 0; r < 16; ++r) rli[r] = __builtin_amdgcn_rcpf(li_l[crow(r, hi)]);
  if (ms == 1) {
#pragma unroll
    for (int r = 0; r < 16; ++r)
#pragma unroll
      for (int d0 = 0; d0 < 4; ++d0) X[crow(r, hi) * 128 + d0 * 32 + r32] = o[d0][r] * rli[r];
  }
  __syncthreads();
  if (ms == 0) {
    float sg[4];
#pragma unroll
    for (int d0 = 0; d0 < 4; ++d0) sg[d0] = subg[d0 * 32 + r32] * 0.8f;
#pragma unroll
    for (int r = 0; r < 16; ++r) {
      float v[4]; float sq = 0.f;
#pragma unroll
      for (int d0 = 0; d0 < 4; ++d0) { v[d0] = o[d0][r] * rli[r] - lam * X[crow(r, hi) * 128 + d0 * 32 + r32]; sq += v[d0] * v[d0]; }
      sq += __shfl_xor(sq, 1); sq += __shfl_xor(sq, 2); sq += __shfl_xor(sq, 4); sq += __shfl_xor(sq, 8); sq += __shfl_xor(sq, 16);
      const float rs = 1.0f / sqrtf(sq * (1.0f / 128.0f) + 1e-6f);
      bf16_t* orow = AO + (tq0 + pr * QBLK + crow(r, hi)) * LD + h * 128 + r32;
#pragma unroll
      for (int d0 = 0; d0 < 4; ++d0) orow[d0 * 32] = (bf16_t)(cvtpk(v[d0] * rs * sg[d0], 0.f) & 0xffffu);
    }
  }
  __syncthreads();
  return false;
#undef SLOAD
#undef SWRITE
#undef SWAIT
#undef RESC
}
#undef KSWZ
#undef SBAR
}
namespace fk {
#define LAS3 __attribute__((address_space(3)))
constexpr int NWAVES = 8, NTHR = 512;
constexpr int LDS_BYTES = 147456;
constexpr int NPH = 22;

__device__ __forceinline__ int otid() { int t = threadIdx.x; asm volatile("" : "+v"(t)); return t; }
__device__ __forceinline__ float wave_sum(float v) {
#pragma unroll
  for (int o = 1; o < 64; o <<= 1) v += __shfl_xor(v, o);
  return v;
}
__device__ __forceinline__ unsigned f2bf(float f) { unsigned u = __builtin_bit_cast(unsigned, f); return (u + 0x7fffu + ((u >> 16) & 1u)) >> 16; }
__device__ __forceinline__ unsigned pk2(float lo, float hi) { return f2bf(lo) | (f2bf(hi) << 16); }

__device__ __forceinline__ int srcblk(int mode, int n0) {
  if (mode == 1) { const int pn = n0 >> 8; if (pn >= 8) return n0; const int bj = (n0 >> 7) & 1, wc = (n0 >> 5) & 3; return pn * 256 + wc * 64 + bj * 32; }
  if (mode == 2) { const int pn = n0 >> 8, bj = (n0 >> 7) & 1, i = n0 & 127; return bj * FF + pn * 128 + i; }
  return n0;
}
__device__ __forceinline__ void transpose_item(const float* __restrict__ W, int K, int N, const float* __restrict__ gk, int mode, bf16_t* __restrict__ WT, float* scr, int item, int lane) {
  const int nblk = N / 32, kb = item / nblk, nb = item % nblk, k0 = 64 * kb, n0 = 32 * nb, s0 = srcblk(mode, n0);
#pragma unroll 8
  for (int i = 0; i < 32; ++i) { const int kk = 2 * i + (lane >> 5); float w = __builtin_nontemporal_load(W + (size_t)(k0 + kk) * N + s0 + (lane & 31)); if (gk) w *= gk[k0 + kk]; scr[kk * 33 + (lane & 31)] = w; }
  asm volatile("s_waitcnt lgkmcnt(0)" ::: "memory");
  const int c = lane & 7;
#pragma unroll
  for (int j = 0; j < 4; ++j) { const int n = (lane >> 3) + 8 * j; const float* s = scr + (8 * c) * 33 + n;
    u32x4 o; o.x = pk2(s[0 * 33], s[1 * 33]); o.y = pk2(s[2 * 33], s[3 * 33]); o.z = pk2(s[4 * 33], s[5 * 33]); o.w = pk2(s[6 * 33], s[7 * 33]);
    *(u32x4*)(WT + (size_t)(n0 + n) * K + k0 + 8 * c) = o; }
  asm volatile("s_waitcnt lgkmcnt(0)" ::: "memory");
}
__device__ __forceinline__ void row_to_bf16_ss(const float* xrow, bf16_t* orow, float* ssp, int lane) {
  const f32x4* xr = (const f32x4*)xrow + lane; f32x4 v[4]; float s = 0.f;
#pragma unroll
  for (int j = 0; j < 4; ++j) { v[j] = __builtin_nontemporal_load(xr + 64 * j); s += (v[j][0] * v[j][0] + v[j][1] * v[j][1]) + (v[j][2] * v[j][2] + v[j][3] * v[j][3]); }
  s = wave_sum(s);
  unsigned long long* o8 = (unsigned long long*)orow + lane;
#pragma unroll
  for (int j = 0; j < 4; ++j) o8[64 * j] = (unsigned long long)pk2(v[j][0], v[j][1]) | ((unsigned long long)pk2(v[j][2], v[j][3]) << 32);
  if (lane == 0) *ssp = s;
}
struct WJob { const float* W; int K, N; const float* gk; int mode; size_t dst; };

__device__ __forceinline__ void prep_phase(const Params& P, char* lds, int vcu, int G) {
  const int tid = otid(), lane = tid & 63, wave = tid >> 6;
  float* scr = (float*)(lds + wave * 16384);
  const int gw = vcu * NWAVES + wave, NGW = G * NWAVES; unsigned char* ws = P.ws;
#define TITEM(Wp, K_, N_, gk_, mode_, dst_, r_) transpose_item(Wp, K_, N_, gk_, mode_, (bf16_t*)(ws + (dst_)), scr, r_, lane)
  for (int it = gw; it < 13312; it += NGW) {
    int r = it;
    if (r < 1536) { TITEM(P.in[5], 1024, 3072, P.in[4], 1, WS_WQKV, r); continue; } r -= 1536;
    if (r < 512) { TITEM(P.in[11], 1024, 1024, nullptr, 0, WS_WO, r); continue; } r -= 512;
    if (r < 1024) { TITEM(P.in[12], 1024, 2048, P.in[4] + 1024, 0, WS_WUV, r); continue; } r -= 1024;
    if (r < 512) { TITEM(P.in[17], 1024, 1024, nullptr, 0, WS_WOUT, r); continue; } r -= 512;
    const int L = r >= 4864 ? 1 : 0; r -= L * 4864;
    if (r < 2816) { TITEM(P.in[19] + (size_t)L * 1024 * NUP, 1024, NUP, P.in[18] + L * 1024, 2, WS_WUP + (size_t)L * 11 * MiB, r); continue; } r -= 2816;
    if (r < 1408) { TITEM(P.in[22] + (size_t)L * FF * 1024, FF, 1024, nullptr, 0, WS_WDN + (size_t)L * (11 * MiB / 2), r); continue; } r -= 1408;
    if (r < 512) { TITEM(P.in[24] + (size_t)L * 1024 * 1024, 1024, 1024, P.in[23] + L * 1024, 0, WS_WG + (size_t)L * 2 * MiB, r); continue; } r -= 512;
    TITEM(P.in[25] + (size_t)L * 256 * 1024, 256, 1024, nullptr, 0, WS_WP + (size_t)L * (MiB / 2), r);
  }
#undef TITEM
  for (int m = gw; m < NTOK; m += NGW) { const float* xr = m < HALF_TOK ? P.xin_a + (size_t)m * DM : P.xin_b + (size_t)(m - HALF_TOK) * DM;
    row_to_bf16_ss(xr, (bf16_t*)(ws + WS_XB) + (size_t)m * DM, (float*)(ws + WS_SS) + m, lane); }
  const size_t gt = (size_t)vcu * NTHR + tid, GT = (size_t)G * NTHR;
  for (size_t i = gt; i < (size_t)2 * NTOK * 256 / 8; i += GT) { const size_t e = i * 8; const int L = (int)(e / ((size_t)NTOK * 256)); const size_t r = e % ((size_t)NTOK * 256);
    const float* src = r < (size_t)HALF_TOK * 256 ? P.in[2] + (size_t)L * HALF_TOK * 256 + r : P.in[3] + (size_t)L * HALF_TOK * 256 + (r - (size_t)HALF_TOK * 256);
    const f32x4 a = __builtin_nontemporal_load((const f32x4*)src), b = __builtin_nontemporal_load((const f32x4*)(src + 4)); *(u32x4*)((bf16_t*)(ws + WS_PB) + e) = pack8(a, b); }
  for (size_t i = gt; i < (size_t)16384 * 32; i += GT) { const int d = (int)(i & 31), pos = (int)(i >> 5);
    const float inv = 1.0f / powf(10000.0f, (float)(2 * d) / 64.0f); const float ang = (float)pos * inv;
    const double tw = 6.283185307179586476925; double r = (double)ang; r -= tw * rint(r / tw); const float rf = (float)r;
    ((float*)(ws + WS_COS))[i] = cosf(rf); ((float*)(ws + WS_SIN))[i] = sinf(rf); }
  for (size_t i = gt; i < (size_t)8 * 128 * 128 / 8; i += GT) { const float* src = P.in[15] + i * 8; *(u32x4*)((bf16_t*)(ws + WS_WSP) + i * 8) = pack8(*(const f32x4*)src, *(const f32x4*)(src + 4)); }
  for (size_t i = gt; i < (size_t)6 * NTOK; i += GT) ((float*)(ws + WS_SS))[NTOK + i] = 0.f;
  for (size_t i = gt; i < (size_t)2 * NTOK; i += GT) ((float*)(ws + WS_LNS))[i] = 0.f;
  if (vcu == 0 && tid == 0) { float d1 = 0.f, d2 = 0.f; for (int i = 0; i < 64; ++i) { d1 += P.in[6][i] * P.in[7][i]; d2 += P.in[8][i] * P.in[9][i]; }
    *(float*)(ws + WS_LAM) = expf(d1) - expf(d2) + 0.2f; }
}

__device__ __forceinline__ void sgu_phase(const Params& P, char* lds, int vcu, int G) {
  const int tid = otid(), lane = tid & 63, w = tid >> 6; unsigned char* ws = P.ws;
  bf16_t* vT = (bf16_t*)lds; bf16_t* Wsm = (bf16_t*)(lds + 34816);
  bf16_t* U = (bf16_t*)(ws + WS_R1); const bf16_t* Vs = (const bf16_t*)(ws + WS_XB); const float* lns = (const float*)(ws + WS_LNS);
  const int c8 = (tid & 15) * 8, q0 = tid >> 4; const int i16 = lane & 15, kg = lane >> 4; const int p = 16 * w + i16;
  int gcur = -1; f32x4 g0, g1, b0, b1; float bias = 0.f;
  u32x4 nv[4]; float ns1[4], ns2[4];
#define SGU_PREF(ui_) do { const int ch_ = (ui_) >> 3, g_ = (ui_) & 7; _Pragma("unroll") for (int i = 0; i < 4; ++i) { const int row_ = ch_ * 128 + q0 + 32 * i; \
      nv[i] = *(const u32x4*)(Vs + (size_t)row_ * DM + g_ * 128 + c8); ns1[i] = lns[row_]; ns2[i] = lns[NTOK + row_]; } } while (0)
  int ui = vcu; if (ui < 4096) SGU_PREF(ui);
#pragma unroll 1
  for (; ui < 4096; ui += G) {
    const int chunk = ui >> 3, g = ui & 7;
    u32x4 cv[4]; float cs1[4], cs2[4];
#pragma unroll
    for (int i = 0; i < 4; ++i) { cv[i] = nv[i]; cs1[i] = ns1[i]; cs2[i] = ns2[i]; }
    if (g != gcur) {
      __syncthreads();
#pragma unroll
      for (int i = 0; i < 4; ++i) { const int pp_ = q0 + 32 * i; *(u32x4*)(Wsm + pp_ * 136 + c8) = *(const u32x4*)((const bf16_t*)(ws + WS_WSP) + (size_t)(g * 128 + pp_) * 128 + c8); }
      const float* lng = P.in[13] + g * 128 + c8; const float* lnb = P.in[14] + g * 128 + c8;
      g0 = *(const f32x4*)lng; g1 = *(const f32x4*)(lng + 4); b0 = *(const f32x4*)lnb; b1 = *(const f32x4*)(lnb + 4); bias = P.in[16][g * 128 + p]; gcur = g;
    }
    if (ui + G < 4096) SGU_PREF(ui + G);
    const size_t token = (size_t)chunk * 128 + p; u32x2 uu[8];
#pragma unroll
    for (int cb = 0; cb < 8; ++cb) uu[cb] = *(const u32x2*)(U + token * DM + g * 128 + 16 * cb + 4 * kg);
#pragma unroll
    for (int i = 0; i < 4; ++i) { const int q = q0 + 32 * i; f32x4 x0, x1; unpack8(cv[i], x0, x1);
      const float mean = cs1[i] * (1.0f / 1024.0f); const float var = cs2[i] * (1.0f / 1024.0f) - mean * mean; const float rs = 1.0f / sqrtf(fmaxf(var, 0.f) + EPS);
      x0 = (x0 - mean) * rs * g0 + b0; x1 = (x1 - mean) * rs * g1 + b1;
#pragma unroll
      for (int e = 0; e < 4; ++e) { vT[(c8 + e) * 136 + q] = (bf16_t)f2bf(x0[e]); vT[(c8 + 4 + e) * 136 + q] = (bf16_t)f2bf(x1[e]); } }
    __syncthreads();
    f32x4 acc[8];
#pragma unroll
    for (int cb = 0; cb < 8; ++cb) acc[cb] = (f32x4){0.f, 0.f, 0.f, 0.f};
#pragma unroll
    for (int ks = 0; ks < 4; ++ks) { const bf16x8 bfrag = *(const bf16x8*)(Wsm + (16 * w + i16) * 136 + ks * 32 + kg * 8);
#pragma unroll
      for (int cb = 0; cb < 8; ++cb) { const bf16x8 afrag = *(const bf16x8*)(vT + (16 * cb + i16) * 136 + ks * 32 + kg * 8);
        acc[cb] = __builtin_amdgcn_mfma_f32_16x16x32_bf16(afrag, bfrag, acc[cb], 0, 0, 0); } }
#pragma unroll
    for (int cb = 0; cb < 8; ++cb) { bf16_t* up = U + token * DM + g * 128 + 16 * cb + 4 * kg;
      const float u0 = __uint_as_float(uu[cb].x << 16), u1 = __uint_as_float(uu[cb].x & 0xffff0000u), u2 = __uint_as_float(uu[cb].y << 16), u3 = __uint_as_float(uu[cb].y & 0xffff0000u);
      u32x2 o; o.x = cvt_pk_bf16(u0 * (acc[cb][0] + bias), u1 * (acc[cb][1] + bias)); o.y = cvt_pk_bf16(u2 * (acc[cb][2] + bias), u3 * (acc[cb][3] + bias)); *(u32x2*)up = o; }
    __syncthreads();
  }
#undef SGU_PREF
}

__device__ __forceinline__ void fixup_phase(const Params& P, int L, int half, int vcu, int G) {
  unsigned char* ws = P.ws; const float* HAL = (const float*)(ws + WS_HALO); bf16_t* Gb = (bf16_t*)(ws + WS_G);
  const float* cw = P.in[20] + (size_t)L * 3 * NUP; const int S = half == 0 ? 16384 : 2048;
  const size_t gt = (size_t)vcu * NTHR + otid(), GT = (size_t)G * NTHR;
  for (size_t i = gt; i < (size_t)512 * 2 * (FF / 4); i += GT) { const int f = (int)(i % (FF / 4)) * 4; const int rb = (int)(i / (FF / 4)); const int blk = rb >> 1, which = rb & 1;
    const int row = blk * 64 + (which ? 63 : 0); const int pos = row % S;
    const float* h = HAL + (size_t)(blk * 4) * NUP;
    f32x4 cv = *(const f32x4*)(h + (2 + which) * NUP + f), cg = *(const f32x4*)(h + (2 + which) * NUP + FF + f);
    if (which == 0) { if (pos != 0) { const float* hp = HAL + (size_t)((blk - 1) * 4 + 1) * NUP; cv += *(const f32x4*)(cw + f) * *(const f32x4*)(hp + f); cg += *(const f32x4*)(cw + FF + f) * *(const f32x4*)(hp + FF + f); } }
    else { if (pos != S - 1) { const float* hn = HAL + (size_t)((blk + 1) * 4 + 0) * NUP; cv += *(const f32x4*)(cw + 2 * NUP + f) * *(const f32x4*)(hn + f); cg += *(const f32x4*)(cw + 2 * NUP + FF + f) * *(const f32x4*)(hn + FF + f); } }
    u32x2 w; w.x = cvt_pk_bf16(cg[0] * sigmoidf_(cg[0]) * cv[0], cg[1] * sigmoidf_(cg[1]) * cv[1]); w.y = cvt_pk_bf16(cg[2] * sigmoidf_(cg[2]) * cv[2], cg[3] * sigmoidf_(cg[3]) * cv[3]);
    *(u32x2*)(Gb + (size_t)row * FF + f) = w; }
}

__device__ __forceinline__ void final_phase(const Params& P, int vcu, int G) {
  const int t_ = otid(); const int lane = t_ & 63, wave = t_ >> 6; const int gw = vcu * NWAVES + wave, NGW = G * NWAVES;
  const float* ss = (const float*)(P.ws + WS_SS) + (size_t)6 * NTOK; const bf16_t* X = (const bf16_t*)(P.ws + WS_R2);
  const f32x4* g4 = (const f32x4*)P.in[26]; const f32x4 ga0 = g4[lane * 2], ga1 = g4[lane * 2 + 1], gb0 = g4[(lane + 64) * 2], gb1 = g4[(lane + 64) * 2 + 1];
  for (int m0 = gw * 4; m0 < NTOK; m0 += NGW * 4) {
    u32x4 xa[4], xb_[4]; float sv[4];
#pragma unroll
    for (int r = 0; r < 4; ++r) { const u32x4* xr = (const u32x4*)(X + (size_t)(m0 + r) * DM) + lane; xa[r] = xr[0]; xb_[r] = xr[64]; sv[r] = ss[m0 + r]; }
#pragma unroll
    for (int r = 0; r < 4; ++r) { const float rs = rstd_of(sv[r]); f32x4* yr = (f32x4*)(P.out + (size_t)(m0 + r) * DM); f32x4 a, b;
      unpack8(xa[r], a, b); yr[lane * 2] = a * rs * ga0; yr[lane * 2 + 1] = b * rs * ga1;
      unpack8(xb_[r], a, b); yr[(lane + 64) * 2] = a * rs * gb0; yr[(lane + 64) * 2 + 1] = b * rs * gb1; } }
}

__global__ void __launch_bounds__(NTHR, 2) mega(Params P) {
  extern __shared__ __attribute__((aligned(16))) unsigned char lds_raw[];
  cg::grid_group grid = cg::this_grid();
  LAS3 unsigned char* lds3 = (LAS3 unsigned char*)lds_raw; char* lds = (char*)lds_raw;
  const int G = gridDim.x, bx = blockIdx.x; const int vcu = (G % 8 == 0) ? (bx % 8) * (G / 8) + bx / 8 : bx;
  unsigned char* ws = P.ws; const int lo = P.ph_lo, hi = P.ph_hi;
  volatile LAS3 unsigned* MISC = (volatile LAS3 unsigned*)(lds3 + 139264);
  if (threadIdx.x < 4) MISC[threadIdx.x] = 0u;
  __syncthreads();
  if (blockIdx.x == 0) for (int i = threadIdx.x; i < XCD_BAR_WORDS; i += NTHR) ((unsigned*)(ws + WS_BAR))[i] = 0u;
  xb::XcdBarrier bar; bar.bar = (unsigned*)(ws + WS_BAR); bar.x = 0; bar.st = MISC;
  float* SS = (float*)(ws + WS_SS);
  bf16_t* XB = (bf16_t*)(ws + WS_XB); bf16_t* R1 = (bf16_t*)(ws + WS_R1); bf16_t* R2 = (bf16_t*)(ws + WS_R2);
#ifndef ENMASK
#define ENMASK 0xffffffffu
#endif
#define IN(k) (lo <= (k) && (k) < hi)
#define EN(b) (((ENMASK) >> (b)) & 1u)
#ifdef PROBE_TA
#ifndef PROBE_DIV
#define PROBE_DIV 2000.0f
#endif
  unsigned long long tp0 = (PROBE_TA == 0) ? __builtin_amdgcn_s_memrealtime() : 0ull, tp1 = 0;
#define STAMP0(k) do { if ((k) == PROBE_TA) tp0 = __builtin_amdgcn_s_memrealtime(); } while (0)
#define STAMP1(k) do { if ((k) == PROBE_TB) tp1 = __builtin_amdgcn_s_memrealtime(); } while (0)
#else
#define STAMP0(k) do {} while (0)
#define STAMP1(k) do {} while (0)
#endif
#define SEAM(k) do { if (IN(k) && IN((k) + 1)) { if ((k) == 0) { grid.sync(); bar = xb::xcd_barrier_post((unsigned*)(ws + WS_BAR), MISC); } else xb::xcd_barrier(bar); } else __syncthreads(); STAMP1(k); STAMP0((k) + 1); } while (0)
#define GEMM(EpiT, E, Aptr, Bptr, M_, N_, K_) do { pg8::Gemm g_{(const bf16_t*)(Aptr), (const bf16_t*)(Bptr), M_, N_, K_}; pg8::StaticOrder S_; S_.init(M_, N_, G, bx); \
    pg8::gemm_phase<EpiT, pg8::StaticOrder, true, true>(lds3, g_, S_, E); } while (0)

  if (EN(0) && IN(0)) { prep_phase(P, lds, vcu, G); }
  SEAM(0);
  if (EN(1) && IN(1)) { EpiQKV E{R1, (bf16_t*)P.out, SS, (const float*)(ws + WS_COS), (const float*)(ws + WS_SIN)};
    GEMM(EpiQKV, E, XB, ws + WS_WQKV, NTOK, 3072, 1024); }
  SEAM(1);
  if (EN(2) && IN(2)) { const float lam = *(const float*)(ws + WS_LAM); const float* subg = P.in[10];
    const bf16_t* Q = R1; const bf16_t* K = (const bf16_t*)P.out; const bf16_t* V = K + (size_t)NTOK * DM; bf16_t* AO = R2;
    const int nu = (G == 256) ? 16 : (4096 + G - 1) / G;
#define ATT_UNIT_ARGS(i) \
      int ui; if (G == 256) { const int x = vcu >> 5, j = vcu & 31; ui = ((i) < 8) ? ((2 * x + ((i) >> 2)) * 128 + j + 32 * ((i) & 3)) : (2048 + (16 * x) * 16 + ((i) - 8) * 32 + j); } \
      else { ui = bx + (i) * G; if (ui >= 4096) break; } \
      long tq0, tk0; int seq, h; \
      if (ui < 2048) { const int ph = ui >> 7, qb = ui & 127; tk0 = (long)(ph >> 3) * 16384; tq0 = tk0 + qb * 128; seq = 16384; h = ph & 7; } \
      else { const int v = ui - 2048, pair = v >> 4, qb = v & 15; tk0 = (long)HALF_TOK + (long)(pair >> 3) * 2048; tq0 = tk0 + qb * 128; seq = 2048; h = pair & 7; }
    unsigned long long badmask = 0ull;
#ifdef PROBE_FORCE_SAFE
    badmask = ~0ull;
#endif
#pragma unroll 1
    for (int i = 0; i < nu && i < 64; ++i) { ATT_UNIT_ARGS(i)
      if (at::diff_unit<true>(Q, K, V, AO, tq0, tk0, seq, h, lam, subg, lds)) badmask |= 1ull << i; }
#pragma unroll 1
    for (int i = 0; i < nu && i < 64; ++i) { if (!((badmask >> i) & 1ull)) continue; ATT_UNIT_ARGS(i)
      (void)at::diff_unit<false>(Q, K, V, AO, tq0, tk0, seq, h, lam, subg, lds); }
#undef ATT_UNIT_ARGS
  }
  SEAM(2);
  if (EN(3) && IN(3)) { EpiRes<0> E{P.xin_a, P.xin_b, nullptr, XB, SS + 1 * NTOK, nullptr, nullptr, 0}; GEMM(EpiRes<0>, E, R2, ws + WS_WO, NTOK, 1024, 1024); }
  SEAM(3);
#pragma unroll 1
  for (int L = 0; L < 2; ++L) {
    const int pb = 4 + 10 * L;
    if (L == 1) {
      if (EN(11) && IN(11)) { EpiUV E{R1, XB, SS + 3 * NTOK, (float*)(ws + WS_LNS)}; GEMM(EpiUV, E, R2, ws + WS_WUV, NTOK, 2048, 1024); }
      SEAM(11);
      if (EN(12) && IN(12)) sgu_phase(P, lds, vcu, G);
      SEAM(12);
      if (EN(13) && IN(13)) { EpiRes<1> E{nullptr, nullptr, R2, XB, SS + 4 * NTOK, nullptr, nullptr, 0}; GEMM(EpiRes<1>, E, R1, ws + WS_WOUT, NTOK, 1024, 1024); }
      SEAM(13);
    }
#pragma unroll 1
    for (int half = 0; half < 2; ++half) {
      const int p0 = pb + 3 * half; const int rowoff = half * HALF_TOK;
      if (EN(4) && IN(p0)) { EpiUp E{(bf16_t*)(ws + WS_G), (float*)(ws + WS_HALO), SS + (size_t)(1 + 3 * L) * NTOK, P.in[20] + (size_t)L * 3 * NUP, P.in[21] + (size_t)L * NUP, rowoff};
        GEMM(EpiUp, E, XB + (size_t)rowoff * DM, ws + WS_WUP + (size_t)L * 11 * MiB, HALF_TOK, NUP, 1024); }
      SEAM(p0);
      if (EN(5) && IN(p0 + 1)) fixup_phase(P, L, half, vcu, G);
      SEAM(p0 + 1);
      if (EN(6) && IN(p0 + 2)) { EpiRes<1> E{nullptr, nullptr, XB, XB, SS + (size_t)(2 + 3 * L) * NTOK, nullptr, nullptr, rowoff};
        GEMM(EpiRes<1>, E, ws + WS_G, ws + WS_WDN + (size_t)L * (11 * MiB / 2), HALF_TOK, 1024, FF); }
      SEAM(p0 + 2);
    }
    const int pp = pb + 6;
    if (EN(10) && IN(pp)) {
      { EpiStore E{R1}; GEMM(EpiStore, E, (bf16_t*)(ws + WS_PB) + (size_t)L * NTOK * 256, ws + WS_WP + (size_t)L * (MiB / 2), NTOK, 1024, 256); }
      __syncthreads();
      { EpiRes<2> E{nullptr, nullptr, XB, R2, SS + (size_t)(3 + 3 * L) * NTOK, SS + (size_t)(2 + 3 * L) * NTOK, R1, 0};
        GEMM(EpiRes<2>, E, XB, ws + WS_WG + (size_t)L * 2 * MiB, NTOK, 1024, 1024); }
    }
    SEAM(pp);
  }
  if (EN(21) && IN(21)) final_phase(P, vcu, G);
#ifdef PROBE_TA
#ifndef PROBE_DIV
#define PROBE_DIV 2000.0f
#endif
  __syncthreads();
#ifdef PROBE_END
  asm volatile("s_waitcnt vmcnt(0)" ::: "memory"); tp1 = __builtin_amdgcn_s_memrealtime();
#endif
  if (bx == 0 && threadIdx.x == 0) { asm volatile("s_waitcnt vmcnt(0)" ::: "memory"); P.out[0] += (float)(tp1 - tp0) * (1.0f / PROBE_DIV); }
#endif
#undef IN
#undef SEAM
#undef EN
#undef GEMM
}
}
#ifndef MODE
#define MODE 0
#endif
#ifndef FASTMASK
#define FASTMASK 0x7f
#endif
namespace fk {
__global__ void __launch_bounds__(256) k_resync(const float* __restrict__ x, bf16_t* __restrict__ xb, float* __restrict__ ss) {
  const int lane = threadIdx.x & 63; const int gw = blockIdx.x * 4 + (threadIdx.x >> 6), NGW = gridDim.x * 4;
  for (int m = gw; m < NTOK; m += NGW) row_to_bf16_ss(x + (size_t)m * DM, xb + (size_t)m * DM, ss + m, lane);
}
}
extern "C" void kernel_launch(void* const* d_in, const int* in_sizes, int n_in, void* d_out, int out_size, void* d_ws, size_t ws_size, hipStream_t stream) {
  static int grid = 0;
  if (grid == 0) {
    if (n_in != 27 || out_size != fk::NTOK * fk::DM || ws_size < (size_t)512 * fk::MiB) { fprintf(stderr, "kernel_launch: unexpected shapes n_in %d out %d ws %zu\n", n_in, out_size, ws_size); grid = -1; return; }
    int dev = 0, cus = 0, per_cu = 0; hipGetDevice(&dev); hipDeviceGetAttribute(&cus, hipDeviceAttributeMultiprocessorCount, dev);
    if (hipFuncSetAttribute((const void*)fk::mega, hipFuncAttributeMaxDynamicSharedMemorySize, fk::LDS_BYTES) != hipSuccess) { fprintf(stderr, "kernel_launch: hipFuncSetAttribute failed\n"); grid = -1; return; }
    if (hipOccupancyMaxActiveBlocksPerMultiprocessor(&per_cu, (const void*)fk::mega, fk::NTHR, fk::LDS_BYTES) != hipSuccess || per_cu < 1) { fprintf(stderr, "kernel_launch: occupancy query says %d\n", per_cu); per_cu = 1; }
    (void)hipGetLastError();
    grid = cus * per_cu; if (grid > 256) grid = 256;
    fprintf(stderr, "kernel_launch: grid %d (cus %d per_cu %d) ws %zu\n", grid, cus, per_cu, ws_size);
  }
  if (grid < 0) return;
  fk::Params p{};
  for (int i = 0; i < 27; ++i) p.in[i] = (const float*)d_in[i];
  p.xin_a = (const float*)d_in[0]; p.xin_b = (const float*)d_in[1]; p.out = (float*)d_out; p.ws = (unsigned char*)d_ws;
#if MODE == 0
  p.ph_lo = 0; p.ph_hi = fk::NPH; void* args[] = {&p};
  hipError_t e = hipLaunchCooperativeKernel((const void*)fk::mega, dim3(grid), dim3(fk::NTHR), args, fk::LDS_BYTES, stream);
  if (e != hipSuccess) fprintf(stderr, "cooperative launch failed: %s (grid %d)\n", hipGetErrorString(e), grid);
#else
  auto runph = [&](int a, int b) { for (int k = a; k <= b; ++k) { p.ph_lo = k; p.ph_hi = k + 1; hipLaunchKernelGGL(fk::mega, dim3(grid), dim3(fk::NTHR), fk::LDS_BYTES, stream, p); } };
  char* nws = (char*)d_ws + 128 * fk::MiB; float* out = (float*)d_out; unsigned char* ws = (unsigned char*)d_ws;
  hipMemsetAsync((char*)d_ws + fk::WS_BAR, 0, 16384, stream);
  runph(0, 0);
  const int first[7] = {1, 4, 10, 11, 14, 20, 21}, last[7] = {3, 9, 10, 13, 19, 20, 21};
  if (!(FASTMASK & 1)) { hipMemcpyAsync(out, d_in[0], (size_t)fk::HALF_TOK * 1024 * 4, hipMemcpyDeviceToDevice, stream); hipMemcpyAsync(out + (size_t)fk::HALF_TOK * 1024, d_in[1], (size_t)fk::HALF_TOK * 1024 * 4, hipMemcpyDeviceToDevice, stream); }
  for (int s = 0; s < 7; ++s) {
    if (FASTMASK & (1 << s)) {
      if (s > 0) fk::k_resync<<<1024, 256, 0, stream>>>(out, (fk::bf16_t*)(ws + (s == 3 ? fk::WS_R2 : fk::WS_XB)), (float*)(ws + fk::WS_SS) + (size_t)s * fk::NTOK);
      runph(first[s], last[s]);
    } else nv::stage(s, d_in, out, nws, stream);
  }
#endif
}
```

```cpp
#include <hip/hip_runtime.h>
#include <hip/hip_cooperative_groups.h>
#include <cstdio>
#include <cstdint>
namespace cg = cooperative_groups;
#define MODE 0
#define FASTMASK 0x7f
namespace pg8 {
#define PG8_LAS __attribute__((address_space(3)))
typedef unsigned short bf16_t;
typedef short bf16x8 __attribute__((ext_vector_type(8)));
typedef float f32x4 __attribute__((ext_vector_type(4)));
typedef unsigned u32x4 __attribute__((ext_vector_type(4)));
constexpr int BM = 256, BK = 64, HALF = 128, HTB = HALF * BK * 2  , STAGE_BYTES = 8 * HTB, NXCD = 8, WGM = 8;

__host__ __device__ __forceinline__ int lds_byte(int r, int c) { const int st = (r >> 4) * 2 + (c >> 5), rr = r & 15, cc = c & 31, ob = rr * 64 + cc * 2; return st * 1024 + (ob ^ (((ob >> 9) & 1) << 5)); }
__host__ __device__ __forceinline__ void stage_rc(int b, int& R, int& C) { const int st = b / 1024, sb = b % 1024, swz = sb ^ (((sb >> 9) & 1) << 5); R = (st >> 1) * 16 + swz / 64; C = (st & 1) * 32 + (swz % 64) / 2; }
__host__ __device__ __forceinline__ int perm32(int rho) { const int n = rho >> 4, i = rho & 15; return 8 * (i >> 2) + 4 * n + (i & 3); }

struct Unit { int pm, pn; };
struct Gemm { const bf16_t* A; const bf16_t* Bt; int M, N, K; };

struct StaticOrder {
    int nM, nN, nwg, G, c;
    __host__ __device__ __forceinline__ void init(int M, int N, int G_, int c_) { nM = M / BM; nN = N / BM; nwg = nM * nN; G = G_; c = c_; }
    __host__ __device__ __forceinline__ bool next(int i, Unit& u) const {
        const long L = (long)i * G + c; if (L >= nwg) return false;
        int wgid = (int)L; { const int q = nwg / NXCD, r = nwg % NXCD, xcd = wgid % NXCD, off = wgid / NXCD; wgid = (xcd < r ? xcd * (q + 1) : r * (q + 1) + (xcd - r) * q) + off; }
        const int nig = WGM * nN, gid = wgid / nig, fm = gid * WGM, gsz = (nM - fm) < WGM ? (nM - fm) : WGM;
        u.pm = fm + ((wgid % nig) % gsz); u.pn = (wgid % nig) / gsz; return true;
    }
    __device__ __forceinline__ void a_ready(const Unit&) const {}
    __device__ __forceinline__ void done(const Unit&) const {}
};

typedef float f32x2cv_t __attribute__((ext_vector_type(2))); typedef __bf16 bf16x2cv_t __attribute__((ext_vector_type(2)));
__device__ __forceinline__ unsigned cvt_pk_bf16(float lo, float hi) { f32x2cv_t v = {lo, hi}; bf16x2cv_t b = __builtin_convertvector(v, bf16x2cv_t); return __builtin_bit_cast(unsigned, b); }
typedef float f32x2 __attribute__((ext_vector_type(2)));
__device__ __forceinline__ f32x2 gelu_pk(f32x2 v) {
    const f32x2 av = __builtin_elementwise_abs(v), d = av * 0.2316418882f + 1.0f;
    f32x2 t; t.x = __builtin_amdgcn_rcpf(d.x); t.y = __builtin_amdgcn_rcpf(d.y);
    f32x2 q = t * 0.5307027145f + (-0.7265760135f); q = q * t + 0.7107068705f; q = q * t + (-0.142248368f); q = q * t + 0.127414796f; q = q * t;
    const f32x2 s = (v * v) * (-0.72134752044f);
    f32x2 e; e.x = __builtin_amdgcn_exp2f(s.x); e.y = __builtin_amdgcn_exp2f(s.y);
    const f32x2 m = v * (q * e), r = v - m;
    f32x2 o; o.x = v.x < 0.f ? m.x : r.x; o.y = v.y < 0.f ? m.y : r.y; return o;
}

template <class Epi, class Sched, bool ALIGN_EPI = false, bool SP2 = false>
__device__ __forceinline__ void gemm_phase(PG8_LAS unsigned char* lds, const Gemm g, const Sched& S, const Epi& E) {
    int tid_ = threadIdx.x; asm volatile("" : "+v"(tid_));
    const int tid = tid_, wid = __builtin_amdgcn_readfirstlane(tid >> 6), lane = tid & 63, wr = wid >> 2, wc = wid & 3, fr = lane & 15, fq = lane >> 4;
    const int K = g.K, nt = K / BK;
    unsigned voffA[2], voffB[2];
#pragma unroll
    for (int i = 0; i < 2; ++i) { int R, C; stage_rc(tid * 16 + i * 8192, R, C); const int Rb = Epi::PERM ? ((R & ~31) + perm32(R & 31)) : R;
        voffA[i] = (unsigned)(R * K + C) * 2u; voffB[i] = (unsigned)(Rb * K + C) * 2u; }
    const size_t kstep = (size_t)(BK * 2);
    const size_t hstep = (size_t)HALF * K * 2;
    const size_t tstep = 2 * hstep;
    const unsigned ldsw = (unsigned)wid * 1024u;
    const int aoff = lds_byte(wr * 64 + fr, fq * 8), boff = lds_byte(wc * 32 + fr, fq * 8);
#define PG8_SA(b, h) (((b) * 2 + (h)) * HTB)
#define PG8_SB(b, h) ((4 + (b) * 2 + (h)) * HTB)
#define PG8_STAGE(bufoff, gbase, voff) do { _Pragma("unroll") for (int _i = 0; _i < 2; ++_i) \
        __builtin_amdgcn_global_load_lds((const unsigned*)((const char*)(gbase) + (voff)[_i]), (PG8_LAS unsigned*)(lds + (bufoff) + ldsw + _i * 8192), 16, 0, 0); } while (0)
#define PG8_LDA(dst, b, h) do { _Pragma("unroll") for (int m = 0; m < 4; ++m) _Pragma("unroll") for (int k = 0; k < 2; ++k) dst[m][k] = *(const PG8_LAS bf16x8*)(lds + PG8_SA(b, h) + aoff + m * 2048 + k * 1024); } while (0)
#define PG8_LDB(dst, b, h) do { _Pragma("unroll") for (int n = 0; n < 2; ++n) _Pragma("unroll") for (int k = 0; k < 2; ++k) dst[n][k] = *(const PG8_LAS bf16x8*)(lds + PG8_SB(b, h) + boff + n * 2048 + k * 1024); } while (0)
#define PG8_MMA(ai, bj, At, Bt) do { __builtin_amdgcn_s_setprio(1); _Pragma("unroll") for (int m = 0; m < 4; ++m) _Pragma("unroll") for (int n = 0; n < 2; ++n) _Pragma("unroll") for (int k = 0; k < 2; ++k) \
        acc[ai][bj][m][n] = __builtin_amdgcn_mfma_f32_16x16x32_bf16(Bt[n][k], At[m][k], acc[ai][bj][m][n], 0, 0, 0); __builtin_amdgcn_s_setprio(0); } while (0)
#define PG8_WAIT_V(n) asm volatile("s_waitcnt vmcnt(" #n ")" ::: "memory")
#define PG8_WAIT_L(n) asm volatile("s_waitcnt lgkmcnt(" #n ")" ::: "memory")
#define PG8_BAR __builtin_amdgcn_s_barrier()
#define PG8_SCHED __builtin_amdgcn_sched_barrier(0)
    Unit cur, nxt; int ui = 0;
    if (!S.next(0, cur)) return;
    f32x4 acc[2][2][4][2];
#pragma unroll
    for (int a = 0; a < 2; ++a)
#pragma unroll
        for (int b = 0; b < 2; ++b)
#pragma unroll
            for (int m = 0; m < 4; ++m)
#pragma unroll
                for (int n = 0; n < 2; ++n) acc[a][b][m][n] = (f32x4){0.f, 0.f, 0.f, 0.f};
    bf16x8 At[4][2], B0[2][2], B1[2][2];
    const char* cA = (const char*)g.A + (size_t)cur.pm * tstep; const char* cB = (const char*)g.Bt + (size_t)cur.pn * tstep;
    S.a_ready(cur);
    if constexpr (SP2) {
        PG8_STAGE(PG8_SB(0, 0), cB, voffB); PG8_STAGE(PG8_SB(0, 1), cB + hstep, voffB); PG8_STAGE(PG8_SA(0, 0), cA, voffA); PG8_STAGE(PG8_SA(0, 1), cA + hstep, voffA);
        if (wr == 1) PG8_BAR;
        PG8_WAIT_V(2); PG8_BAR;
        PG8_STAGE(PG8_SB(1, 0), cB + kstep, voffB); PG8_STAGE(PG8_SA(1, 0), cA + kstep, voffA); PG8_STAGE(PG8_SB(1, 1), cB + hstep + kstep, voffB);
        PG8_WAIT_V(6); PG8_BAR;
    } else {
        PG8_STAGE(PG8_SB(0, 0), cB, voffB); PG8_STAGE(PG8_SA(0, 0), cA, voffA); PG8_STAGE(PG8_SB(0, 1), cB + hstep, voffB); PG8_STAGE(PG8_SA(0, 1), cA + hstep, voffA);
        if (wr == 1) PG8_BAR;
        PG8_WAIT_V(4); PG8_BAR;
        PG8_STAGE(PG8_SB(1, 0), cB + kstep, voffB); PG8_STAGE(PG8_SA(1, 0), cA + kstep, voffA); PG8_STAGE(PG8_SB(1, 1), cB + hstep + kstep, voffB);
        PG8_WAIT_V(6); PG8_BAR;
    }
    for (;;) {
        const bool has_next = S.next(ui + 1, nxt);
        const char* nA = has_next ? (const char*)g.A + (size_t)nxt.pm * tstep : cA; const char* nB = has_next ? (const char*)g.Bt + (size_t)nxt.pn * tstep : cB;
#pragma unroll 1
        for (int t = 0; t < nt; t += 2) {
            const bool last = (t == nt - 2);
            const char* a1 = cA + (size_t)(t + 1) * kstep;
            const char* a2 = last ? nA : cA + (size_t)(t + 2) * kstep; const char* b2 = last ? nB : cB + (size_t)(t + 2) * kstep;
            const char* a3 = a2 + kstep; const char* b3 = b2 + kstep;
            if (last && has_next) S.a_ready(nxt);
            if constexpr (SP2) {
            PG8_LDB(B0, 0, 0); PG8_LDB(B1, 0, 1); PG8_SCHED; PG8_LDA(At, 0, 0); PG8_STAGE(PG8_SA(1, 1), a1 + hstep, voffA);
            PG8_WAIT_V(8); PG8_WAIT_L(0); PG8_BAR; PG8_MMA(0, 0, At, B0); PG8_MMA(0, 1, At, B1); PG8_BAR; PG8_SCHED;
            PG8_LDA(At, 0, 1); PG8_STAGE(PG8_SB(0, 0), b2, voffB); PG8_STAGE(PG8_SB(0, 1), b2 + hstep, voffB); PG8_STAGE(PG8_SA(0, 0), a2, voffA);
            PG8_WAIT_V(8); PG8_WAIT_L(0); PG8_BAR; PG8_MMA(1, 0, At, B0); PG8_MMA(1, 1, At, B1); PG8_BAR; PG8_SCHED;
            PG8_LDB(B0, 1, 0); PG8_LDB(B1, 1, 1); PG8_SCHED; PG8_LDA(At, 1, 0); PG8_STAGE(PG8_SA(0, 1), a2 + hstep, voffA);
            PG8_WAIT_V(8); PG8_WAIT_L(0); PG8_BAR; PG8_MMA(0, 0, At, B0); PG8_MMA(0, 1, At, B1); PG8_BAR; PG8_SCHED;
            PG8_LDA(At, 1, 1); PG8_STAGE(PG8_SB(1, 0), b3, voffB); PG8_STAGE(PG8_SB(1, 1), b3 + hstep, voffB); PG8_STAGE(PG8_SA(1, 0), a3, voffA);
            PG8_WAIT_V(8); PG8_WAIT_L(0); PG8_BAR; PG8_MMA(1, 0, At, B0); PG8_MMA(1, 1, At, B1); PG8_BAR; PG8_SCHED;
            } else {
            PG8_LDB(B0, 0, 0); PG8_SCHED; PG8_LDA(At, 0, 0); PG8_STAGE(PG8_SA(1, 1), a1 + hstep, voffA);
            PG8_WAIT_L(8); PG8_BAR; PG8_WAIT_L(0); PG8_MMA(0, 0, At, B0); PG8_BAR; PG8_SCHED;
            PG8_LDB(B1, 0, 1); PG8_STAGE(PG8_SB(0, 0), b2, voffB);
            PG8_BAR; PG8_WAIT_L(0); PG8_MMA(0, 1, At, B1); PG8_BAR;
            PG8_LDA(At, 0, 1); PG8_STAGE(PG8_SA(0, 0), a2, voffA);
            PG8_BAR; PG8_WAIT_L(0); PG8_MMA(1, 0, At, B0); PG8_BAR; PG8_SCHED;
            PG8_STAGE(PG8_SB(0, 1), b2 + hstep, voffB);
            PG8_WAIT_V(6); PG8_BAR; PG8_MMA(1, 1, At, B1); PG8_BAR;
            PG8_LDB(B0, 1, 0); PG8_SCHED; PG8_LDA(At, 1, 0); PG8_STAGE(PG8_SA(0, 1), a2 + hstep, voffA);
            PG8_WAIT_L(8); PG8_BAR; PG8_WAIT_L(0); PG8_MMA(0, 0, At, B0); PG8_BAR; PG8_SCHED;
            PG8_LDB(B1, 1, 1); PG8_STAGE(PG8_SB(1, 0), b3, voffB);
            PG8_BAR; PG8_WAIT_L(0); PG8_MMA(0, 1, At, B1); PG8_BAR;
            PG8_LDA(At, 1, 1); PG8_STAGE(PG8_SA(1, 0), a3, voffA);
            PG8_BAR; PG8_WAIT_L(0); PG8_MMA(1, 0, At, B0); PG8_BAR; PG8_SCHED;
            PG8_STAGE(PG8_SB(1, 1), b3 + hstep, voffB);
            PG8_WAIT_V(6); PG8_BAR; PG8_MMA(1, 1, At, B1); PG8_BAR;
            }
        }
        if constexpr (ALIGN_EPI) { if (wr == 0) PG8_BAR; }
        if constexpr (!Epi::AFTER_DRAIN) { E(acc, cur, wr, wc, fr, fq); S.done(cur); }
        if (!has_next) break;
#pragma unroll
        for (int a = 0; a < 2; ++a)
#pragma unroll
            for (int b = 0; b < 2; ++b)
#pragma unroll
                for (int m = 0; m < 4; ++m)
#pragma unroll
                    for (int n = 0; n < 2; ++n) acc[a][b][m][n] = (f32x4){0.f, 0.f, 0.f, 0.f};
        cur = nxt; cA = nA; cB = nB; ++ui;
        if constexpr (ALIGN_EPI) { if (wr == 1) PG8_BAR; }
    }
    PG8_WAIT_V(0);
    if constexpr (!ALIGN_EPI) { if (wr == 0) PG8_BAR; }
    PG8_BAR;
    if constexpr (Epi::AFTER_DRAIN) { E.fused(acc, cur, wr, wc, fr, fq, lds, wid, lane); S.done(cur); }
#undef PG8_SA
#undef PG8_SB
#undef PG8_STAGE
#undef PG8_LDA
#undef PG8_LDB
#undef PG8_MMA
#undef PG8_WAIT_V
#undef PG8_WAIT_L
#undef PG8_BAR
#undef PG8_SCHED
}
}
namespace xb {
#define LAS __attribute__((address_space(3)))
#define XB_TMO      128
#define XB_XCNT(j)  (256  + 64 * (j))
#define XB_XSUB(j)  (1280 + 64 * (j))
#define XB_XGEN(j)  (2304 + 64 * (j))
#define XB_TOP      3328
#define XB_TOPGEN   3392
#define XCD_BAR_WORDS 3456
#define XB_SPIN_CAP (1u << 18)

__device__ __forceinline__ unsigned xb_ld(unsigned* p)              { return __hip_atomic_load(p, __ATOMIC_RELAXED, __HIP_MEMORY_SCOPE_AGENT); }
__device__ __forceinline__ unsigned xb_add(unsigned* p, unsigned v) { return __hip_atomic_fetch_add(p, v, __ATOMIC_RELAXED, __HIP_MEMORY_SCOPE_AGENT); }
__device__ __forceinline__ unsigned xb_xcc_id() { return (unsigned)__builtin_amdgcn_s_getreg((3 << 11) | 20) & 0xFu; }
#define XB_SPIN(cond, bar) do { unsigned _sp = 0; while (cond) { __builtin_amdgcn_s_sleep(1); \
    if ((++_sp & 255u) == 0u) { if (xb_ld(&(bar)[XB_TMO])) break; if (_sp > XB_SPIN_CAP) { atomicAdd(&(bar)[XB_TMO], 1u); break; } } } } while (0)

struct XcdBarrier {
    unsigned* bar; unsigned x;
    volatile LAS unsigned* st;
};

__device__ __forceinline__ XcdBarrier xcd_barrier_post(unsigned* bar, volatile LAS unsigned* st) {
    XcdBarrier b; b.bar = bar; b.x = xb_xcc_id(); b.st = st;
    if (threadIdx.x == 0) (void)xb_add(&bar[XB_XCNT(b.x)], 1u);
    return b;
}
__device__ __forceinline__ void xcd_barrier_complete(unsigned* bar, unsigned x, unsigned& nloc, unsigned& nx) {
    const unsigned G = gridDim.x * gridDim.y * gridDim.z;
    unsigned sum, cnt, mine, sp = 0u;
    for (;;) {
        sum = 0u; cnt = 0u; mine = 0u;
#pragma unroll
        for (unsigned j = 0; j < 16; ++j) { const unsigned c = xb_ld(&bar[XB_XCNT(j)]); sum += c; cnt += (c > 0u) ? 1u : 0u; mine = (j == x) ? c : mine; }
        if (sum == G) break;
        __builtin_amdgcn_s_sleep(1);
        if ((++sp & 255u) == 0u) { if (xb_ld(&bar[XB_TMO])) break; if (sp > XB_SPIN_CAP) { atomicAdd(&bar[XB_TMO], 1u); break; } }
    }
    nloc = mine > 0u ? mine : 1u; nx = cnt > 0u ? cnt : 1u;
}

__device__ __forceinline__ void xcd_barrier(const XcdBarrier& b) {
    asm volatile("s_waitcnt vmcnt(0)" ::: "memory");
    __syncthreads();
    if (threadIdx.x == 0) {
        unsigned* bar = b.bar;
        __builtin_amdgcn_s_waitcnt(0);
        unsigned nloc = b.st[0], nx = b.st[1];
        if (nloc == 0u) { xcd_barrier_complete(bar, b.x, nloc, nx); b.st[0] = nloc; b.st[1] = nx; }
        const unsigned old = xb_add(&bar[XB_XSUB(b.x)], 1u);
        const unsigned gen = old / nloc;
        if (old + 1u == (gen + 1u) * nloc) {
            __builtin_amdgcn_fence(__ATOMIC_RELEASE, "agent");
            asm volatile("s_waitcnt vmcnt(0)" ::: "memory");
            const unsigned og = xb_add(&bar[XB_TOP], 1u);
            const unsigned tg = og / nx;
            if (og + 1u == (tg + 1u) * nx) xb_add(&bar[XB_TOPGEN], 1u);
            else XB_SPIN(xb_ld(&bar[XB_TOPGEN]) == tg, bar);
            __builtin_amdgcn_fence(__ATOMIC_ACQUIRE, "agent");
            xb_add(&bar[XB_XGEN(b.x)], 1u);
            asm volatile("s_waitcnt vmcnt(0)" ::: "memory");
        } else {
            XB_SPIN(xb_ld(&bar[XB_XGEN(b.x)]) == gen, bar);
            __builtin_amdgcn_fence(__ATOMIC_ACQUIRE, "agent");
            asm volatile("s_waitcnt vmcnt(0)" ::: "memory");
        }
    }
    __syncthreads();
}
#undef LAS
}
namespace fk {
using pg8::bf16_t; using pg8::bf16x8; using pg8::f32x4; using pg8::u32x4; using pg8::Unit; using pg8::cvt_pk_bf16; using pg8::f32x2;
typedef unsigned u32x2 __attribute__((ext_vector_type(2)));
constexpr int NTOK = 65536, DM = 1024, FF = 2816, NUP = 5632, HALF_TOK = 32768;
constexpr size_t MiB = (size_t)1 << 20;
constexpr size_t WS_LAM = 0, WS_BAR = 4096, WS_SS = 1 * MiB, WS_LNS = 3 * MiB, WS_COS = 4 * MiB, WS_SIN = 6 * MiB, WS_WSP = 8 * MiB;
constexpr size_t WS_WQKV = 10 * MiB, WS_WO = 16 * MiB, WS_WUV = 18 * MiB, WS_WOUT = 22 * MiB, WS_WUP = 24 * MiB, WS_WDN = 46 * MiB, WS_WG = 57 * MiB, WS_WP = 61 * MiB;
constexpr size_t WS_PB = 64 * MiB, WS_XB = 128 * MiB, WS_R1 = 256 * MiB, WS_R2 = 384 * MiB, WS_G = 256 * MiB, WS_HALO = 432 * MiB;
constexpr float EPS = 1e-6f;

struct Params {
  const float* in[27];
  const float* xin_a; const float* xin_b;
  float* out; unsigned char* ws;
  int ph_lo, ph_hi;
};

__device__ __forceinline__ float rstd_of(float ss) { return 1.0f / sqrtf(ss * (1.0f / 1024.0f) + EPS); }
__device__ __forceinline__ float bf2f(unsigned short b) { return __uint_as_float((unsigned)b << 16); }
__device__ __forceinline__ float sigmoidf_(float x) { return __builtin_amdgcn_rcpf(1.0f + __builtin_amdgcn_exp2f(-1.4426950408889634f * x)); }
__device__ __forceinline__ u32x4 pack8(const f32x4 a, const f32x4 b) { u32x4 w; w.x = cvt_pk_bf16(a[0], a[1]); w.y = cvt_pk_bf16(a[2], a[3]); w.z = cvt_pk_bf16(b[0], b[1]); w.w = cvt_pk_bf16(b[2], b[3]); return w; }
__device__ __forceinline__ void unpack8(const u32x4 w, f32x4& a, f32x4& b) {
  a[0] = __uint_as_float(w.x << 16); a[1] = __uint_as_float(w.x & 0xffff0000u); a[2] = __uint_as_float(w.y << 16); a[3] = __uint_as_float(w.y & 0xffff0000u);
  b[0] = __uint_as_float(w.z << 16); b[1] = __uint_as_float(w.z & 0xffff0000u); b[2] = __uint_as_float(w.w << 16); b[3] = __uint_as_float(w.w & 0xffff0000u); }

__device__ __forceinline__ float sum_fq(float v) {
  auto a = __builtin_amdgcn_permlane16_swap(__float_as_uint(v), __float_as_uint(v), false, false); v = __uint_as_float(a[0]) + __uint_as_float(a[1]);
  auto b = __builtin_amdgcn_permlane32_swap(__float_as_uint(v), __float_as_uint(v), false, false); return __uint_as_float(b[0]) + __uint_as_float(b[1]); }
__device__ __forceinline__ float row_prev(float v) { return __int_as_float(__builtin_amdgcn_update_dpp(0, __float_as_int(v), 0x121, 0xf, 0xf, false)); }
__device__ __forceinline__ float row_next(float v) { return __int_as_float(__builtin_amdgcn_update_dpp(0, __float_as_int(v), 0x12f, 0xf, 0xf, false)); }
#define ACC_T const f32x4 (&acc)[2][2][4][2]
__device__ __forceinline__ int opaque_lane() { int l; asm volatile("v_mbcnt_lo_u32_b32 %0, -1, 0\n\tv_mbcnt_hi_u32_b32 %0, -1, %0" : "=v"(l)); return l; }
#define OPAQUE_LANE() const int ol_ = opaque_lane(); const int fr = ol_ & 15, fq = ol_ >> 4;

struct EpiQKV {
  static constexpr bool PERM = true, AFTER_DRAIN = false;
  bf16_t *Q, *KV; const float* ss; const float* cs; const float* sn;
  __device__ __forceinline__ void operator()(ACC_T, const Unit& u, int wr, int wc, int fr_, int fq_) const { OPAQUE_LANE()
    const int sect = u.pn >> 2; bf16_t* base = KV + (size_t)(sect > 0 ? sect - 1 : 0) * NTOK * DM; if (sect == 0) base = Q;
    const int rowb = u.pm * 256 + wr * 64 + fr; const float qs = (sect == 0 ? 0.18033688011112042f : 1.0f);
    if (sect < 2) {
      f32x4 ct[4], nt[4]; float crs, nrs;
#define QK_LOAD(T, RS, idx) do { const int row_ = rowb + ((idx) >> 2) * 128 + ((idx) & 3) * 16; const int pos_ = row_ < HALF_TOK ? (row_ & 16383) : (row_ & 2047); \
        RS = ss[row_]; T[0] = *(const f32x4*)(cs + pos_ * 32 + 8 * fq); T[1] = *(const f32x4*)(cs + pos_ * 32 + 8 * fq + 4); \
        T[2] = *(const f32x4*)(sn + pos_ * 32 + 8 * fq); T[3] = *(const f32x4*)(sn + pos_ * 32 + 8 * fq + 4); } while (0)
      QK_LOAD(ct, crs, 0);
      const int col = ((u.pn & 3) * 4 + wc) * 64 + 8 * fq;
#pragma unroll
      for (int idx = 0; idx < 8; ++idx) { const int ai = idx >> 2, m = idx & 3; const int row = rowb + ai * 128 + m * 16;
        if (idx < 7) QK_LOAD(nt, nrs, idx + 1);
        const float rs = rstd_of(crs) * qs; bf16_t* rowp = base + (size_t)row * DM;
        u32x4 w1, w2;
        { const f32x4 x1 = acc[ai][0][m][0] * rs, x2 = acc[ai][1][m][0] * rs; const f32x4 o1 = x1 * ct[0] - x2 * ct[2], o2 = x2 * ct[0] + x1 * ct[2];
          w1.x = cvt_pk_bf16(o1[0], o1[1]); w1.y = cvt_pk_bf16(o1[2], o1[3]); w2.x = cvt_pk_bf16(o2[0], o2[1]); w2.y = cvt_pk_bf16(o2[2], o2[3]); }
        { const f32x4 x1 = acc[ai][0][m][1] * rs, x2 = acc[ai][1][m][1] * rs; const f32x4 o1 = x1 * ct[1] - x2 * ct[3], o2 = x2 * ct[1] + x1 * ct[3];
          w1.z = cvt_pk_bf16(o1[0], o1[1]); w1.w = cvt_pk_bf16(o1[2], o1[3]); w2.z = cvt_pk_bf16(o2[0], o2[1]); w2.w = cvt_pk_bf16(o2[2], o2[3]); }
        *(u32x4*)(rowp + col) = w1; *(u32x4*)(rowp + col + 32) = w2;
        asm volatile("" ::: "memory");
#pragma unroll
        for (int t = 0; t < 4; ++t) ct[t] = nt[t];
        crs = nrs; }
#undef QK_LOAD
    } else {
      float rsv[8];
#pragma unroll
      for (int idx = 0; idx < 8; ++idx) rsv[idx] = ss[rowb + (idx >> 2) * 128 + (idx & 3) * 16];
#pragma unroll
      for (int idx = 0; idx < 8; ++idx) { const int ai = idx >> 2, m = idx & 3; const int row = rowb + ai * 128 + m * 16; const float rs = rstd_of(rsv[idx]); bf16_t* rowp = base + (size_t)row * DM;
#pragma unroll
        for (int bj = 0; bj < 2; ++bj) { const int col = (u.pn & 3) * 256 + bj * 128 + wc * 32 + 8 * fq;
          *(u32x4*)(rowp + col) = pack8(acc[ai][bj][m][0] * rs, acc[ai][bj][m][1] * rs); }
        asm volatile("" ::: "memory"); }
    }
  }
};

template <int KIND> struct EpiRes {
  static constexpr bool PERM = true, AFTER_DRAIN = false;
  const float* xa; const float* xb_src; const bf16_t* xsrc; bf16_t* xbo; float* ssn; const float* ss; const bf16_t* pp; int rowoff;
  __device__ __forceinline__ void operator()(ACC_T, const Unit& u, int wr, int wc, int fr_, int fq_) const { OPAQUE_LANE()
    const int colb = u.pn * 256 + wc * 32 + 8 * fq; const int rowb = rowoff + u.pm * 256 + wr * 64 + fr;
    f32x4 cx[4], nx[4]; u32x4 cb[2], nb[2], cp[2], np[2]; float crs = 1.f, nrs = 1.f;
#define RES_LOAD(X, XB_, PPV, RS, idx) do { const int row_ = rowb + ((idx) >> 2) * 128 + ((idx) & 3) * 16; \
      if (KIND == 0) { const float* xr_ = (row_ < HALF_TOK ? xa + (size_t)row_ * DM : xb_src + (size_t)(row_ - HALF_TOK) * DM); \
        X[0] = __builtin_nontemporal_load((const f32x4*)(xr_ + colb)); X[1] = __builtin_nontemporal_load((const f32x4*)(xr_ + colb + 4)); X[2] = __builtin_nontemporal_load((const f32x4*)(xr_ + colb + 128)); X[3] = __builtin_nontemporal_load((const f32x4*)(xr_ + colb + 132)); } \
      else { XB_[0] = *(const u32x4*)(xsrc + (size_t)row_ * DM + colb); XB_[1] = *(const u32x4*)(xsrc + (size_t)row_ * DM + colb + 128); } \
      if (KIND == 2) { PPV[0] = *(const u32x4*)(pp + (size_t)row_ * DM + colb); PPV[1] = *(const u32x4*)(pp + (size_t)row_ * DM + colb + 128); RS = rstd_of(ss[row_]); } } while (0)
    RES_LOAD(cx, cb, cp, crs, 0);
#pragma unroll
    for (int idx = 0; idx < 8; ++idx) {
      const int ai = idx >> 2, m = idx & 3; const int row = rowb + ai * 128 + m * 16;
      if (idx < 7) RES_LOAD(nx, nb, np, nrs, idx + 1);
      float sq = 0.f;
#pragma unroll
      for (int bj = 0; bj < 2; ++bj) { const int col = colb + bj * 128;
        f32x4 d0 = acc[ai][bj][m][0], d1 = acc[ai][bj][m][1];
        if (KIND == 2) { f32x4 p0, p1; unpack8(cp[bj], p0, p1);
#pragma unroll
          for (int j = 0; j < 4; ++j) { d0[j] = sigmoidf_(d0[j] * crs) * p0[j]; d1[j] = sigmoidf_(d1[j] * crs) * p1[j]; } }
        f32x4 a0, a1; if (KIND == 0) { a0 = cx[2 * bj]; a1 = cx[2 * bj + 1]; } else unpack8(cb[bj], a0, a1);
        const f32x4 v0 = a0 + d0, v1 = a1 + d1;
        *(u32x4*)(xbo + (size_t)row * DM + col) = pack8(v0, v1);
        sq += (v0[0] * v0[0] + v0[1] * v0[1]) + (v0[2] * v0[2] + v0[3] * v0[3]) + (v1[0] * v1[0] + v1[1] * v1[1]) + (v1[2] * v1[2] + v1[3] * v1[3]); }
      sq = sum_fq(sq);
      if (fq == 0) atomicAdd(ssn + row, sq);
      asm volatile("" ::: "memory");
      if (KIND == 0) {
#pragma unroll
        for (int t = 0; t < 4; ++t) cx[t] = nx[t]; }
      else { cb[0] = nb[0]; cb[1] = nb[1]; }
      if (KIND == 2) { cp[0] = np[0]; cp[1] = np[1]; crs = nrs; }
    }
#undef RES_LOAD
  }
};

struct EpiStore {
  static constexpr bool PERM = true, AFTER_DRAIN = false;
  bf16_t* O;
  __device__ __forceinline__ void operator()(ACC_T, const Unit& u, int wr, int wc, int fr_, int fq_) const { OPAQUE_LANE()
#pragma unroll
    for (int ai = 0; ai < 2; ++ai)
#pragma unroll
      for (int m = 0; m < 4; ++m) { const int row = u.pm * 256 + ai * 128 + wr * 64 + m * 16 + fr;
#pragma unroll
        for (int bj = 0; bj < 2; ++bj) { const int col = u.pn * 256 + bj * 128 + wc * 32 + 8 * fq;
          *(u32x4*)(O + (size_t)row * DM + col) = pack8(acc[ai][bj][m][0], acc[ai][bj][m][1]); } asm volatile("" ::: "memory"); }
  }
};

struct EpiUV {
  static constexpr bool PERM = true, AFTER_DRAIN = false;
  bf16_t *U, *Vs; const float* ss; float* lns;
  __device__ __forceinline__ void operator()(ACC_T, const Unit& u, int wr, int wc, int fr_, int fq_) const { OPAQUE_LANE()
    const bool isv = u.pn >= 4; bf16_t* base = isv ? Vs : U;
    float rsv[8];
#pragma unroll
    for (int idx = 0; idx < 8; ++idx) rsv[idx] = ss[u.pm * 256 + (idx >> 2) * 128 + wr * 64 + (idx & 3) * 16 + fr];
#pragma unroll
    for (int ai = 0; ai < 2; ++ai)
#pragma unroll
      for (int m = 0; m < 4; ++m) { const int row = u.pm * 256 + ai * 128 + wr * 64 + m * 16 + fr; const float rs = rstd_of(rsv[ai * 4 + m]);
        float s1 = 0.f, s2 = 0.f;
#pragma unroll
        for (int bj = 0; bj < 2; ++bj) { const int col = (u.pn & 3) * 256 + bj * 128 + wc * 32 + 8 * fq;
          const f32x4 v0 = acc[ai][bj][m][0] * rs, v1 = acc[ai][bj][m][1] * rs;
          const f32x2 a = pg8::gelu_pk((f32x2){v0[0], v0[1]}), b = pg8::gelu_pk((f32x2){v0[2], v0[3]}), c = pg8::gelu_pk((f32x2){v1[0], v1[1]}), d = pg8::gelu_pk((f32x2){v1[2], v1[3]});
          s1 += (a.x + a.y) + (b.x + b.y) + (c.x + c.y) + (d.x + d.y);
          s2 += (a.x * a.x + a.y * a.y) + (b.x * b.x + b.y * b.y) + (c.x * c.x + c.y * c.y) + (d.x * d.x + d.y * d.y);
          u32x4 w; w.x = cvt_pk_bf16(a.x, a.y); w.y = cvt_pk_bf16(b.x, b.y); w.z = cvt_pk_bf16(c.x, c.y); w.w = cvt_pk_bf16(d.x, d.y);
          *(u32x4*)(base + (size_t)row * DM + col) = w; asm volatile("" ::: "memory"); }
        if (isv) { s1 = sum_fq(s1); s2 = sum_fq(s2);
          if (fq == 0) { atomicAdd(lns + row, s1); atomicAdd(lns + NTOK + row, s2); } }
        asm volatile("" ::: "memory");
      }
  }
};

struct EpiUp {
  static constexpr bool PERM = true, AFTER_DRAIN = false;
  bf16_t* G; bf16_t* HAL; const float* ss; const float* cw; const float* cb; int rowoff;
  __device__ __forceinline__ void operator()(ACC_T, const Unit& u, int wr, int wc, int fr_, int fq_) const { OPAQUE_LANE()
    float rs[2][4];
#pragma unroll
    for (int ai = 0; ai < 2; ++ai)
#pragma unroll
      for (int m = 0; m < 4; ++m) rs[ai][m] = ss[rowoff + u.pm * 256 + ai * 128 + wr * 64 + 16 * m + fr];
#pragma unroll
    for (int n = 0; n < 2; ++n) {
      const int cv = u.pn * 128 + wc * 32 + 8 * fq + 4 * n;
      const f32x4 wv0 = *(const f32x4*)(cw + cv), wv1 = *(const f32x4*)(cw + NUP + cv), wv2 = *(const f32x4*)(cw + 2 * NUP + cv), bv = *(const f32x4*)(cb + cv);
      const f32x4 wg0 = *(const f32x4*)(cw + FF + cv), wg1 = *(const f32x4*)(cw + NUP + FF + cv), wg2 = *(const f32x4*)(cw + 2 * NUP + FF + cv), bg = *(const f32x4*)(cb + FF + cv);
#pragma unroll
      for (int ai = 0; ai < 2; ++ai) {
        const int R0 = u.pm * 256 + ai * 128 + wr * 64; const int blk = R0 >> 6;
        f32x4 av[4], ag[4];
#pragma unroll
        for (int m = 0; m < 4; ++m) { const float r_ = rstd_of(rs[ai][m]); av[m] = acc[ai][0][m][n] * r_; ag[m] = acc[ai][1][m][n] * r_; }
#pragma unroll
        for (int m = 0; m < 4; ++m) {
          f32x4 pv, pg, nv, ng;
#pragma unroll
          for (int j = 0; j < 4; ++j) {
            const float sv = (fr == 15) ? (m > 0 ? av[m > 0 ? m - 1 : 0][j] : 0.f) : av[m][j];
            const float sg = (fr == 15) ? (m > 0 ? ag[m > 0 ? m - 1 : 0][j] : 0.f) : ag[m][j];
            pv[j] = row_prev(sv); pg[j] = row_prev(sg);
            const float tv = (fr == 0) ? (m < 3 ? av[m < 3 ? m + 1 : 3][j] : 0.f) : av[m][j];
            const float tg = (fr == 0) ? (m < 3 ? ag[m < 3 ? m + 1 : 3][j] : 0.f) : ag[m][j];
            nv[j] = row_next(tv); ng[j] = row_next(tg);
          }
          const f32x4 c_v = bv + wv0 * pv + wv1 * av[m] + wv2 * nv, c_g = bg + wg0 * pg + wg1 * ag[m] + wg2 * ng;
          const bool first = (m == 0 && fr == 0), last = (m == 3 && fr == 15);
          if (first) { bf16_t* h = HAL + (size_t)(blk * 4) * NUP; *(u32x2*)(h + cv) = (u32x2){cvt_pk_bf16(av[m][0], av[m][1]), cvt_pk_bf16(av[m][2], av[m][3])}; *(u32x2*)(h + FF + cv) = (u32x2){cvt_pk_bf16(ag[m][0], ag[m][1]), cvt_pk_bf16(ag[m][2], ag[m][3])}; *(u32x2*)(h + 2 * NUP + cv) = (u32x2){cvt_pk_bf16(c_v[0], c_v[1]), cvt_pk_bf16(c_v[2], c_v[3])}; *(u32x2*)(h + 2 * NUP + FF + cv) = (u32x2){cvt_pk_bf16(c_g[0], c_g[1]), cvt_pk_bf16(c_g[2], c_g[3])}; }
          else if (last) { bf16_t* h = HAL + (size_t)(blk * 4) * NUP; *(u32x2*)(h + NUP + cv) = (u32x2){cvt_pk_bf16(av[m][0], av[m][1]), cvt_pk_bf16(av[m][2], av[m][3])}; *(u32x2*)(h + NUP + FF + cv) = (u32x2){cvt_pk_bf16(ag[m][0], ag[m][1]), cvt_pk_bf16(ag[m][2], ag[m][3])}; *(u32x2*)(h + 3 * NUP + cv) = (u32x2){cvt_pk_bf16(c_v[0], c_v[1]), cvt_pk_bf16(c_v[2], c_v[3])}; *(u32x2*)(h + 3 * NUP + FF + cv) = (u32x2){cvt_pk_bf16(c_g[0], c_g[1]), cvt_pk_bf16(c_g[2], c_g[3])}; }
          else { u32x2 w; w.x = cvt_pk_bf16(c_g[0] * sigmoidf_(c_g[0]) * c_v[0], c_g[1] * sigmoidf_(c_g[1]) * c_v[1]); w.y = cvt_pk_bf16(c_g[2] * sigmoidf_(c_g[2]) * c_v[2], c_g[3] * sigmoidf_(c_g[3]) * c_v[3]);
            *(u32x2*)(G + (size_t)(R0 + 16 * m + fr) * FF + cv) = w; }
          asm volatile("" ::: "memory");
        }
      }
    }
  }
};
#undef ACC_T
}
namespace at {
using bf16x8 = __attribute__((ext_vector_type(8))) short;
using s16x4 = __attribute__((ext_vector_type(4))) short;
using f32x16 = __attribute__((ext_vector_type(16))) float;
using u32x4 = __attribute__((ext_vector_type(4))) unsigned;
typedef unsigned short bf16_t;
constexpr int D = 128, NW = 8, QBLK = 32, KVBLK = 64, LD = 1024;
constexpr float THR = 11.5f;
constexpr size_t SHM_V = KVBLK * D * 2, SHM_K = KVBLK * D * 2;
constexpr size_t NSLOT = 3, OFF_K = NSLOT * SHM_V, OFF_WS = NSLOT * (SHM_V + SHM_K), OFF_X = 0, ATT_LDS = OFF_WS + NW * 64 * 4;
#define KSWZ(row, colB) ((row) * 256 + ((colB) ^ (((row) & 7) << 4)))
#define SBAR() __builtin_amdgcn_sched_barrier(0)
__device__ __forceinline__ int crow(int r, int hi) { return (r & 3) + 8 * (r >> 2) + 4 * hi; }
typedef float f32x2c_t __attribute__((ext_vector_type(2))); typedef __bf16 bf16x2c_t __attribute__((ext_vector_type(2)));
__device__ __forceinline__ unsigned cvtpk(float lo, float hi) { f32x2c_t v = {lo, hi}; bf16x2c_t b = __builtin_convertvector(v, bf16x2c_t); return __builtin_bit_cast(unsigned, b); }
template <bool FAST> __device__ __forceinline__ void partialSM(f32x16& p0, f32x16& p1, float& m_reg, float& mn, float& alpha) {
  if constexpr (FAST) {
#pragma unroll
    for (int r = 0; r < 16; ++r) p0[r] = __builtin_amdgcn_exp2f(p0[r]);
    alpha = 1.f; mn = 0.f;
  } else {
  float pmax = p0[0];
#pragma unroll
  for (int r = 1; r < 16; ++r) pmax = fmaxf(pmax, p0[r]);
#pragma unroll
  for (int r = 0; r < 16; ++r) pmax = fmaxf(pmax, p1[r]);
  { auto rr = __builtin_amdgcn_permlane32_swap(__float_as_uint(pmax), __float_as_uint(pmax), false, false);
    pmax = fmaxf(__uint_as_float(rr[0]), __uint_as_float(rr[1])); }
  if (__builtin_expect(__all(pmax - m_reg <= THR), 1)) { mn = m_reg; alpha = 1.f; }
  else { mn = fmaxf(m_reg, pmax); alpha = __builtin_amdgcn_exp2f(m_reg - mn); m_reg = mn; }
#pragma unroll
  for (int r = 0; r < 16; ++r) p0[r] = p0[r] - mn;
#pragma unroll
  for (int r = 0; r < 16; ++r) p1[r] = p1[r] - mn;
#pragma unroll
  for (int r = 0; r < 16; ++r) p0[r] = __builtin_amdgcn_exp2f(p0[r]);
  }
}
__device__ __forceinline__ void finishSM(f32x16& p0, f32x16& p1, float alpha, float& l_reg, bf16x8& pa0, bf16x8& pa1, bf16x8& pa2, bf16x8& pa3) {
#pragma unroll
  for (int r = 0; r < 16; ++r) p1[r] = __builtin_amdgcn_exp2f(p1[r]);
  typedef float f32x2_ __attribute__((ext_vector_type(2)));
  f32x2_ s2 = (f32x2_){p0[0], p0[1]} + (f32x2_){p1[0], p1[1]};
#pragma unroll
  for (int r = 2; r < 16; r += 2) { s2 += (f32x2_){p0[r], p0[r + 1]}; s2 += (f32x2_){p1[r], p1[r + 1]}; }
  float ps = s2[0] + s2[1];
  { auto rr = __builtin_amdgcn_permlane32_swap(__float_as_uint(ps), __float_as_uint(ps), false, false);
    ps = __uint_as_float(rr[0]) + __uint_as_float(rr[1]); }
  l_reg = l_reg * alpha + ps;
#define PK4(P, BASE, OUT) do { unsigned a0 = cvtpk(P[BASE + 0], P[BASE + 1]), a1 = cvtpk(P[BASE + 2], P[BASE + 3]);   \
    unsigned b0 = cvtpk(P[BASE + 4], P[BASE + 5]), b1 = cvtpk(P[BASE + 6], P[BASE + 7]);                              \
    auto r0 = __builtin_amdgcn_permlane32_swap(a0, b0, false, false); auto r1 = __builtin_amdgcn_permlane32_swap(a1, b1, false, false); \
    u32x4 w = {r0[0], r1[0], r0[1], r1[1]}; OUT = *reinterpret_cast<bf16x8*>(&w); } while (0)
  PK4(p0, 0, pa0); PK4(p0, 8, pa1); PK4(p1, 0, pa2); PK4(p1, 8, pa3);
#undef PK4
}
__device__ __forceinline__ void qkt(f32x16& p0, f32x16& p1, const char* Ks, const bf16x8* qr, int r32, int hi, int ms) {
  p0 = f32x16{}; p1 = f32x16{};
#pragma unroll
  for (int d0 = 0; d0 < 4; ++d0) { int cb = (ms * 64 + d0 * 16 + hi * 8) * 2;
    bf16x8 b0 = *reinterpret_cast<const bf16x8*>(Ks + KSWZ(r32, cb));
    bf16x8 b1 = *reinterpret_cast<const bf16x8*>(Ks + KSWZ(32 + r32, cb));
    p0 = __builtin_amdgcn_mfma_f32_32x32x16_bf16(b0, qr[d0], p0, 0, 0, 0);
    p1 = __builtin_amdgcn_mfma_f32_32x32x16_bf16(b1, qr[d0], p1, 0, 0, 0); }
}
__device__ __forceinline__ int v_st(int k, int c) { const int kk = (k & ~0xC) | ((k & 4) << 1) | ((k & 8) >> 1); return ((kk >> 3) * 4 + (c >> 5)) * 512 + ((kk & 7) * 32 + (c & 31)) * 2; }
__device__ __forceinline__ int v_rd_base(int lane) { return ((lane & 3) << 3) | (((lane >> 2) & 3) << 6) | (((lane >> 4) & 1) << 5) | (((lane >> 5) & 1) << 8); }
constexpr int v_rd_off(int d0, int ks, int half) { return d0 * 512 + ks * 4096 + half * 2048; }
typedef short v4i16_t __attribute__((ext_vector_type(4)));
typedef const __attribute__((address_space(3))) char* lds_cptr;
template <int OFF> __device__ __forceinline__ s16x4 tr_read(lds_cptr vb) {
  return __builtin_bit_cast(s16x4, __builtin_amdgcn_ds_read_tr16_b64_v4i16((__attribute__((address_space(3))) v4i16_t*)(vb + OFF)));
}
template <int D0> __device__ __forceinline__ void pv_one(f32x16& od, lds_cptr vb, bf16x8 pa0, bf16x8 pa1, bf16x8 pa2, bf16x8 pa3) {
  const s16x4 l0 = tr_read<v_rd_off(D0, 0, 0)>(vb), h0 = tr_read<v_rd_off(D0, 0, 1)>(vb), l1 = tr_read<v_rd_off(D0, 1, 0)>(vb), h1 = tr_read<v_rd_off(D0, 1, 1)>(vb);
  const s16x4 l2 = tr_read<v_rd_off(D0, 2, 0)>(vb), h2 = tr_read<v_rd_off(D0, 2, 1)>(vb), l3 = tr_read<v_rd_off(D0, 3, 0)>(vb), h3 = tr_read<v_rd_off(D0, 3, 1)>(vb);
#define PK(L, H) (bf16x8){L[0], L[1], L[2], L[3], H[0], H[1], H[2], H[3]}
  od = __builtin_amdgcn_mfma_f32_32x32x16_bf16(pa0, PK(l0, h0), od, 0, 0, 0);
  od = __builtin_amdgcn_mfma_f32_32x32x16_bf16(pa1, PK(l1, h1), od, 0, 0, 0);
  od = __builtin_amdgcn_mfma_f32_32x32x16_bf16(pa2, PK(l2, h2), od, 0, 0, 0);
  od = __builtin_amdgcn_mfma_f32_32x32x16_bf16(pa3, PK(l3, h3), od, 0, 0, 0);
#undef PK
}
__device__ __forceinline__ void pv_d0(f32x16* o, lds_cptr vb, bf16x8 pa0, bf16x8 pa1, bf16x8 pa2, bf16x8 pa3) {
  pv_one<0>(o[0], vb, pa0, pa1, pa2, pa3); pv_one<1>(o[1], vb, pa0, pa1, pa2, pa3); pv_one<2>(o[2], vb, pa0, pa1, pa2, pa3); pv_one<3>(o[3], vb, pa0, pa1, pa2, pa3);
}
template <bool FAST> __device__ __forceinline__ bool diff_unit(const bf16_t* __restrict__ Q, const bf16_t* __restrict__ K, const bf16_t* __restrict__ V, bf16_t* __restrict__ AO,
                                          long tq0, long tk0, int seq, int h, float lam, const float* __restrict__ subg, char* lds) {
  int tid_ = threadIdx.x; asm volatile("" : "+v"(tid_)); const int tid = tid_, wid = tid >> 6, lane = tid & 63, r32 = lane & 31, hi = lane >> 5, pr = wid & 3, ms = wid >> 2;
  char* V_lds = lds; char* K_lds = lds + OFF_K;
  float* wsf = (float*)(lds + OFF_WS) + wid * 64; float* li_l = wsf; float* al_l = wsf + 32;
  float* X = (float*)(lds + OFF_X) + pr * (32 * 128);
  float m_reg = -1e30f, l_reg = 0; f32x16 o[4] = {}; bf16x8 qr[4];
  const bf16_t* Qw = Q + (tq0 + pr * QBLK + r32) * LD + (2 * h + ms) * 64 + hi * 8;
#pragma unroll
  for (int d0 = 0; d0 < 4; ++d0) qr[d0] = *reinterpret_cast<const bf16x8*>(Qw + d0 * 16);
  const bf16_t* Kh = K + tk0 * LD + h * 128; const bf16_t* Vh = V + tk0 * LD + h * 128;
  const int sr = tid >> 4, sc = (tid & 15) * 8, vst0 = v_st(sr, sc), vst1 = v_st(32 + sr, sc);
  const lds_cptr vb0 = (lds_cptr)V_lds + v_rd_base(lane);
  struct { bf16x8 vs0, vs1, ks0, ks1; } sr_[2];
#define SLOAD(i, k0) do { sr_[i].vs0 = *(const bf16x8*)(&Vh[(long)((k0) + sr) * LD + sc]); sr_[i].vs1 = *(const bf16x8*)(&Vh[(long)((k0) + 32 + sr) * LD + sc]); \
    sr_[i].ks0 = *(const bf16x8*)(&Kh[(long)((k0) + sr) * LD + sc]); sr_[i].ks1 = *(const bf16x8*)(&Kh[(long)((k0) + 32 + sr) * LD + sc]); } while (0)
#define SWRITE(off, i) do { *(bf16x8*)(V_lds + (off) + vst0) = sr_[i].vs0;          \
    *(bf16x8*)(V_lds + (off) + vst1) = sr_[i].vs1; int kc = sc * 2;               \
    *(bf16x8*)(K_lds + (off) + KSWZ(sr, kc)) = sr_[i].ks0;                       \
    *(bf16x8*)(K_lds + (off) + KSWZ(32 + sr, kc)) = sr_[i].ks1; } while (0)
#define SWAIT() asm volatile("s_waitcnt vmcnt(4)" ::: "memory")
#define RESC(a) do { if (!FAST) if (__any((a) < 1.f)) { if (hi == 0) al_l[r32] = (a); asm volatile("s_waitcnt lgkmcnt(0)" ::: "memory"); \
    _Pragma("unroll") for (int d = 0; d < 4; ++d) _Pragma("unroll") for (int r = 0; r < 16; ++r) o[d][r] *= al_l[crow(r, hi)]; } } while (0)
  f32x16 pA0, pA1, pB0, pB1; float mnA, mnB, alA, alB; bf16x8 pa0, pa1, pa2, pa3; const int NT = seq / KVBLK;
  constexpr int SE = 0, SO = 1;
  int s0 = 0, s1 = (int)SHM_V, s2 = 2 * (int)SHM_V;
  SLOAD(SE, 0); asm volatile("s_waitcnt vmcnt(0)" ::: "memory"); SWRITE(0, SE); __syncthreads();
  qkt(pA0, pA1, K_lds, qr, r32, hi, ms); partialSM<FAST>(pA0, pA1, m_reg, mnA, alA); RESC(alA);
  SLOAD(SO, KVBLK); if (2 < NT) SLOAD(SE, 2 * KVBLK);
  SWAIT(); SWRITE(s1, SO); __syncthreads();
  for (int j = 1; j + 1 < NT; j += 2) {
    SBAR(); qkt(pB0, pB1, K_lds + s1, qr, r32, hi, ms);
    finishSM(pA0, pA1, alA, l_reg, pa0, pa1, pa2, pa3); SBAR();
    SLOAD(SO, (j + 2) * KVBLK); SBAR();
    SWAIT(); SWRITE(s2, SE);
    pv_d0(o, vb0 + s0, pa0, pa1, pa2, pa3); partialSM<FAST>(pB0, pB1, m_reg, mnB, alB); RESC(alB);
    __syncthreads();
    SBAR(); qkt(pA0, pA1, K_lds + s2, qr, r32, hi, ms);
    finishSM(pB0, pB1, alB, l_reg, pa0, pa1, pa2, pa3); SBAR();
    if (j + 3 < NT) SLOAD(SE, (j + 3) * KVBLK); SBAR();
    SWAIT(); SWRITE(s0, SO);
    pv_d0(o, vb0 + s1, pa0, pa1, pa2, pa3); partialSM<FAST>(pA0, pA1, m_reg, mnA, alA); RESC(alA);
    __syncthreads();
    { const int t = s0; s0 = s2; s2 = s1; s1 = t; }
  }
  SBAR(); qkt(pB0, pB1, K_lds + s1, qr, r32, hi, ms);
  finishSM(pA0, pA1, alA, l_reg, pa0, pa1, pa2, pa3); SBAR();
  pv_d0(o, vb0 + s0, pa0, pa1, pa2, pa3); partialSM<FAST>(pB0, pB1, m_reg, mnB, alB); RESC(alB);
  finishSM(pB0, pB1, alB, l_reg, pa0, pa1, pa2, pa3); SBAR();
  pv_d0(o, vb0 + s1, pa0, pa1, pa2, pa3);
  __syncthreads();
  if constexpr (FAST) { const int bad = !(l_reg > 1e-30f && l_reg < 1e30f); if (__syncthreads_or(bad)) return true; }
  if (hi == 0) li_l[r32] = l_reg; asm volatile("s_waitcnt lgkmcnt(0)" ::: "memory");
  float rli[16];
#pragma unroll
  for (int r = 0; r < 16; ++r) rli[r] = __builtin_amdgcn_rcpf(li_l[crow(r, hi)]);
  if (ms == 1) {
#pragma unroll
    for (int r = 0; r < 16; ++r)
#pragma unroll
      for (int d0 = 0; d0 < 4; ++d0) X[crow(r, hi) * 128 + d0 * 32 + r32] = o[d0][r] * rli[r];
  }
  __syncthreads();
  if (ms == 0) {
    float sg[4];
#pragma unroll
    for (int d0 = 0; d0 < 4; ++d0) sg[d0] = subg[d0 * 32 + r32] * 0.8f;
#pragma unroll
    for (int r = 0; r < 16; ++r) {
      float v[4]; float sq = 0.f;
#pragma unroll
      for (int d0 = 0; d0 < 4; ++d0) { v[d0] = o[d0][r] * rli[r] - lam * X[crow(r, hi) * 128 + d0 * 32 + r32]; sq += v[d0] * v[d0]; }
      sq += __shfl_xor(sq, 1); sq += __shfl_xor(sq, 2); sq += __shfl_xor(sq, 4); sq += __shfl_xor(sq, 8); sq += __shfl_xor(sq, 16);
      const float rs = 1.0f / sqrtf(sq * (1.0f / 128.0f) + 1e-6f);
      bf16_t* orow = AO + (tq0 + pr * QBLK + crow(r, hi)) * LD + h * 128 + r32;
#pragma unroll
      for (int d0 = 0; d0 < 4; ++d0) orow[d0 * 32] = (bf16_t)(cvtpk(v[d0] * rs * sg[d0], 0.f) & 0xffffu);
    }
  }
  __syncthreads();
  return false;
#undef SLOAD
#undef SWRITE
#undef SWAIT
#undef RESC
}
#undef KSWZ
#undef SBAR
}
namespace fk {
#define LAS3 __attribute__((address_space(3)))
constexpr int NWAVES = 8, NTHR = 512;
constexpr int LDS_BYTES = 147456;
constexpr int NPH = 22;

__device__ __forceinline__ int otid() { int t = threadIdx.x; asm volatile("" : "+v"(t)); return t; }
__device__ __forceinline__ float wave_sum(float v) {
#pragma unroll
  for (int o = 1; o < 64; o <<= 1) v += __shfl_xor(v, o);
  return v;
}
__device__ __forceinline__ unsigned f2bf(float f) { unsigned u = __builtin_bit_cast(unsigned, f); return (u + 0x7fffu + ((u >> 16) & 1u)) >> 16; }
__device__ __forceinline__ unsigned pk2(float lo, float hi) { return f2bf(lo) | (f2bf(hi) << 16); }

__device__ __forceinline__ int srcblk(int mode, int n0) {
  if (mode == 1) { const int pn = n0 >> 8; if (pn >= 8) return n0; const int bj = (n0 >> 7) & 1, wc = (n0 >> 5) & 3; return pn * 256 + wc * 64 + bj * 32; }
  if (mode == 2) { const int pn = n0 >> 8, bj = (n0 >> 7) & 1, i = n0 & 127; return bj * FF + pn * 128 + i; }
  return n0;
}
__device__ __forceinline__ void transpose_item(const float* __restrict__ W, int K, int N, const float* __restrict__ gk, int mode, bf16_t* __restrict__ WT, float* scr, int item, int lane) {
  const int nblk = N / 32, kb = item / nblk, nb = item % nblk, k0 = 64 * kb, n0 = 32 * nb, s0 = srcblk(mode, n0);
#pragma unroll 8
  for (int i = 0; i < 32; ++i) { const int kk = 2 * i + (lane >> 5); float w = __builtin_nontemporal_load(W + (size_t)(k0 + kk) * N + s0 + (lane & 31)); if (gk) w *= gk[k0 + kk]; scr[kk * 33 + (lane & 31)] = w; }
  asm volatile("s_waitcnt lgkmcnt(0)" ::: "memory");
  const int c = lane & 7;
#pragma unroll
  for (int j = 0; j < 4; ++j) { const int n = (lane >> 3) + 8 * j; const float* s = scr + (8 * c) * 33 + n;
    u32x4 o; o.x = pk2(s[0 * 33], s[1 * 33]); o.y = pk2(s[2 * 33], s[3 * 33]); o.z = pk2(s[4 * 33], s[5 * 33]); o.w = pk2(s[6 * 33], s[7 * 33]);
    *(u32x4*)(WT + (size_t)(n0 + n) * K + k0 + 8 * c) = o; }
  asm volatile("s_waitcnt lgkmcnt(0)" ::: "memory");
}
__device__ __forceinline__ void row_to_bf16_ss(const float* xrow, bf16_t* orow, float* ssp, int lane) {
  const f32x4* xr = (const f32x4*)xrow + lane; f32x4 v[4]; float s = 0.f;
#pragma unroll
  for (int j = 0; j < 4; ++j) { v[j] = __builtin_nontemporal_load(xr + 64 * j); s += (v[j][0] * v[j][0] + v[j][1] * v[j][1]) + (v[j][2] * v[j][2] + v[j][3] * v[j][3]); }
  s = wave_sum(s);
  unsigned long long* o8 = (unsigned long long*)orow + lane;
#pragma unroll
  for (int j = 0; j < 4; ++j) o8[64 * j] = (unsigned long long)pk2(v[j][0], v[j][1]) | ((unsigned long long)pk2(v[j][2], v[j][3]) << 32);
  if (lane == 0) *ssp = s;
}
struct WJob { const float* W; int K, N; const float* gk; int mode; size_t dst; };

__device__ __forceinline__ void prep_phase(const Params& P, char* lds, int vcu, int G) {
  const int tid = otid(), lane = tid & 63, wave = tid >> 6;
  float* scr = (float*)(lds + wave * 16384);
  const int gw = vcu * NWAVES + wave, NGW = G * NWAVES; unsigned char* ws = P.ws;
#define TITEM(Wp, K_, N_, gk_, mode_, dst_, r_) transpose_item(Wp, K_, N_, gk_, mode_, (bf16_t*)(ws + (dst_)), scr, r_, lane)
  for (int it = gw; it < 13312; it += NGW) {
    int r = it;
    if (r < 1536) { TITEM(P.in[5], 1024, 3072, P.in[4], 1, WS_WQKV, r); continue; } r -= 1536;
    if (r < 512) { TITEM(P.in[11], 1024, 1024, nullptr, 0, WS_WO, r); continue; } r -= 512;
    if (r < 1024) { TITEM(P.in[12], 1024, 2048, P.in[4] + 1024, 0, WS_WUV, r); continue; } r -= 1024;
    if (r < 512) { TITEM(P.in[17], 1024, 1024, nullptr, 0, WS_WOUT, r); continue; } r -= 512;
    const int L = r >= 4864 ? 1 : 0; r -= L * 4864;
    if (r < 2816) { TITEM(P.in[19] + (size_t)L * 1024 * NUP, 1024, NUP, P.in[18] + L * 1024, 2, WS_WUP + (size_t)L * 11 * MiB, r); continue; } r -= 2816;
    if (r < 1408) { TITEM(P.in[22] + (size_t)L * FF * 1024, FF, 1024, nullptr, 0, WS_WDN + (size_t)L * (11 * MiB / 2), r); continue; } r -= 1408;
    if (r < 512) { TITEM(P.in[24] + (size_t)L * 1024 * 1024, 1024, 1024, P.in[23] + L * 1024, 0, WS_WG + (size_t)L * 2 * MiB, r); continue; } r -= 512;
    TITEM(P.in[25] + (size_t)L * 256 * 1024, 256, 1024, nullptr, 0, WS_WP + (size_t)L * (MiB / 2), r);
  }
#undef TITEM
  for (int m = gw; m < NTOK; m += NGW) { const float* xr = m < HALF_TOK ? P.xin_a + (size_t)m * DM : P.xin_b + (size_t)(m - HALF_TOK) * DM;
    row_to_bf16_ss(xr, (bf16_t*)(ws + WS_XB) + (size_t)m * DM, (float*)(ws + WS_SS) + m, lane); }
  const size_t gt = (size_t)vcu * NTHR + tid, GT = (size_t)G * NTHR;
  for (size_t i = gt; i < (size_t)2 * NTOK * 256 / 8; i += GT) { const size_t e = i * 8; const int L = (int)(e / ((size_t)NTOK * 256)); const size_t r = e % ((size_t)NTOK * 256);
    const float* src = r < (size_t)HALF_TOK * 256 ? P.in[2] + (size_t)L * HALF_TOK * 256 + r : P.in[3] + (size_t)L * HALF_TOK * 256 + (r - (size_t)HALF_TOK * 256);
    const f32x4 a = __builtin_nontemporal_load((const f32x4*)src), b = __builtin_nontemporal_load((const f32x4*)(src + 4)); *(u32x4*)((bf16_t*)(ws + WS_PB) + e) = pack8(a, b); }
  for (size_t i = gt; i < (size_t)16384 * 32; i += GT) { const int d = (int)(i & 31), pos = (int)(i >> 5);
    const float inv = 1.0f / powf(10000.0f, (float)(2 * d) / 64.0f); const float ang = (float)pos * inv;
    const double tw = 6.283185307179586476925; double r = (double)ang; r -= tw * rint(r / tw); const float rf = (float)r;
    ((float*)(ws + WS_COS))[i] = cosf(rf); ((float*)(ws + WS_SIN))[i] = sinf(rf); }
  for (size_t i = gt; i < (size_t)8 * 128 * 128 / 8; i += GT) { const float* src = P.in[15] + i * 8; *(u32x4*)((bf16_t*)(ws + WS_WSP) + i * 8) = pack8(*(const f32x4*)src, *(const f32x4*)(src + 4)); }
  for (size_t i = gt; i < (size_t)6 * NTOK; i += GT) ((float*)(ws + WS_SS))[NTOK + i] = 0.f;
  for (size_t i = gt; i < (size_t)2 * NTOK; i += GT) ((float*)(ws + WS_LNS))[i] = 0.f;
  if (vcu == 0 && tid == 0) { float d1 = 0.f, d2 = 0.f; for (int i = 0; i < 64; ++i) { d1 += P.in[6][i] * P.in[7][i]; d2 += P.in[8][i] * P.in[9][i]; }
    *(float*)(ws + WS_LAM) = expf(d1) - expf(d2) + 0.2f; }
}

__device__ __forceinline__ void sgu_phase(const Params& P, char* lds, int vcu, int G) {
  const int tid = otid(), lane = tid & 63, w = tid >> 6; unsigned char* ws = P.ws;
  bf16_t* vT = (bf16_t*)lds; bf16_t* Wsm = (bf16_t*)(lds + 34816);
  bf16_t* U = (bf16_t*)(ws + WS_R1); const bf16_t* Vs = (const bf16_t*)(ws + WS_XB); const float* lns = (const float*)(ws + WS_LNS);
  const int c8 = (tid & 15) * 8, q0 = tid >> 4; const int i16 = lane & 15, kg = lane >> 4; const int p = 16 * w + i16;
  int gcur = -1; f32x4 g0, g1, b0, b1; float bias = 0.f;
  u32x4 nv[4]; float ns1[4], ns2[4];
#define SGU_PREF(ui_) do { const int ch_ = (ui_) >> 3, g_ = (ui_) & 7; _Pragma("unroll") for (int i = 0; i < 4; ++i) { const int row_ = ch_ * 128 + q0 + 32 * i; \
      nv[i] = *(const u32x4*)(Vs + (size_t)row_ * DM + g_ * 128 + c8); ns1[i] = lns[row_]; ns2[i] = lns[NTOK + row_]; } } while (0)
  int ui = vcu; if (ui < 4096) SGU_PREF(ui);
#pragma unroll 1
  for (; ui < 4096; ui += G) {
    const int chunk = ui >> 3, g = ui & 7;
    u32x4 cv[4]; float cs1[4], cs2[4];
#pragma unroll
    for (int i = 0; i < 4; ++i) { cv[i] = nv[i]; cs1[i] = ns1[i]; cs2[i] = ns2[i]; }
    if (g != gcur) {
      __syncthreads();
#pragma unroll
      for (int i = 0; i < 4; ++i) { const int pp_ = q0 + 32 * i; *(u32x4*)(Wsm + pp_ * 136 + c8) = *(const u32x4*)((const bf16_t*)(ws + WS_WSP) + (size_t)(g * 128 + pp_) * 128 + c8); }
      const float* lng = P.in[13] + g * 128 + c8; const float* lnb = P.in[14] + g * 128 + c8;
      g0 = *(const f32x4*)lng; g1 = *(const f32x4*)(lng + 4); b0 = *(const f32x4*)lnb; b1 = *(const f32x4*)(lnb + 4); bias = P.in[16][g * 128 + p]; gcur = g;
    }
    if (ui + G < 4096) SGU_PREF(ui + G);
    const size_t token = (size_t)chunk * 128 + p; u32x2 uu[8];
#pragma unroll
    for (int cb = 0; cb < 8; ++cb) uu[cb] = *(const u32x2*)(U + token * DM + g * 128 + 16 * cb + 4 * kg);
#pragma unroll
    for (int i = 0; i < 4; ++i) { const int q = q0 + 32 * i; f32x4 x0, x1; unpack8(cv[i], x0, x1);
      const float mean = cs1[i] * (1.0f / 1024.0f); const float var = cs2[i] * (1.0f / 1024.0f) - mean * mean; const float rs = 1.0f / sqrtf(fmaxf(var, 0.f) + EPS);
      x0 = (x0 - mean) * rs * g0 + b0; x1 = (x1 - mean) * rs * g1 + b1;
#pragma unroll
      for (int e = 0; e < 4; ++e) { vT[(c8 + e) * 136 + q] = (bf16_t)f2bf(x0[e]); vT[(c8 + 4 + e) * 136 + q] = (bf16_t)f2bf(x1[e]); } }
    __syncthreads();
    f32x4 acc[8];
#pragma unroll
    for (int cb = 0; cb < 8; ++cb) acc[cb] = (f32x4){0.f, 0.f, 0.f, 0.f};
#pragma unroll
    for (int ks = 0; ks < 4; ++ks) { const bf16x8 bfrag = *(const bf16x8*)(Wsm + (16 * w + i16) * 136 + ks * 32 + kg * 8);
#pragma unroll
      for (int cb = 0; cb < 8; ++cb) { const bf16x8 afrag = *(const bf16x8*)(vT + (16 * cb + i16) * 136 + ks * 32 + kg * 8);
        acc[cb] = __builtin_amdgcn_mfma_f32_16x16x32_bf16(afrag, bfrag, acc[cb], 0, 0, 0); } }
#pragma unroll
    for (int cb = 0; cb < 8; ++cb) { bf16_t* up = U + token * DM + g * 128 + 16 * cb + 4 * kg;
      const float u0 = __uint_as_float(uu[cb].x << 16), u1 = __uint_as_float(uu[cb].x & 0xffff0000u), u2 = __uint_as_float(uu[cb].y << 16), u3 = __uint_as_float(uu[cb].y & 0xffff0000u);
      u32x2 o; o.x = cvt_pk_bf16(u0 * (acc[cb][0] + bias), u1 * (acc[cb][1] + bias)); o.y = cvt_pk_bf16(u2 * (acc[cb][2] + bias), u3 * (acc[cb][3] + bias)); *(u32x2*)up = o; }
    __syncthreads();
  }
#undef SGU_PREF
}

__device__ __forceinline__ f32x4 ld4bf(const bf16_t* p) { const u32x2 w = *(const u32x2*)p; return (f32x4){__uint_as_float(w.x << 16), __uint_as_float(w.x & 0xffff0000u), __uint_as_float(w.y << 16), __uint_as_float(w.y & 0xffff0000u)}; }
__device__ __forceinline__ void fixup_phase(const Params& P, int L, int half, int vcu, int G) {
  unsigned char* ws = P.ws; const bf16_t* HAL = (const bf16_t*)(ws + WS_HALO); bf16_t* Gb = (bf16_t*)(ws + WS_G);
  const float* cw = P.in[20] + (size_t)L * 3 * NUP; const int S = half == 0 ? 16384 : 2048;
  const size_t gt = (size_t)vcu * NTHR + otid(), GT = (size_t)G * NTHR;
  for (size_t i = gt; i < (size_t)512 * 2 * (FF / 4); i += GT) { const int f = (int)(i % (FF / 4)) * 4; const int rb = (int)(i / (FF / 4)); const int blk = rb >> 1, which = rb & 1;
    const int row = blk * 64 + (which ? 63 : 0); const int pos = row % S;
    const bf16_t* h = HAL + (size_t)(blk * 4) * NUP;
    f32x4 cv = ld4bf(h + (2 + which) * NUP + f), cg = ld4bf(h + (2 + which) * NUP + FF + f);
    if (which == 0) { if (pos != 0) { const bf16_t* hp = HAL + (size_t)((blk - 1) * 4 + 1) * NUP; cv += *(const f32x4*)(cw + f) * ld4bf(hp + f); cg += *(const f32x4*)(cw + FF + f) * ld4bf(hp + FF + f); } }
    else { if (pos != S - 1) { const bf16_t* hn = HAL + (size_t)((blk + 1) * 4 + 0) * NUP; cv += *(const f32x4*)(cw + 2 * NUP + f) * ld4bf(hn + f); cg += *(const f32x4*)(cw + 2 * NUP + FF + f) * ld4bf(hn + FF + f); } }
    u32x2 w; w.x = cvt_pk_bf16(cg[0] * sigmoidf_(cg[0]) * cv[0], cg[1] * sigmoidf_(cg[1]) * cv[1]); w.y = cvt_pk_bf16(cg[2] * sigmoidf_(cg[2]) * cv[2], cg[3] * sigmoidf_(cg[3]) * cv[3]);
    *(u32x2*)(Gb + (size_t)row * FF + f) = w; }
}

__device__ __forceinline__ void final_phase(const Params& P, int vcu, int G) {
  const int t_ = otid(); const int lane = t_ & 63, wave = t_ >> 6; const int gw = vcu * NWAVES + wave, NGW = G * NWAVES;
  const float* ss = (const float*)(P.ws + WS_SS) + (size_t)6 * NTOK; const bf16_t* X = (const bf16_t*)(P.ws + WS_R2);
  const f32x4* g4 = (const f32x4*)P.in[26]; const f32x4 ga0 = g4[lane * 2], ga1 = g4[lane * 2 + 1], gb0 = g4[(lane + 64) * 2], gb1 = g4[(lane + 64) * 2 + 1];
  for (int m0 = gw * 4; m0 < NTOK; m0 += NGW * 4) {
    u32x4 xa[4], xb_[4]; float sv[4];
#pragma unroll
    for (int r = 0; r < 4; ++r) { const u32x4* xr = (const u32x4*)(X + (size_t)(m0 + r) * DM) + lane; xa[r] = xr[0]; xb_[r] = xr[64]; sv[r] = ss[m0 + r]; }
#pragma unroll
    for (int r = 0; r < 4; ++r) { const float rs = rstd_of(sv[r]); f32x4* yr = (f32x4*)(P.out + (size_t)(m0 + r) * DM); f32x4 a, b;
      unpack8(xa[r], a, b); yr[lane * 2] = a * rs * ga0; yr[lane * 2 + 1] = b * rs * ga1;
      unpack8(xb_[r], a, b); yr[(lane + 64) * 2] = a * rs * gb0; yr[(lane + 64) * 2 + 1] = b * rs * gb1; } }
}

__global__ void __launch_bounds__(NTHR, 2) mega(Params P) {
  extern __shared__ __attribute__((aligned(16))) unsigned char lds_raw[];
  cg::grid_group grid = cg::this_grid();
  LAS3 unsigned char* lds3 = (LAS3 unsigned char*)lds_raw; char* lds = (char*)lds_raw;
  const int G = gridDim.x, bx = blockIdx.x; const int vcu = (G % 8 == 0) ? (bx % 8) * (G / 8) + bx / 8 : bx;
  unsigned char* ws = P.ws; const int lo = P.ph_lo, hi = P.ph_hi;
  volatile LAS3 unsigned* MISC = (volatile LAS3 unsigned*)(lds3 + 139264);
  if (threadIdx.x < 4) MISC[threadIdx.x] = 0u;
  __syncthreads();
  if (blockIdx.x == 0) for (int i = threadIdx.x; i < XCD_BAR_WORDS; i += NTHR) ((unsigned*)(ws + WS_BAR))[i] = 0u;
  xb::XcdBarrier bar; bar.bar = (unsigned*)(ws + WS_BAR); bar.x = 0; bar.st = MISC;
  float* SS = (float*)(ws + WS_SS);
  bf16_t* XB = (bf16_t*)(ws + WS_XB); bf16_t* R1 = (bf16_t*)(ws + WS_R1); bf16_t* R2 = (bf16_t*)(ws + WS_R2);
#ifndef ENMASK
#define ENMASK 0xffffffffu
#endif
#define IN(k) (lo <= (k) && (k) < hi)
#define EN(b) (((ENMASK) >> (b)) & 1u)
#ifdef PROBE_TA
#ifndef PROBE_DIV
#define PROBE_DIV 2000.0f
#endif
  unsigned long long tp0 = (PROBE_TA == 0) ? __builtin_amdgcn_s_memrealtime() : 0ull, tp1 = 0;
#define STAMP0(k) do { if ((k) == PROBE_TA) tp0 = __builtin_amdgcn_s_memrealtime(); } while (0)
#define STAMP1(k) do { if ((k) == PROBE_TB) tp1 = __builtin_amdgcn_s_memrealtime(); } while (0)
#else
#define STAMP0(k) do {} while (0)
#define STAMP1(k) do {} while (0)
#endif
#define SEAM(k) do { if (IN(k) && IN((k) + 1)) { if ((k) == 0) { grid.sync(); bar = xb::xcd_barrier_post((unsigned*)(ws + WS_BAR), MISC); } else xb::xcd_barrier(bar); } else __syncthreads(); STAMP1(k); STAMP0((k) + 1); } while (0)
#define GEMM(EpiT, E, Aptr, Bptr, M_, N_, K_) do { pg8::Gemm g_{(const bf16_t*)(Aptr), (const bf16_t*)(Bptr), M_, N_, K_}; pg8::StaticOrder S_; S_.init(M_, N_, G, bx); \
    pg8::gemm_phase<EpiT, pg8::StaticOrder, true, true>(lds3, g_, S_, E); } while (0)

  if (EN(0) && IN(0)) { prep_phase(P, lds, vcu, G); }
  SEAM(0);
  if (EN(1) && IN(1)) { EpiQKV E{R1, (bf16_t*)P.out, SS, (const float*)(ws + WS_COS), (const float*)(ws + WS_SIN)};
    GEMM(EpiQKV, E, XB, ws + WS_WQKV, NTOK, 3072, 1024); }
  SEAM(1);
  if (EN(2) && IN(2)) { const float lam = *(const float*)(ws + WS_LAM); const float* subg = P.in[10];
    const bf16_t* Q = R1; const bf16_t* K = (const bf16_t*)P.out; const bf16_t* V = K + (size_t)NTOK * DM; bf16_t* AO = R2;
    const int nu = (G == 256) ? 16 : (4096 + G - 1) / G;
#define ATT_UNIT_ARGS(i) \
      int ui; if (G == 256) { const int x = vcu >> 5, j = vcu & 31; ui = ((i) < 8) ? ((2 * x + ((i) >> 2)) * 128 + j + 32 * ((i) & 3)) : (2048 + (16 * x) * 16 + ((i) - 8) * 32 + j); } \
      else { ui = bx + (i) * G; if (ui >= 4096) break; } \
      long tq0, tk0; int seq, h; \
      if (ui < 2048) { const int ph = ui >> 7, qb = ui & 127; tk0 = (long)(ph >> 3) * 16384; tq0 = tk0 + qb * 128; seq = 16384; h = ph & 7; } \
      else { const int v = ui - 2048, pair = v >> 4, qb = v & 15; tk0 = (long)HALF_TOK + (long)(pair >> 3) * 2048; tq0 = tk0 + qb * 128; seq = 2048; h = pair & 7; }
    unsigned long long badmask = 0ull;
#ifdef PROBE_FORCE_SAFE
    badmask = ~0ull;
#endif
#pragma unroll 1
    for (int i = 0; i < nu && i < 64; ++i) { ATT_UNIT_ARGS(i)
      if (at::diff_unit<true>(Q, K, V, AO, tq0, tk0, seq, h, lam, subg, lds)) badmask |= 1ull << i; }
#pragma unroll 1
    for (int i = 0; i < nu && i < 64; ++i) { if (!((badmask >> i) & 1ull)) continue; ATT_UNIT_ARGS(i)
      (void)at::diff_unit<false>(Q, K, V, AO, tq0, tk0, seq, h, lam, subg, lds); }
#undef ATT_UNIT_ARGS
  }
  SEAM(2);
  if (EN(3) && IN(3)) { EpiRes<0> E{P.xin_a, P.xin_b, nullptr, XB, SS + 1 * NTOK, nullptr, nullptr, 0}; GEMM(EpiRes<0>, E, R2, ws + WS_WO, NTOK, 1024, 1024); }
  SEAM(3);
#pragma unroll 1
  for (int L = 0; L < 2; ++L) {
    const int pb = 4 + 10 * L;
    if (L == 1) {
      if (EN(11) && IN(11)) { EpiUV E{R1, XB, SS + 3 * NTOK, (float*)(ws + WS_LNS)}; GEMM(EpiUV, E, R2, ws + WS_WUV, NTOK, 2048, 1024); }
      SEAM(11);
      if (EN(12) && IN(12)) sgu_phase(P, lds, vcu, G);
      SEAM(12);
      if (EN(13) && IN(13)) { EpiRes<1> E{nullptr, nullptr, R2, XB, SS + 4 * NTOK, nullptr, nullptr, 0}; GEMM(EpiRes<1>, E, R1, ws + WS_WOUT, NTOK, 1024, 1024); }
      SEAM(13);
    }
#pragma unroll 1
    for (int half = 0; half < 2; ++half) {
      const int p0 = pb + 3 * half; const int rowoff = half * HALF_TOK;
      if (EN(4) && IN(p0)) { EpiUp E{(bf16_t*)(ws + WS_G), (bf16_t*)(ws + WS_HALO), SS + (size_t)(1 + 3 * L) * NTOK, P.in[20] + (size_t)L * 3 * NUP, P.in[21] + (size_t)L * NUP, rowoff};
        GEMM(EpiUp, E, XB + (size_t)rowoff * DM, ws + WS_WUP + (size_t)L * 11 * MiB, HALF_TOK, NUP, 1024); }
      SEAM(p0);
      if (EN(5) && IN(p0 + 1)) fixup_phase(P, L, half, vcu, G);
      SEAM(p0 + 1);
      if (EN(6) && IN(p0 + 2)) { EpiRes<1> E{nullptr, nullptr, XB, XB, SS + (size_t)(2 + 3 * L) * NTOK, nullptr, nullptr, rowoff};
        GEMM(EpiRes<1>, E, ws + WS_G, ws + WS_WDN + (size_t)L * (11 * MiB / 2), HALF_TOK, 1024, FF); }
      SEAM(p0 + 2);
    }
    const int pp = pb + 6;
    if (EN(10) && IN(pp)) {
      { EpiStore E{R1}; GEMM(EpiStore, E, (bf16_t*)(ws + WS_PB) + (size_t)L * NTOK * 256, ws + WS_WP + (size_t)L * (MiB / 2), NTOK, 1024, 256); }
      __syncthreads();
      { EpiRes<2> E{nullptr, nullptr, XB, R2, SS + (size_t)(3 + 3 * L) * NTOK, SS + (size_t)(2 + 3 * L) * NTOK, R1, 0};
        GEMM(EpiRes<2>, E, XB, ws + WS_WG + (size_t)L * 2 * MiB, NTOK, 1024, 1024); }
    }
    SEAM(pp);
  }
  if (EN(21) && IN(21)) final_phase(P, vcu, G);
#ifdef PROBE_TA
#ifndef PROBE_DIV
#define PROBE_DIV 2000.0f
#endif
  __syncthreads();
#ifdef PROBE_END
  asm volatile("s_waitcnt vmcnt(0)" ::: "memory"); tp1 = __builtin_amdgcn_s_memrealtime();
#endif
  if (bx == 0 && threadIdx.x == 0) { asm volatile("s_waitcnt vmcnt(0)" ::: "memory"); P.out[0] += (float)(tp1 - tp0) * (1.0f / PROBE_DIV); }
#endif
#undef IN
#undef SEAM
#undef EN
#undef GEMM
}
}
#ifndef MODE
#define MODE 0
#endif
#ifndef FASTMASK
#define FASTMASK 0x7f
#endif
namespace fk {
__global__ void __launch_bounds__(256) k_resync(const float* __restrict__ x, bf16_t* __restrict__ xb, float* __restrict__ ss) {
  const int lane = threadIdx.x & 63; const int gw = blockIdx.x * 4 + (threadIdx.x >> 6), NGW = gridDim.x * 4;
  for (int m = gw; m < NTOK; m += NGW) row_to_bf16_ss(x + (size_t)m * DM, xb + (size_t)m * DM, ss + m, lane);
}
}
extern "C" void kernel_launch(void* const* d_in, const int* in_sizes, int n_in, void* d_out, int out_size, void* d_ws, size_t ws_size, hipStream_t stream) {
  static int grid = 0;
  if (grid == 0) {
    if (n_in != 27 || out_size != fk::NTOK * fk::DM || ws_size < (size_t)512 * fk::MiB) { fprintf(stderr, "kernel_launch: unexpected shapes n_in %d out %d ws %zu\n", n_in, out_size, ws_size); grid = -1; return; }
    int dev = 0, cus = 0, per_cu = 0; hipGetDevice(&dev); hipDeviceGetAttribute(&cus, hipDeviceAttributeMultiprocessorCount, dev);
    if (hipFuncSetAttribute((const void*)fk::mega, hipFuncAttributeMaxDynamicSharedMemorySize, fk::LDS_BYTES) != hipSuccess) { fprintf(stderr, "kernel_launch: hipFuncSetAttribute failed\n"); grid = -1; return; }
    if (hipOccupancyMaxActiveBlocksPerMultiprocessor(&per_cu, (const void*)fk::mega, fk::NTHR, fk::LDS_BYTES) != hipSuccess || per_cu < 1) { fprintf(stderr, "kernel_launch: occupancy query says %d\n", per_cu); per_cu = 1; }
    (void)hipGetLastError();
    grid = cus * per_cu; if (grid > 256) grid = 256;
    fprintf(stderr, "kernel_launch: grid %d (cus %d per_cu %d) ws %zu\n", grid, cus, per_cu, ws_size);
  }
  if (grid < 0) return;
  fk::Params p{};
  for (int i = 0; i < 27; ++i) p.in[i] = (const float*)d_in[i];
  p.xin_a = (const float*)d_in[0]; p.xin_b = (const float*)d_in[1]; p.out = (float*)d_out; p.ws = (unsigned char*)d_ws;
#if MODE == 0
  p.ph_lo = 0; p.ph_hi = fk::NPH; void* args[] = {&p};
  hipError_t e = hipLaunchCooperativeKernel((const void*)fk::mega, dim3(grid), dim3(fk::NTHR), args, fk::LDS_BYTES, stream);
  if (e != hipSuccess) fprintf(stderr, "cooperative launch failed: %s (grid %d)\n", hipGetErrorString(e), grid);
#else
  auto runph = [&](int a, int b) { for (int k = a; k <= b; ++k) { p.ph_lo = k; p.ph_hi = k + 1; hipLaunchKernelGGL(fk::mega, dim3(grid), dim3(fk::NTHR), fk::LDS_BYTES, stream, p); } };
  char* nws = (char*)d_ws + 128 * fk::MiB; float* out = (float*)d_out; unsigned char* ws = (unsigned char*)d_ws;
  hipMemsetAsync((char*)d_ws + fk::WS_BAR, 0, 16384, stream);
  runph(0, 0);
  const int first[7] = {1, 4, 10, 11, 14, 20, 21}, last[7] = {3, 9, 10, 13, 19, 20, 21};
  if (!(FASTMASK & 1)) { hipMemcpyAsync(out, d_in[0], (size_t)fk::HALF_TOK * 1024 * 4, hipMemcpyDeviceToDevice, stream); hipMemcpyAsync(out + (size_t)fk::HALF_TOK * 1024, d_in[1], (size_t)fk::HALF_TOK * 1024 * 4, hipMemcpyDeviceToDevice, stream); }
  for (int s = 0; s < 7; ++s) {
    if (FASTMASK & (1 << s)) {
      if (s > 0) fk::k_resync<<<1024, 256, 0, stream>>>(out, (fk::bf16_t*)(ws + (s == 3 ? fk::WS_R2 : fk::WS_XB)), (float*)(ws + fk::WS_SS) + (size_t)s * fk::NTOK);
      runph(first[s], last[s]);
    } else nv::stage(s, d_in, out, nws, stream);
  }
#endif
}
```
